# Optimizing an MI355X kernel written in HIP

```python
import jax, jax.numpy as jnp
from jax import lax
import numpy as np

D_MODEL = 1024
BATCH = 8
SEQ = 2048
DEPTH = 2

HEAD_DIM = 64
NSA_HEADS = 8
NSA_KV_GROUPS = 2
NSA_WIDTH = NSA_HEADS * HEAD_DIM
CMP_STRIDE = 16
CMP_BLOCK = 2 * CMP_STRIDE
CMP_HIDDEN = 128
SLC_BLOCK = 64
SLC_TOPN = 16
NSA_WINDOW = 512
SLC_QUERY_BLOCK = 64
SWA_HEADS = 4
SWA_KV_HEADS = 2
SWA_WIDTH = SWA_HEADS * HEAD_DIM
SWA_WINDOW = 128
RWKV_HEADS = 4
RWKV_WIDTH = RWKV_HEADS * HEAD_DIM
DECAY_LORA = 64
ICLR_LORA = 64
VRES_LORA = 32
RWKV_SHIFT_WIDTH = 3 * RWKV_WIDTH + DECAY_LORA + ICLR_LORA

N_BRANCHES = 3
QUERY_BLOCK = 128
NORM_EPS = 1e-6
GN_EPS = 64e-5
NEG_INF = -1e30
FORCE = 1e9
F32 = jnp.float32

IN_SEGMENTS = (
    ("a_q", NSA_WIDTH),
    ("a_kv_cmp", 2 * NSA_KV_GROUPS * HEAD_DIM),
    ("a_kv_slc", 2 * NSA_KV_GROUPS * HEAD_DIM),
    ("a_kv_win", 2 * NSA_KV_GROUPS * HEAD_DIM),
    ("a_gate", 3 * NSA_HEADS),
    ("a_z", NSA_WIDTH),
    ("b_q", SWA_WIDTH),
    ("b_kv", 2 * SWA_KV_HEADS * HEAD_DIM),
    ("b_z", SWA_WIDTH),
    ("c_shift", RWKV_SHIFT_WIDTH),
    ("c_z", RWKV_WIDTH),
    ("merge", N_BRANCHES * D_MODEL),
)
N_IN = sum(size for _, size in IN_SEGMENTS)

kernel_name = "hybrid_nsa_swa_rwkv7_gated_parallel"


def rms_norm(x, g):
    xf = x.astype(F32)
    y = xf * lax.rsqrt(jnp.mean(xf * xf, axis=-1, keepdims=True) + NORM_EPS)
    return (y * g.astype(F32)).astype(x.dtype)


def split_columns(h):
    out = {}
    off = 0
    for name, size in IN_SEGMENTS:
        out[name] = h[..., off:off + size]
        off += size
    return out


def masked_softmax(s, valid, sink=None):
    s = jnp.where(valid, s, NEG_INF)
    m = jnp.max(s, axis=-1, keepdims=True)
    if sink is not None:
        m = jnp.maximum(m, sink)
    p = jnp.where(valid, jnp.exp(s - m), 0.0)
    denom = jnp.sum(p, axis=-1, keepdims=True)
    if sink is not None:
        denom = denom + jnp.exp(sink - m)
    denom = jnp.where(denom > 0, denom, 1.0)
    return p / denom


def banded_attention(q, k, v, window, sink=None):
    b, t, g, hg, dh = q.shape
    nb = t // QUERY_BLOCK
    span = window + QUERY_BLOCK
    pad = ((0, 0), (window, 0), (0, 0), (0, 0))
    kp = jnp.pad(k, pad)
    vp = jnp.pad(v, pad)
    scale = dh ** -0.5
    sink_b = None if sink is None else sink.astype(F32)[None, :, :, None, None]

    def block(i):
        start = i * QUERY_BLOCK
        qb = lax.dynamic_slice_in_dim(q, start, QUERY_BLOCK, axis=1)
        kb = lax.dynamic_slice_in_dim(kp, start, span, axis=1)
        vb = lax.dynamic_slice_in_dim(vp, start, span, axis=1)
        s = jnp.einsum('bqghd,bkgd->bghqk', qb, kb, preferred_element_type=F32) * scale
        tpos = start + jnp.arange(QUERY_BLOCK)
        kpos = start - window + jnp.arange(span)
        rel = tpos[:, None] - kpos[None, :]
        valid = (rel >= 0) & (rel < window) & (kpos[None, :] >= 0)
        p = masked_softmax(s, valid, sink_b)
        return jnp.einsum('bghqk,bkgd->bqghd', p, vb.astype(F32)).astype(q.dtype)

    out = lax.map(block, jnp.arange(nb))
    return jnp.moveaxis(out, 0, 1).reshape(b, t, g, hg, dh)


def nsa_attention(q, kv_cmp, kv_slc, kv_win, gate_logits, pe_k, w1_k, w2_k, pe_v, w1_v, w2_v):
    b, t, _ = q.shape
    g, hg, dh = NSA_KV_GROUPS, NSA_HEADS // NSA_KV_GROUPS, HEAD_DIM
    q = q.reshape(b, t, g, hg, dh)
    scale = dh ** -0.5

    def kv_split(kv):
        kv = kv.reshape(b, t, 2, g, dh)
        return kv[:, :, 0], kv[:, :, 1]

    k_c, v_c = kv_split(kv_cmp)
    k_s, v_s = kv_split(kv_slc)
    k_w, v_w = kv_split(kv_win)

    n_cmp = t // CMP_STRIDE - 1

    def compress(z, pe, w1, w2):
        c = z.reshape(b, t // CMP_STRIDE, CMP_STRIDE, g, dh)
        blocks = jnp.concatenate([c[:, :-1], c[:, 1:]], axis=2) + pe[None, None, :, None, :]
        flat = jnp.moveaxis(blocks, 3, 2).reshape(b, n_cmp, g, CMP_BLOCK * dh)
        return jax.nn.silu(flat @ w1) @ w2

    kc = compress(k_c, pe_k, w1_k, w2_k)
    vc = compress(v_c, pe_v, w1_v, w2_v)
    s = jnp.einsum('btghd,bngd->bghtn', q, kc, preferred_element_type=F32) * scale
    tpos = jnp.arange(t)
    cmp_end = jnp.arange(n_cmp) * CMP_STRIDE + CMP_BLOCK - 1
    valid_c = cmp_end[None, :] <= tpos[:, None]
    p_cmp = masked_softmax(s, valid_c)
    o_cmp = jnp.einsum('bghtn,bngd->btghd', p_cmp, vc.astype(F32)).astype(q.dtype)

    n_slc = t // SLC_BLOCK
    n_sel = min(SLC_TOPN, n_slc)
    ci = jnp.arange(n_cmp)[:, None] * CMP_STRIDE
    sj = jnp.arange(n_slc)[None, :] * SLC_BLOCK
    overlap = ((ci < sj + SLC_BLOCK) & (ci + CMP_BLOCK > sj)).astype(F32)
    imp = jnp.einsum('bghtn,nj->bgtj', p_cmp, overlap)
    blk = jnp.arange(n_slc)[None, :]
    cur = (tpos // SLC_BLOCK)[:, None]
    forced = (blk == 0) | (blk == cur) | (blk == cur - 1)
    score = jnp.where(forced, FORCE, jnp.where(blk <= cur, imp, -FORCE))
    _, idx = lax.top_k(score, n_sel)

    ks = jnp.moveaxis(k_s.reshape(b, n_slc, SLC_BLOCK, g, dh), 3, 1)
    vs = jnp.moveaxis(v_s.reshape(b, n_slc, SLC_BLOCK, g, dh), 3, 1)
    nqb = t // SLC_QUERY_BLOCK
    q_blocks = jnp.moveaxis(q.reshape(b, nqb, SLC_QUERY_BLOCK, g, hg, dh), 1, 0)
    idx_blocks = jnp.moveaxis(idx.reshape(b, g, nqb, SLC_QUERY_BLOCK, n_sel), 2, 0)
    starts = jnp.arange(nqb) * SLC_QUERY_BLOCK
    bi = jnp.arange(b)[:, None, None, None]
    gi = jnp.arange(g)[None, :, None, None]

    def sel_block(args):
        qb, ib, start = args
        kg = ks[bi, gi, ib]
        vg = vs[bi, gi, ib]
        sc = jnp.einsum('bqghd,bgqnkd->bghqnk', qb, kg, preferred_element_type=F32) * scale
        kpos = ib[..., None] * SLC_BLOCK + jnp.arange(SLC_BLOCK)
        qpos = start + jnp.arange(SLC_QUERY_BLOCK)
        valid = (kpos <= qpos[None, None, :, None, None])[:, :, None]
        sc = sc.reshape(b, g, hg, SLC_QUERY_BLOCK, n_sel * SLC_BLOCK)
        valid = valid.reshape(b, g, 1, SLC_QUERY_BLOCK, n_sel * SLC_BLOCK)
        p = masked_softmax(sc, valid).reshape(b, g, hg, SLC_QUERY_BLOCK, n_sel, SLC_BLOCK)
        return jnp.einsum('bghqnk,bgqnkd->bqghd', p, vg.astype(F32)).astype(qb.dtype)

    o_slc = lax.map(sel_block, (q_blocks, idx_blocks, starts))
    o_slc = jnp.moveaxis(o_slc, 0, 1).reshape(b, t, g, hg, dh)

    o_win = banded_attention(q, k_w, v_w, NSA_WINDOW)

    gates = jax.nn.sigmoid(gate_logits.reshape(b, t, 3, g, hg))[..., None]
    o = gates[:, :, 0] * o_cmp + gates[:, :, 1] * o_slc + gates[:, :, 2] * o_win
    return o.reshape(b, t, NSA_WIDTH)


def swa_sink_attention(q, kv, sinks):
    b, t, _ = q.shape
    g, hg = SWA_KV_HEADS, SWA_HEADS // SWA_KV_HEADS
    q = q.reshape(b, t, g, hg, HEAD_DIM)
    kv = kv.reshape(b, t, 2, g, HEAD_DIM)
    o = banded_attention(q, kv[:, :, 0], kv[:, :, 1], SWA_WINDOW, sinks.reshape(g, hg))
    return o.reshape(b, t, SWA_WIDTH)


def token_shift(z, mu):
    prev = jnp.pad(z, ((0, 0), (1, 0), (0, 0)))[:, :-1]
    return z + (prev - z) * mu


def rwkv7_step(state, inp):
    r, w, k, v, a, bb = inp
    sa = jnp.einsum('bhvk,bhk->bhv', state, a)
    state = state * w[:, :, None, :] + sa[..., None] * bb[:, :, None, :] + v[..., None] * k[:, :, None, :]
    return state, jnp.einsum('bhvk,bhk->bhv', state, r)


def rwkv7_time_mix(feat, v_first, mu, w0, w2, a0, a2, k_k, k_a, r_k, ln_w, ln_b, v_res):
    b, t, _ = feat.shape
    h, n, c = RWKV_HEADS, HEAD_DIM, RWKV_WIDTH
    xs = token_shift(feat, mu)
    r = xs[..., :c]
    k = xs[..., c:2 * c]
    v = xs[..., 2 * c:3 * c]
    wd = xs[..., 3 * c:3 * c + DECAY_LORA]
    ad = xs[..., 3 * c + DECAY_LORA:]
    w = -jax.nn.softplus(-(w0 + jnp.tanh(wd) @ w2)) - 0.5
    decay = jnp.exp(-jnp.exp(w.astype(F32)))
    if v_res is None:
        v_first = v
    else:
        v0, v1, v2 = v_res
        v = v + (v_first - v) * jax.nn.sigmoid(v0 + (v @ v1) @ v2)
    a = jax.nn.sigmoid(a0 + ad @ a2)
    kk = (k * k_k).reshape(b, t, h, n).astype(F32)
    kk = kk / jnp.maximum(jnp.sqrt(jnp.sum(kk * kk, axis=-1, keepdims=True)), 1e-12)
    k = k * (1.0 + (a - 1.0) * k_a)

    def heads(z):
        return z.reshape(b, t, h, n).astype(F32)

    r_h, k_h, v_h, a_h, w_h = heads(r), heads(k), heads(v), heads(a), heads(decay)
    seq_in = tuple(jnp.moveaxis(z, 1, 0) for z in (r_h, w_h, k_h, v_h, -kk, kk * a_h))
    state0 = jnp.zeros((b, h, n, n), F32)
    _, ys = lax.scan(rwkv7_step, state0, seq_in)
    y = jnp.moveaxis(ys, 0, 1)
    mean = jnp.mean(y, axis=-1, keepdims=True)
    var = jnp.mean(jnp.square(y - mean), axis=-1, keepdims=True)
    y = (y - mean) * lax.rsqrt(var + GN_EPS) * ln_w.astype(F32).reshape(h, n) + ln_b.astype(F32).reshape(h, n)
    y = y + jnp.sum(r_h * k_h * r_k.astype(F32), axis=-1, keepdims=True) * v_h
    return y.reshape(b, t, c).astype(feat.dtype), v_first


def setup_inputs(seed: int = 0) -> dict:
    key = jax.random.key(seed)
    keys = iter(jax.random.split(key, 40))
    L = DEPTH
    C = RWKV_WIDTH

    def nrm(shape, scale):
        return jax.random.normal(next(keys), shape, F32) * scale

    return {
        "x": nrm((BATCH, SEQ, D_MODEL), 1.0),
        "norm_g": 1.0 + nrm((L, D_MODEL), 0.02),
        "w_in": nrm((L, D_MODEL, N_IN), D_MODEL ** -0.5),
        "b_merge": nrm((L, N_BRANCHES, D_MODEL), 0.02),
        "cmp_pe_k": nrm((L, CMP_BLOCK, HEAD_DIM), 0.1),
        "cmp_w1_k": nrm((L, CMP_BLOCK * HEAD_DIM, CMP_HIDDEN), (CMP_BLOCK * HEAD_DIM) ** -0.5),
        "cmp_w2_k": nrm((L, CMP_HIDDEN, HEAD_DIM), CMP_HIDDEN ** -0.5),
        "cmp_pe_v": nrm((L, CMP_BLOCK, HEAD_DIM), 0.1),
        "cmp_w1_v": nrm((L, CMP_BLOCK * HEAD_DIM, CMP_HIDDEN), (CMP_BLOCK * HEAD_DIM) ** -0.5),
        "cmp_w2_v": nrm((L, CMP_HIDDEN, HEAD_DIM), CMP_HIDDEN ** -0.5),
        "swa_sinks": nrm((L, SWA_HEADS), 0.5),
        "rwkv_mu": jax.random.uniform(next(keys), (L, RWKV_SHIFT_WIDTH), F32),
        "rwkv_w0": jax.random.uniform(next(keys), (L, C), F32, -6.0, -1.0),
        "rwkv_w2": nrm((L, DECAY_LORA, C), 0.5 * DECAY_LORA ** -0.5),
        "rwkv_a0": nrm((L, C), 0.5),
        "rwkv_a2": nrm((L, ICLR_LORA, C), 0.5 * ICLR_LORA ** -0.5),
        "rwkv_k_k": 0.85 + nrm((L, C), 0.02),
        "rwkv_k_a": 1.0 + nrm((L, C), 0.02),
        "rwkv_r_k": nrm((L, RWKV_HEADS, HEAD_DIM), 0.1),
        "rwkv_ln_w": 1.0 + nrm((L, C), 0.02),
        "rwkv_ln_b": nrm((L, C), 0.02),
        "rwkv_v0": nrm((L - 1, C), 0.5),
        "rwkv_v1": nrm((L - 1, C, VRES_LORA), C ** -0.5),
        "rwkv_v2": nrm((L - 1, VRES_LORA, C), 0.5 * VRES_LORA ** -0.5),
        "proj_a": nrm((L, NSA_WIDTH, D_MODEL), NSA_WIDTH ** -0.5),
        "proj_b": nrm((L, SWA_WIDTH, D_MODEL), SWA_WIDTH ** -0.5),
        "proj_c": nrm((L, RWKV_WIDTH, D_MODEL), RWKV_WIDTH ** -0.5),
        "w_out": nrm((L, D_MODEL, D_MODEL), D_MODEL ** -0.5),
        "final_g": 1.0 + nrm((D_MODEL,), 0.02),
    }


def reference(x, norm_g, w_in, b_merge, cmp_pe_k, cmp_w1_k, cmp_w2_k, cmp_pe_v, cmp_w1_v, cmp_w2_v,
              swa_sinks, rwkv_mu, rwkv_w0, rwkv_w2, rwkv_a0, rwkv_a2, rwkv_k_k, rwkv_k_a, rwkv_r_k,
              rwkv_ln_w, rwkv_ln_b, rwkv_v0, rwkv_v1, rwkv_v2, proj_a, proj_b, proj_c, w_out, final_g):
    b, t, d = x.shape
    v_first = None
    for l in range(DEPTH):
        xn = rms_norm(x, norm_g[l])
        cols = split_columns(xn @ w_in[l])
        y_a = nsa_attention(cols["a_q"], cols["a_kv_cmp"], cols["a_kv_slc"], cols["a_kv_win"], cols["a_gate"],
                            cmp_pe_k[l], cmp_w1_k[l], cmp_w2_k[l], cmp_pe_v[l], cmp_w1_v[l], cmp_w2_v[l])
        y_a = y_a * jax.nn.silu(cols["a_z"])
        y_b = swa_sink_attention(cols["b_q"], cols["b_kv"], swa_sinks[l]) * jax.nn.silu(cols["b_z"])
        v_res = None if l == 0 else (rwkv_v0[l - 1], rwkv_v1[l - 1], rwkv_v2[l - 1])
        y_c, v_first = rwkv7_time_mix(cols["c_shift"], v_first, rwkv_mu[l], rwkv_w0[l], rwkv_w2[l],
                                      rwkv_a0[l], rwkv_a2[l], rwkv_k_k[l], rwkv_k_a[l], rwkv_r_k[l],
                                      rwkv_ln_w[l], rwkv_ln_b[l], v_res)
        y_c = y_c * jax.nn.silu(cols["c_z"])
        gates = jax.nn.sigmoid(cols["merge"].reshape(b, t, N_BRANCHES, d) + b_merge[l])
        mixed = (gates[:, :, 0] * (y_a @ proj_a[l])
                 + gates[:, :, 1] * (y_b @ proj_b[l])
                 + gates[:, :, 2] * (y_c @ proj_c[l]))
        x = x + mixed @ w_out[l]
    return rms_norm(x, final_g)
```

```cpp
#include <hip/hip_runtime.h>
#include <hip/hip_cooperative_groups.h>
#include <cstdio>
namespace cg = cooperative_groups;

#define DI __device__ __forceinline__
typedef unsigned short bf16_t;
typedef short bf16x8 __attribute__((ext_vector_type(8)));
typedef short s16x4 __attribute__((ext_vector_type(4)));
typedef float f32x16 __attribute__((ext_vector_type(16)));
typedef __bf16 bfv2 __attribute__((ext_vector_type(2)));
typedef float fv2 __attribute__((ext_vector_type(2)));
#define MFMA32(a, b, c) __builtin_amdgcn_mfma_f32_32x32x16_bf16((a), (b), (c), 0, 0, 0)

DI unsigned pack2(float a, float b) { fv2 v = {a, b}; return __builtin_bit_cast(unsigned, __builtin_convertvector(v, bfv2)); }
DI bf16_t f2bf(float a) { return (bf16_t)(pack2(a, 0.f) & 0xffffu); }
DI float bflo(unsigned u) { return __uint_as_float(u << 16); }
DI float bfhi(unsigned u) { return __uint_as_float(u & 0xffff0000u); }
DI float bf2f(bf16_t u) { return __uint_as_float(((unsigned)u) << 16); }
DI float sigmoidf_(float x) { return 1.f / (1.f + __expf(-x)); }
DI float siluf_(float x) { return x / (1.f + __expf(-x)); }
DI int tidx() { int t = threadIdx.x; asm volatile("" : "+v"(t)); return t; }
DI int bidx() { int b = blockIdx.x; asm volatile("" : "+s"(b)); return b; }
DI int crow(int i, int h) { return (i & 3) + 8 * (i >> 2) + 4 * h; }

constexpr int T_ = 2048, NTOK = 16384, HS = 3840, NIN = 6808;
constexpr int C_AQ = 0, C_KC = 512, C_VC = 640, C_KS = 768, C_KW = 1024, C_AZ = 1280, C_BQ = 1792, C_BK = 2048,
              C_BZ = 2304, C_R = 2560, C_K = 2816, C_V = 3072, C_WD = 3328, C_CZ = 3456, C_GATE = 3712;

constexpr size_t al256(size_t x) { return (x + 255) & ~(size_t)255; }
constexpr size_t O_WTA = 0;
constexpr size_t O_WTM = O_WTA + (size_t)3840 * 1024 * 2;
constexpr size_t O_WTP = O_WTM + (size_t)3072 * 1024 * 2;
constexpr size_t O_WTO = O_WTP + (size_t)1024 * 1024 * 2;
constexpr size_t O_W1K = O_WTO + (size_t)1024 * 1024 * 2;
constexpr size_t O_W1V = O_W1K + (size_t)128 * 2048 * 2;
constexpr size_t O_W2K = O_W1V + (size_t)128 * 2048 * 2;
constexpr size_t O_W2V = O_W2K + (size_t)64 * 128 * 2;
constexpr size_t O_PEB = O_W2V + (size_t)64 * 128 * 2;
constexpr size_t O_LW2 = O_PEB + 1024;
constexpr size_t O_LA2 = O_LW2 + 256 * 64 * 2;
constexpr size_t O_V1T = O_LA2 + 256 * 64 * 2;
constexpr size_t O_V2T = O_V1T + 32 * 256 * 2;
constexpr size_t O_CNT = O_V2T + 256 * 32 * 2;
constexpr size_t O_BAR = O_CNT + 256;
constexpr size_t O_XN = O_BAR + 16384;
constexpr size_t O_H = O_XN + (size_t)NTOK * 1024 * 2;
constexpr size_t O_VT = O_H + (size_t)NTOK * HS * 2;
constexpr size_t O_KC = O_VT + (size_t)3 * 8 * 2 * 64 * 2048 * 2;
constexpr size_t O_VCT = O_KC + (size_t)16 * 128 * 64 * 2;
constexpr size_t O_VF = O_VCT + (size_t)16 * 128 * 64 * 2;
constexpr size_t O_YR = O_VF + (size_t)NTOK * 256 * 2;
constexpr size_t O_BON = O_YR + (size_t)NTOK * 256 * 2;
constexpr size_t O_PR = O_BON + (size_t)NTOK * 4 * 4;
constexpr size_t WS_TOTAL = O_PR + (size_t)NTOK * 4 * 384 * 2;

#ifndef PROBE
#define PROBE 0
#endif
struct Params {
  const float* in[29];
  float* out;
  char* ws;
};

constexpr int SMEM_BYTES = 73728;
constexpr int LDT = 72;

#define G_LOAD(P, ao_, bo_) do { const long ao__ = (ao_); const int bo__ = (bo_); \
  P##a0 = *(const uint4*)(a0 + ao__); P##a1 = *(const uint4*)(a1 + ao__); P##a2 = *(const uint4*)(a2 + ao__); P##a3 = *(const uint4*)(a3 + ao__); \
  P##b0 = *(const uint4*)(b0 + bo__); P##b1 = *(const uint4*)(b1 + bo__); P##b2 = *(const uint4*)(b2 + bo__); P##b3 = *(const uint4*)(b3 + bo__); } while (0)
#define G_STORE(P, A_, B_) do { bf16_t* A__ = (A_); bf16_t* B__ = (B_); \
  *(uint4*)(A__ + (wr)*LDT + wc) = P##a0; *(uint4*)(A__ + (wr + 32) * LDT + wc) = P##a1; \
  *(uint4*)(A__ + (wr + 64) * LDT + wc) = P##a2; *(uint4*)(A__ + (wr + 96) * LDT + wc) = P##a3; \
  *(uint4*)(B__ + (wr)*LDT + wc) = P##b0; *(uint4*)(B__ + (wr + 32) * LDT + wc) = P##b1; \
  *(uint4*)(B__ + (wr + 64) * LDT + wc) = P##b2; *(uint4*)(B__ + (wr + 96) * LDT + wc) = P##b3; } while (0)
DI void g_compute(f32x16 (&acc)[2][2], const bf16_t* A_, const bf16_t* B_) {
  __builtin_amdgcn_s_setprio(1);
#pragma unroll
  for (int s = 0; s < 4; ++s) {
    bf16x8 fa0 = *(const bf16x8*)(A_ + 16 * s);
    bf16x8 fa1 = *(const bf16x8*)(A_ + 32 * LDT + 16 * s);
    bf16x8 fb0 = *(const bf16x8*)(B_ + 16 * s);
    bf16x8 fb1 = *(const bf16x8*)(B_ + 32 * LDT + 16 * s);
    acc[0][0] = MFMA32(fa0, fb0, acc[0][0]);
    acc[0][1] = MFMA32(fa0, fb1, acc[0][1]);
    acc[1][0] = MFMA32(fa1, fb0, acc[1][0]);
    acc[1][1] = MFMA32(fa1, fb1, acc[1][1]);
  }
  __builtin_amdgcn_s_setprio(0);
}
DI void gemm_core(f32x16 (&acc)[2][2], const bf16_t* a0, const bf16_t* a1, const bf16_t* a2, const bf16_t* a3, long aks,
                  const bf16_t* b0, const bf16_t* b1, const bf16_t* b2, const bf16_t* b3, int KT, bf16_t* sm) {
  const int tid = tidx(), lane = tid & 63, w = tid >> 6, wm = w >> 1, wn = w & 1, h = lane >> 5, r31 = lane & 31;
  bf16_t* As = sm;
  bf16_t* Bs = sm + 2 * 128 * LDT;
  const int wr = (tid >> 3), wc = (tid & 7) * 8;
#pragma unroll
  for (int i = 0; i < 2; ++i)
#pragma unroll
    for (int j = 0; j < 2; ++j)
#pragma unroll
      for (int e = 0; e < 16; ++e) acc[i][j][e] = 0.f;
  uint4 pa0, pa1, pa2, pa3, pb0, pb1, pb2, pb3, qa0, qa1, qa2, qa3, qb0, qb1, qb2, qb3;
  G_LOAD(p, 0, 0);
  G_LOAD(q, aks, 64);
  __syncthreads();
  G_STORE(p, As, Bs);
  __syncthreads();
  const int aoff = (wm * 64 + r31) * LDT + 8 * h, boff = (wn * 64 + r31) * LDT + 8 * h;
  for (int kt = 0; kt < KT; kt += 2) {
    if (kt + 2 < KT) G_LOAD(p, (long)(kt + 2) * aks, (kt + 2) * 64);
    __builtin_amdgcn_sched_barrier(0);
    g_compute(acc, As + aoff, Bs + boff);
    G_STORE(q, As + 128 * LDT, Bs + 128 * LDT);
    __syncthreads();
    if (kt + 3 < KT) G_LOAD(q, (long)(kt + 3) * aks, (kt + 3) * 64);
    __builtin_amdgcn_sched_barrier(0);
    g_compute(acc, As + 128 * LDT + aoff, Bs + 128 * LDT + boff);
    if (kt + 2 < KT) G_STORE(p, As, Bs);
    __syncthreads();
  }
}

DI void gemm_plain(f32x16 (&acc)[2][2], const bf16_t* A, long lda, int m0, const bf16_t* Bt, long ldb, int n0, int K, bf16_t* sm) {
  const int tid = tidx(), wr = tid >> 3, wc = (tid & 7) * 8;
  const bf16_t* a0 = A + (long)(m0 + wr) * lda + wc;
  const bf16_t* b0 = Bt + (long)(n0 + wr) * ldb + wc;
  gemm_core(acc, a0, a0 + 32 * lda, a0 + 64 * lda, a0 + 96 * lda, 64, b0, b0 + 32 * ldb, b0 + 64 * ldb, b0 + 96 * ldb, K >> 6, sm);
}


template <int NT, int CS>
DI bool xcd_tile(int round, int& mt, int& nt) {
  const int xcd = bidx() & 7, local = bidx() >> 3, nlocal = gridDim.x >> 3;
  const int q = local + round * nlocal;
  if (q >= 16 * NT) return false;
  const int rg = q / (8 * NT), rem = q - rg * 8 * NT;
  const int cg = rem / (8 * CS), rem2 = rem - cg * 8 * CS;
  const int c = rem2 >> 3, r = rem2 & 7;
  mt = xcd + 8 * (rg * 8 + r);
  nt = cg * CS + c;
  return true;
}

struct TJob { const float* src; int ld; int mode; bf16_t* dst; int ldd; int ntn; int ntk; };

DI TJob get_job(int j, const Params& p, int l) {
  char* ws = p.ws;
  TJob t;
  switch (j) {
    case 0: t = {p.in[2] + (size_t)l * 1024 * NIN, NIN, 1, (bf16_t*)(ws + O_WTA), 1024, 60, 16}; break;
    case 1: t = {p.in[2] + (size_t)l * 1024 * NIN + 3736, NIN, 0, (bf16_t*)(ws + O_WTM), 1024, 48, 16}; break;
    case 2: t = {p.in[24] + (size_t)l * 512 * 1024, 1024, 0, (bf16_t*)(ws + O_WTP), 1024, 16, 8}; break;
    case 3: t = {p.in[25] + (size_t)l * 256 * 1024, 1024, 0, (bf16_t*)(ws + O_WTP) + 512, 1024, 16, 4}; break;
    case 4: t = {p.in[26] + (size_t)l * 256 * 1024, 1024, 0, (bf16_t*)(ws + O_WTP) + 768, 1024, 16, 4}; break;
    case 5: t = {p.in[27] + (size_t)l * 1024 * 1024, 1024, 0, (bf16_t*)(ws + O_WTO), 1024, 16, 16}; break;
    case 6: t = {p.in[5] + (size_t)l * 2048 * 128, 128, 0, (bf16_t*)(ws + O_W1K), 2048, 2, 32}; break;
    case 7: t = {p.in[8] + (size_t)l * 2048 * 128, 128, 0, (bf16_t*)(ws + O_W1V), 2048, 2, 32}; break;
    case 8: t = {p.in[6] + (size_t)l * 128 * 64, 64, 0, (bf16_t*)(ws + O_W2K), 128, 1, 2}; break;
    case 9: t = {p.in[9] + (size_t)l * 128 * 64, 64, 0, (bf16_t*)(ws + O_W2V), 128, 1, 2}; break;
    case 10: t = {p.in[13] + (size_t)l * 64 * 256, 256, 0, (bf16_t*)(ws + O_LW2), 64, 4, 1}; break;
    default: t = {p.in[15] + (size_t)l * 64 * 256, 256, 0, (bf16_t*)(ws + O_LA2), 64, 4, 1}; break;
  }
  return t;
}

DI void transpose_tile(const TJob& jb, int n0, int k0, float* tile) {
  const int tid = tidx();
  const int n4 = (tid & 15) * 4;
  const int c = n0 + n4;
  int oc = c; bool valid = true;
  if (jb.mode == 1) {
    if (c < 1280) oc = c; else if (c < 3712) oc = c + 24; else if (c < 3736) oc = c - 3712 + 1280; else { oc = 0; valid = false; }
  }
#pragma unroll
  for (int pz = 0; pz < 4; ++pz) {
    const int kk = (tid >> 4) + 16 * pz;
    float4 v = make_float4(0.f, 0.f, 0.f, 0.f);
    if (valid) v = *(const float4*)(jb.src + (size_t)(k0 + kk) * jb.ld + oc);
    tile[kk * 65 + n4 + 0] = v.x; tile[kk * 65 + n4 + 1] = v.y; tile[kk * 65 + n4 + 2] = v.z; tile[kk * 65 + n4 + 3] = v.w;
  }
  __syncthreads();
#pragma unroll
  for (int pz = 0; pz < 2; ++pz) {
    const int q = tid + 256 * pz;
    const int nn = q >> 3, kc = (q & 7) * 8;
    uint4 o;
    o.x = pack2(tile[(kc + 0) * 65 + nn], tile[(kc + 1) * 65 + nn]);
    o.y = pack2(tile[(kc + 2) * 65 + nn], tile[(kc + 3) * 65 + nn]);
    o.z = pack2(tile[(kc + 4) * 65 + nn], tile[(kc + 5) * 65 + nn]);
    o.w = pack2(tile[(kc + 6) * 65 + nn], tile[(kc + 7) * 65 + nn]);
    *(uint4*)(jb.dst + (size_t)(n0 + nn) * jb.ldd + k0 + kc) = o;
  }
  __syncthreads();
}

DI float wave_sum(float v) {
#pragma unroll
  for (int o = 32; o > 0; o >>= 1) v += __shfl_xor(v, o, 64);
  return v;
}

DI void rmsnorm_rows(const float* x, const float* g, bf16_t* outb, float* outf) {
  const int lane = tidx() & 63, w = tidx() >> 6;
  for (int it = bidx(); it < NTOK / 4; it += gridDim.x) {
    const int row = it * 4 + w;
    const float* xr = x + (size_t)row * 1024;
    float4 v[4]; float ss = 0.f;
#pragma unroll
    for (int i = 0; i < 4; ++i) { v[i] = *(const float4*)(xr + lane * 4 + 256 * i); ss += v[i].x * v[i].x + v[i].y * v[i].y + v[i].z * v[i].z + v[i].w * v[i].w; }
    ss = wave_sum(ss);
    const float rs = rsqrtf(ss * (1.f / 1024.f) + 1e-6f);
#pragma unroll
    for (int i = 0; i < 4; ++i) {
      const float4 gg = *(const float4*)(g + lane * 4 + 256 * i);
      const float o0 = v[i].x * rs * gg.x, o1 = v[i].y * rs * gg.y, o2 = v[i].z * rs * gg.z, o3 = v[i].w * rs * gg.w;
      if (outf) { *(float4*)(outf + (size_t)row * 1024 + lane * 4 + 256 * i) = make_float4(o0, o1, o2, o3); }
      else { uint2 o; o.x = pack2(o0, o1); o.y = pack2(o2, o3); *(uint2*)(outb + (size_t)row * 1024 + lane * 4 + 256 * i) = o; }
    }
  }
}

DI void phase0(const Params& p, int l, char* smraw) {
  float* tile = (float*)smraw;
  for (int id = bidx(); id < 2380; id += gridDim.x) {
    int rem = id;
    for (int j = 0; j < 12; ++j) {
      TJob jb = get_job(j, p, l);
      const int cnt = jb.ntn * jb.ntk;
      if (rem < cnt) { transpose_tile(jb, (rem / jb.ntk) * 64, (rem % jb.ntk) * 64, tile); break; }
      rem -= cnt;
    }
  }
  const float* xin = (l == 0) ? p.in[0] : p.out;
  rmsnorm_rows(xin, p.in[1] + l * 1024, (bf16_t*)(p.ws + O_XN), nullptr);
  const int gtid = bidx() * 256 + tidx(), nth = gridDim.x * 256;
  if (l == 1) {
    bf16_t* v1t = (bf16_t*)(p.ws + O_V1T); bf16_t* v2t = (bf16_t*)(p.ws + O_V2T);
    const float* v1 = p.in[22]; const float* v2 = p.in[23];
    for (int idx = gtid; idx < 8192; idx += nth) {
      { const int j = idx >> 8, c = idx & 255; v1t[idx] = f2bf(v1[c * 32 + j]); }
      { const int c = idx >> 5, j = idx & 31; v2t[idx] = f2bf(v2[j * 256 + c]); }
    }
  }
  {
    bf16_t* kc = (bf16_t*)(p.ws + O_KC); bf16_t* vct = (bf16_t*)(p.ws + O_VCT);
    for (int idx = gtid; idx < 1024; idx += nth) {
      const int bg = idx >> 6, d = idx & 63;
      kc[(bg * 128 + 127) * 64 + d] = 0; vct[(bg * 64 + d) * 128 + 127] = 0;
    }
    if (gtid == 0) { ((int*)(p.ws + O_CNT))[l] = 0; }
    if (gtid < 32) { ((int*)(p.ws + O_CNT))[8 + gtid] = 0; }
  }
  {
    const int lane = tidx() & 63, gw = bidx() * 4 + (tidx() >> 6), nw = gridDim.x * 4;
    float* peb = (float*)(p.ws + O_PEB);
    for (int o = gw; o < 256; o += nw) {
      const int which = o >> 7, n = o & 127;
      const float* pe = (which ? p.in[7] : p.in[4]) + (size_t)l * 2048;
      const float* w1 = (which ? p.in[8] : p.in[5]) + (size_t)l * 2048 * 128;
      float s = 0.f;
      for (int k = lane; k < 2048; k += 64) s += pe[k] * w1[(size_t)k * 128 + n];
      s = wave_sum(s);
      if (lane == 0) peb[o] = s;
    }
  }
}

DI void phase1(const Params& p, char* smraw) {
  bf16_t* sm = (bf16_t*)smraw;
  const bf16_t* xn = (const bf16_t*)(p.ws + O_XN);
  const bf16_t* wta = (const bf16_t*)(p.ws + O_WTA);
  bf16_t* hb = (bf16_t*)(p.ws + O_H);
  bf16_t* vt = (bf16_t*)(p.ws + O_VT);
  const int lane = tidx() & 63, w = tidx() >> 6, wm = w >> 1, wn = w & 1, h = lane >> 5, r31 = lane & 31;
  for (int round = 0;; ++round) {
    int mt, nt;
    if (!xcd_tile<30, 6>(round, mt, nt)) break;
    f32x16 acc[2][2];
    gemm_plain(acc, xn, 1024, mt * 128, wta, 1024, nt * 128, 1024, sm);
    const int which = (nt == 7) ? 0 : (nt == 9) ? 1 : (nt == 17) ? 2 : -1;
    if (which < 0) {
#pragma unroll
      for (int i = 0; i < 2; ++i)
#pragma unroll
        for (int j = 0; j < 2; ++j) {
          const int n = nt * 128 + wn * 64 + 32 * j + r31;
#pragma unroll
          for (int e = 0; e < 16; ++e) {
            const int m = mt * 128 + wm * 64 + 32 * i + crow(e, h);
            hb[(size_t)m * HS + n] = f2bf(acc[i][j][e]);
          }
        }
    } else {
#pragma unroll
      for (int i = 0; i < 2; ++i)
#pragma unroll
        for (int j = 0; j < 2; ++j) {
          const int nl = wn * 64 + 32 * j + r31;
#pragma unroll
          for (int q = 0; q < 4; ++q) {
            const int m = mt * 128 + wm * 64 + 32 * i + 8 * q + 4 * h;
            const int b = m >> 11, t = m & 2047;
            uint2 o; o.x = pack2(acc[i][j][4 * q], acc[i][j][4 * q + 1]); o.y = pack2(acc[i][j][4 * q + 2], acc[i][j][4 * q + 3]);
            *(uint2*)(vt + ((size_t)((which * 8 + b) * 128 + nl)) * 2048 + t) = o;
          }
        }
    }
  }
}

DI void compress_tile(const Params& p, int item, char* smraw, int* s_flag) {
  const int ks = item & 3, mt = (item >> 2) & 15, which = item >> 6;
  bf16_t* sm = (bf16_t*)smraw;
  const bf16_t* hb = (const bf16_t*)(p.ws + O_H);
  const bf16_t* w1t = (const bf16_t*)(p.ws + (which ? O_W1V : O_W1K));
  const bf16_t* w2t = (const bf16_t*)(p.ws + (which ? O_W2V : O_W2K));
  const float* peb = (const float*)(p.ws + O_PEB) + which * 128;
  const int tid = tidx(), lane = tid & 63, w = tid >> 6, wm = w >> 1, wn = w & 1, h = lane >> 5, r31 = lane & 31;
  const int wr = tid >> 3, wc = (tid & 7) * 8;
  const int col0 = which ? C_VC : C_KC;
  const bf16_t* ap[4];
#pragma unroll
  for (int i = 0; i < 4; ++i) {
    int m = mt * 128 + wr + 32 * i; if (m >= 2032) m = 0;
    const int b = m / 254, rem = m - b * 254, n = rem >> 1, g = rem & 1;
    ap[i] = hb + ((size_t)(b * 2048 + 16 * n + 8 * ks)) * HS + col0 + g * 64 + wc;
  }
  const bf16_t* b0 = w1t + (size_t)wr * 2048 + wc + ks * 512;
  f32x16 acc[2][2];
  gemm_core(acc, ap[0], ap[1], ap[2], ap[3], HS, b0, b0 + 32 * 2048, b0 + 64 * 2048, b0 + 96 * 2048, 8, sm);
  float4* scr = (float4*)(p.ws + O_YR) + (size_t)((which * 16 + mt) * 4) * 4096;
#pragma unroll
  for (int i = 0; i < 2; ++i)
#pragma unroll
    for (int j = 0; j < 2; ++j)
#pragma unroll
      for (int q = 0; q < 4; ++q)
        scr[(size_t)ks * 4096 + ((i * 2 + j) * 4 + q) * 256 + tid] = make_float4(acc[i][j][4 * q], acc[i][j][4 * q + 1], acc[i][j][4 * q + 2], acc[i][j][4 * q + 3]);
  __threadfence();
  __syncthreads();
  if (tid == 0) *s_flag = atomicAdd((int*)(p.ws + O_CNT) + 8 + which * 16 + mt, 1);
  __syncthreads();
  const bool last = (*s_flag == 3);
  __syncthreads();
  if (!last) return;
  __threadfence();
  bf16_t* Hs = sm;
#pragma unroll
  for (int i = 0; i < 2; ++i)
#pragma unroll
    for (int j = 0; j < 2; ++j) {
      const int n = wn * 64 + 32 * j + r31;
      const float bias = peb[n];
#pragma unroll
      for (int q = 0; q < 4; ++q) {
        const int o = ((i * 2 + j) * 4 + q) * 256 + tid;
        const float4 p0 = scr[o], p1 = scr[4096 + o], p2 = scr[2 * 4096 + o], p3 = scr[3 * 4096 + o];
        const float v0 = ((p0.x + p1.x) + p2.x) + p3.x, v1 = ((p0.y + p1.y) + p2.y) + p3.y;
        const float v2 = ((p0.z + p1.z) + p2.z) + p3.z, v3 = ((p0.w + p1.w) + p2.w) + p3.w;
        const int r = wm * 64 + 32 * i + 8 * q + 4 * h;
        Hs[(r + 0) * 136 + n] = f2bf(siluf_(v0 + bias));
        Hs[(r + 1) * 136 + n] = f2bf(siluf_(v1 + bias));
        Hs[(r + 2) * 136 + n] = f2bf(siluf_(v2 + bias));
        Hs[(r + 3) * 136 + n] = f2bf(siluf_(v3 + bias));
      }
    }
  __syncthreads();
  f32x16 o2[2];
#pragma unroll
  for (int j = 0; j < 2; ++j)
#pragma unroll
    for (int e = 0; e < 16; ++e) o2[j][e] = 0.f;
#pragma unroll
  for (int s = 0; s < 8; ++s) {
    const bf16x8 fa = *(const bf16x8*)(Hs + (w * 32 + r31) * 136 + 16 * s + 8 * h);
#pragma unroll
    for (int j = 0; j < 2; ++j) {
      const bf16x8 fb = *(const bf16x8*)(w2t + (32 * j + r31) * 128 + 16 * s + 8 * h);
      o2[j] = MFMA32(fa, fb, o2[j]);
    }
  }
  bf16_t* kc = (bf16_t*)(p.ws + O_KC); bf16_t* vct = (bf16_t*)(p.ws + O_VCT);
#pragma unroll
  for (int j = 0; j < 2; ++j) {
    const int d = 32 * j + r31;
#pragma unroll
    for (int e = 0; e < 16; ++e) {
      const int m = mt * 128 + w * 32 + crow(e, h);
      if (m < 2032) {
        const int b = m / 254, rem = m - b * 254, n = rem >> 1, g = rem & 1;
        if (which == 0) kc[((size_t)((b * 2 + g) * 128 + n)) * 64 + d] = f2bf(o2[j][e]);
        else vct[((size_t)((b * 2 + g) * 64 + d)) * 128 + n] = f2bf(o2[j][e]);
      }
    }
  }
  __syncthreads();
}

DI void rwkv_prep(const Params& p, int l, int item, char* smraw) {
  const bf16_t* hb = (const bf16_t*)(p.ws + O_H);
  bf16_t* A1 = (bf16_t*)smraw;
  bf16_t* A2 = A1 + 64 * LDT;
  bf16_t* A3 = A2 + 64 * LDT;
  const int tid = tidx(), lane = tid & 63, w = tid >> 6, h = lane >> 5, r31 = lane & 31;
  const int T0 = item * 32;
  const float* mu = p.in[11] + l * 896;
  __syncthreads();
  for (int idx = tid; idx < 32 * 16; idx += 256) {
    const int tok = idx >> 4, c8 = idx & 15;
    const size_t m = (size_t)(T0 + tok);
    const uint4 z = *(const uint4*)(hb + m * HS + C_WD + c8 * 8);
    uint4 zp = make_uint4(0, 0, 0, 0);
    if (((T0 + tok) & 2047) != 0) zp = *(const uint4*)(hb + (m - 1) * HS + C_WD + c8 * 8);
    const unsigned zz[4] = {z.x, z.y, z.z, z.w}, pp[4] = {zp.x, zp.y, zp.z, zp.w};
    unsigned oo[4];
#pragma unroll
    for (int e = 0; e < 4; ++e) {
      const float m0 = mu[768 + c8 * 8 + 2 * e], m1 = mu[768 + c8 * 8 + 2 * e + 1];
      float x0 = bflo(zz[e]), x1 = bfhi(zz[e]);
      x0 = x0 + (bflo(pp[e]) - x0) * m0; x1 = x1 + (bfhi(pp[e]) - x1) * m1;
      if (c8 < 8) { x0 = 1.f - 2.f / (__expf(2.f * x0) + 1.f); x1 = 1.f - 2.f / (__expf(2.f * x1) + 1.f); }
      oo[e] = pack2(x0, x1);
    }
    bf16_t* dst = (c8 < 8) ? (A1 + tok * LDT + c8 * 8) : (A2 + tok * LDT + (c8 - 8) * 8);
    *(uint4*)dst = make_uint4(oo[0], oo[1], oo[2], oo[3]);
  }
  if (l == 1) {
    for (int idx = tid; idx < 32 * 32; idx += 256) {
      const int tok = idx >> 5, c8 = idx & 31;
      const size_t m = (size_t)(T0 + tok);
      const uint4 z = *(const uint4*)(hb + m * HS + C_V + c8 * 8);
      uint4 zp = make_uint4(0, 0, 0, 0);
      if (((T0 + tok) & 2047) != 0) zp = *(const uint4*)(hb + (m - 1) * HS + C_V + c8 * 8);
      const unsigned zz[4] = {z.x, z.y, z.z, z.w}, pp[4] = {zp.x, zp.y, zp.z, zp.w};
      unsigned oo[4];
#pragma unroll
      for (int e = 0; e < 4; ++e) {
        const float m0 = mu[512 + c8 * 8 + 2 * e], m1 = mu[512 + c8 * 8 + 2 * e + 1];
        float x0 = bflo(zz[e]), x1 = bfhi(zz[e]);
        x0 = x0 + (bflo(pp[e]) - x0) * m0; x1 = x1 + (bfhi(pp[e]) - x1) * m1;
        oo[e] = pack2(x0, x1);
      }
      *(uint4*)(A3 + tok * 264 + c8 * 8) = make_uint4(oo[0], oo[1], oo[2], oo[3]);
    }
  }
  __syncthreads();
  const bf16_t* lw2 = (const bf16_t*)(p.ws + O_LW2);
  const bf16_t* la2 = (const bf16_t*)(p.ws + O_LA2);
  const bf16_t* v1t = (const bf16_t*)(p.ws + O_V1T);
  const bf16_t* v2t = (const bf16_t*)(p.ws + O_V2T);
  const float* w0 = p.in[12] + l * 256; const float* a0 = p.in[14] + l * 256;
  const float* kkw = p.in[16] + l * 256; const float* kaw = p.in[17] + l * 256; const float* rkw = p.in[18] + l * 256;
  const float* v0 = p.in[21];
  bf16_t* vf = (bf16_t*)(p.ws + O_VF);
  bf16_t* pr = (bf16_t*)(p.ws + O_PR);
  float* bon = (float*)(p.ws + O_BON);
  {
    const int tt = 0;
    const int tokl = 32 * tt + r31;
    const size_t m = (size_t)(T0 + tokl);
    const bool first = (((T0 + tokl) & 2047) == 0);
    const int b = (int)(m >> 11), t = (int)(m & 2047);
    float ss = 0.f;
#pragma unroll
    for (int nt = 0; nt < 2; ++nt)
#pragma unroll
      for (int q = 0; q < 4; ++q) {
        const int c = w * 64 + 32 * nt + 8 * q + 4 * h;
        const uint2 zk = *(const uint2*)(hb + m * HS + C_K + c);
        uint2 pk_ = make_uint2(0, 0);
        if (!first) pk_ = *(const uint2*)(hb + (m - 1) * HS + C_K + c);
        const float4 muk = *(const float4*)(mu + 256 + c);
        const float4 kw4 = *(const float4*)(kkw + c);
        float x0 = bflo(zk.x), x1 = bfhi(zk.x), x2 = bflo(zk.y), x3 = bfhi(zk.y);
        x0 = (x0 + (bflo(pk_.x) - x0) * muk.x) * kw4.x; x1 = (x1 + (bfhi(pk_.x) - x1) * muk.y) * kw4.y;
        x2 = (x2 + (bflo(pk_.y) - x2) * muk.z) * kw4.z; x3 = (x3 + (bfhi(pk_.y) - x3) * muk.w) * kw4.w;
        ss += x0 * x0 + x1 * x1 + x2 * x2 + x3 * x3;
      }
    ss += __shfl_xor(ss, 32, 64);
    const float inv = 1.f / fmaxf(sqrtf(ss), 1e-12f);
    float bsum = 0.f;
    bf16_t* prow = pr + ((size_t)((b * 4 + w) * 2048 + t)) * 384;
#pragma unroll 1
    for (int nt = 0; nt < 2; ++nt) {
      f32x16 aw, aa, av;
#pragma unroll
      for (int e = 0; e < 16; ++e) { aw[e] = 0.f; aa[e] = 0.f; av[e] = 0.f; }
#pragma unroll
      for (int s = 0; s < 4; ++s) {
        const bf16x8 f1 = *(const bf16x8*)(A1 + (32 * tt + r31) * LDT + 16 * s + 8 * h);
        const bf16x8 f2 = *(const bf16x8*)(A2 + (32 * tt + r31) * LDT + 16 * s + 8 * h);
        const bf16x8 gw = *(const bf16x8*)(lw2 + (w * 64 + 32 * nt + r31) * 64 + 16 * s + 8 * h);
        const bf16x8 ga = *(const bf16x8*)(la2 + (w * 64 + 32 * nt + r31) * 64 + 16 * s + 8 * h);
        aw = MFMA32(gw, f1, aw);
        aa = MFMA32(ga, f2, aa);
      }
      if (l == 1) {
        f32x16 t1;
#pragma unroll
        for (int e = 0; e < 16; ++e) t1[e] = 0.f;
#pragma unroll
        for (int s = 0; s < 16; ++s) {
          const bf16x8 fv = *(const bf16x8*)(A3 + (32 * tt + r31) * 264 + 16 * s + 8 * h);
          const bf16x8 g1 = *(const bf16x8*)(v1t + r31 * 256 + 16 * s + 8 * h);
          t1 = MFMA32(g1, fv, t1);
        }
#pragma unroll
        for (int s = 0; s < 2; ++s) {
          unsigned pk[4];
#pragma unroll
          for (int e = 0; e < 4; ++e) pk[e] = pack2(t1[8 * s + 2 * e], t1[8 * s + 2 * e + 1]);
          const bf16x8 fb = __builtin_bit_cast(bf16x8, make_uint4(pk[0], pk[1], pk[2], pk[3]));
          const bf16_t* vr = v2t + (w * 64 + 32 * nt + r31) * 32 + 16 * s + 4 * h;
          const uint2 lo = *(const uint2*)vr; const uint2 hi = *(const uint2*)(vr + 8);
          const bf16x8 fa = __builtin_bit_cast(bf16x8, make_uint4(lo.x, lo.y, hi.x, hi.y));
          av = MFMA32(fa, fb, av);
        }
      }
#pragma unroll
      for (int q = 0; q < 4; ++q) {
        const int cl = 32 * nt + 8 * q + 4 * h;
        const int c = w * 64 + cl;
        const uint2 zr = *(const uint2*)(hb + m * HS + C_R + c);
        const uint2 zk = *(const uint2*)(hb + m * HS + C_K + c);
        const uint2 zv = *(const uint2*)(hb + m * HS + C_V + c);
        uint2 pr_ = make_uint2(0, 0), pk_ = make_uint2(0, 0), pv_ = make_uint2(0, 0);
        if (!first) {
          pr_ = *(const uint2*)(hb + (m - 1) * HS + C_R + c);
          pk_ = *(const uint2*)(hb + (m - 1) * HS + C_K + c);
          pv_ = *(const uint2*)(hb + (m - 1) * HS + C_V + c);
        }
        uint2 vfl = make_uint2(0, 0);
        if (l == 1) vfl = *(const uint2*)(vf + m * 256 + c);
        float orr[4], ou[4], okp[4], ovv[4], oa[4], ob[4];
#pragma unroll
        for (int e = 0; e < 4; ++e) {
          const int cc = c + e; const int i = 4 * q + e;
          const unsigned zru = (e < 2) ? zr.x : zr.y, zku = (e < 2) ? zk.x : zk.y, zvu = (e < 2) ? zv.x : zv.y;
          const unsigned pru = (e < 2) ? pr_.x : pr_.y, pku = (e < 2) ? pk_.x : pk_.y, pvu = (e < 2) ? pv_.x : pv_.y;
          const unsigned vfu = (e < 2) ? vfl.x : vfl.y;
          float xr = (e & 1) ? bfhi(zru) : bflo(zru), xk = (e & 1) ? bfhi(zku) : bflo(zku), xv = (e & 1) ? bfhi(zvu) : bflo(zvu);
          const float qr = (e & 1) ? bfhi(pru) : bflo(pru), qk = (e & 1) ? bfhi(pku) : bflo(pku), qv = (e & 1) ? bfhi(pvu) : bflo(pvu);
          xr = xr + (qr - xr) * mu[cc]; xk = xk + (qk - xk) * mu[256 + cc]; xv = xv + (qv - xv) * mu[512 + cc];
          const float wl = w0[cc] + aw[i];
          const float ew = 0.60653065971f * sigmoidf_(wl);
          const float u = ew * (1.f - ew * 0.5f * (1.f - ew * (1.f / 3.f) * (1.f - ew * 0.25f * (1.f - ew * 0.2f * (1.f - ew * (1.f / 6.f) * (1.f - ew * (1.f / 7.f) * (1.f - ew * 0.125f)))))));
          const float a = sigmoidf_(a0[cc] + aa[i]);
          if (l == 1) {
            const float vfirst = (e & 1) ? bfhi(vfu) : bflo(vfu);
            xv = xv + (vfirst - xv) * sigmoidf_(v0[cc] + av[i]);
          }
          const float kk = xk * kkw[cc] * inv;
          const float kp = xk * (1.f + (a - 1.f) * kaw[cc]);
          bsum += xr * kp * rkw[cc];
          orr[e] = xr; ou[e] = u; okp[e] = kp; ovv[e] = xv; oa[e] = -kk; ob[e] = kk * a;
        }
        uint2 o;
        o.x = pack2(orr[0], orr[1]); o.y = pack2(orr[2], orr[3]); *(uint2*)(prow + 0 * 64 + cl) = o;
        o.x = pack2(ou[0], ou[1]); o.y = pack2(ou[2], ou[3]); *(uint2*)(prow + 1 * 64 + cl) = o;
        o.x = pack2(okp[0], okp[1]); o.y = pack2(okp[2], okp[3]); *(uint2*)(prow + 2 * 64 + cl) = o;
        o.x = pack2(ovv[0], ovv[1]); o.y = pack2(ovv[2], ovv[3]); *(uint2*)(prow + 3 * 64 + cl) = o;
        if (l == 0) *(uint2*)(vf + m * 256 + c) = o;
        o.x = pack2(oa[0], oa[1]); o.y = pack2(oa[2], oa[3]); *(uint2*)(prow + 4 * 64 + cl) = o;
        o.x = pack2(ob[0], ob[1]); o.y = pack2(ob[2], ob[3]); *(uint2*)(prow + 5 * 64 + cl) = o;
      }
    }
    bsum += __shfl_xor(bsum, 32, 64);
    if (h == 0) bon[m * 4 + w] = bsum;
  }
  __syncthreads();
}

DI float dpp_add(float x, const int ctrl_sel) {
  int xi = __float_as_int(x), yi;
  if (ctrl_sel == 0) yi = __builtin_amdgcn_update_dpp(0, xi, 0xB1, 0xF, 0xF, true);
  else if (ctrl_sel == 1) yi = __builtin_amdgcn_update_dpp(0, xi, 0x4E, 0xF, 0xF, true);
  else if (ctrl_sel == 2) yi = __builtin_amdgcn_update_dpp(0, xi, 0x141, 0xF, 0xF, true);
  else yi = __builtin_amdgcn_update_dpp(0, xi, 0x140, 0xF, 0xF, true);
  return x + __int_as_float(yi);
}
DI float row16_sum(float x) { x = dpp_add(x, 0); x = dpp_add(x, 1); x = dpp_add(x, 2); x = dpp_add(x, 3); return x; }

DI void scan_put(const uint4& g, int idx, float* dstbase) {
  const int e0 = idx * 8; const int arr = (e0 % 384) >> 6;
  float f[8] = {bflo(g.x), bfhi(g.x), bflo(g.y), bfhi(g.y), bflo(g.z), bfhi(g.z), bflo(g.w), bfhi(g.w)};
  if (arr == 1) {
#pragma unroll
    for (int e = 0; e < 8; ++e) f[e] = 1.f - f[e];
  }
  *(float4*)(dstbase + e0) = make_float4(f[0], f[1], f[2], f[3]);
  *(float4*)(dstbase + e0 + 4) = make_float4(f[4], f[5], f[6], f[7]);
}
DI void rwkv_scan(const Params& p, int item, char* smraw) {
  const int rg = item & 7, hd = (item >> 3) & 3, b = item >> 5;
  float* stage = (float*)smraw;
  const bf16_t* pr = (const bf16_t*)(p.ws + O_PR) + ((size_t)((b * 4 + hd) * 2048)) * 384;
  bf16_t* yr = (bf16_t*)(p.ws + O_YR);
  const int tid = tidx(), row = (tid >> 4) & 7, kq = tid & 15;
  const bool comp = tid < 128;
  const int st_ = tid & 127;
  fv2 S01 = {0.f, 0.f}, S23 = {0.f, 0.f};
  uint4 g[6];
  __syncthreads();
  __builtin_amdgcn_s_setprio(3);
  if (!comp) {
#pragma unroll
    for (int c0 = 0; c0 < 2; ++c0) {
#pragma unroll
      for (int i = 0; i < 6; ++i) g[i] = *(const uint4*)(pr + (size_t)c0 * 16 * 384 + (size_t)(st_ + 128 * i) * 8);
#pragma unroll
      for (int i = 0; i < 6; ++i) scan_put(g[i], st_ + 128 * i, stage + c0 * 16 * 384);
    }
#pragma unroll
    for (int i = 0; i < 6; ++i) g[i] = *(const uint4*)(pr + (size_t)2 * 16 * 384 + (size_t)(st_ + 128 * i) * 8);
  }
  __syncthreads();
  float4 Pr0, Pw0, Pk0, Pa0, Pb0, Pr1, Pw1, Pk1, Pa1, Pb1; float Pv0, Pv1;
  {
    const float* sp = stage + 4 * kq; const float* vp = stage + 3 * 64 + 8 * rg + row;
    Pr0 = *(const float4*)(sp + 0 * 64); Pw0 = *(const float4*)(sp + 1 * 64); Pk0 = *(const float4*)(sp + 2 * 64); Pa0 = *(const float4*)(sp + 4 * 64); Pb0 = *(const float4*)(sp + 5 * 64); Pv0 = vp[0];
    sp += 384; vp += 384;
    Pr1 = *(const float4*)(sp + 0 * 64); Pw1 = *(const float4*)(sp + 1 * 64); Pk1 = *(const float4*)(sp + 2 * 64); Pa1 = *(const float4*)(sp + 4 * 64); Pb1 = *(const float4*)(sp + 5 * 64); Pv1 = vp[0];
  }
  int cur = 0;
  for (int ch = 0; ch < 128; ++ch) {
    if (comp) {
      int nxt = cur + 1; if (nxt == 3) nxt = 0;
      const float* st = stage + cur * 16 * 384 + 4 * kq;
      const float* sv = stage + cur * 16 * 384 + 3 * 64 + 8 * rg + row;
      const float* stn = stage + nxt * 16 * 384 + 4 * kq;
      const float* svn = stage + nxt * 16 * 384 + 3 * 64 + 8 * rg + row;
      float ykeep = 0.f, yp = 0.f;
#pragma unroll
      for (int s = 0; s < 16; ++s) {
        float4 cr, cw, ck, ca, cb; float cv;
        if (s & 1) { cr = Pr1; cw = Pw1; ck = Pk1; ca = Pa1; cb = Pb1; cv = Pv1; }
        else { cr = Pr0; cw = Pw0; ck = Pk0; ca = Pa0; cb = Pb0; cv = Pv0; }
        {
          const float* sp = (s < 14) ? (st + (s + 2) * 384) : (stn + (s - 14) * 384);
          const float* vp = (s < 14) ? (sv + (s + 2) * 384) : (svn + (s - 14) * 384);
          if (s & 1) { Pr1 = *(const float4*)(sp + 0 * 64); Pw1 = *(const float4*)(sp + 1 * 64); Pk1 = *(const float4*)(sp + 2 * 64); Pa1 = *(const float4*)(sp + 4 * 64); Pb1 = *(const float4*)(sp + 5 * 64); Pv1 = vp[0]; }
          else { Pr0 = *(const float4*)(sp + 0 * 64); Pw0 = *(const float4*)(sp + 1 * 64); Pk0 = *(const float4*)(sp + 2 * 64); Pa0 = *(const float4*)(sp + 4 * 64); Pb0 = *(const float4*)(sp + 5 * 64); Pv0 = vp[0]; }
        }
        const fv2 a01 = {ca.x, ca.y}, a23 = {ca.z, ca.w}, w01 = {cw.x, cw.y}, w23 = {cw.z, cw.w};
        const fv2 k01 = {ck.x, ck.y}, k23 = {ck.z, ck.w}, b01 = {cb.x, cb.y}, b23 = {cb.z, cb.w};
        const fv2 r01 = {cr.x, cr.y}, r23 = {cr.z, cr.w};
        const fv2 vv = {cv, cv};
        fv2 pa = S01 * a01; pa = __builtin_elementwise_fma(S23, a23, pa);
        float sa = pa.x + pa.y;
        const fv2 t01 = __builtin_elementwise_fma(S01, w01, vv * k01);
        const fv2 t23 = __builtin_elementwise_fma(S23, w23, vv * k23);
        if (s > 0) {
          sa = dpp_add(sa, 0); yp = dpp_add(yp, 0); sa = dpp_add(sa, 1); yp = dpp_add(yp, 1);
          sa = dpp_add(sa, 2); yp = dpp_add(yp, 2); sa = dpp_add(sa, 3); yp = dpp_add(yp, 3);
          ykeep = (kq == s - 1) ? yp : ykeep;
        } else {
          sa = row16_sum(sa);
        }
        const fv2 sav = {sa, sa};
        S01 = __builtin_elementwise_fma(sav, b01, t01);
        S23 = __builtin_elementwise_fma(sav, b23, t23);
        fv2 py = S01 * r01; py = __builtin_elementwise_fma(S23, r23, py);
        yp = py.x + py.y;
      }
      yp = row16_sum(yp);
      ykeep = (kq == 15) ? yp : ykeep;
      yr[((size_t)(b * 2048 + ch * 16 + kq)) * 256 + hd * 64 + 8 * rg + row] = f2bf(ykeep);
    } else {
      if (ch + 2 < 128) {
        int nb = cur + 2; if (nb >= 3) nb -= 3;
        float* dst = stage + nb * 16 * 384;
#pragma unroll
        for (int i = 0; i < 6; ++i) scan_put(g[i], st_ + 128 * i, dst);
      }
      if (ch + 3 < 128) {
        const bf16_t* src = pr + (size_t)(ch + 3) * 16 * 384;
#pragma unroll
        for (int i = 0; i < 6; ++i) g[i] = *(const uint4*)(src + (size_t)(st_ + 128 * i) * 8);
      }
    }
    __syncthreads();
    cur = (cur == 2) ? 0 : cur + 1;
  }
  __builtin_amdgcn_s_setprio(0);
  __syncthreads();
}

constexpr float SL2 = 0.125f * 1.4426950408889634f;

template <int MODE>
DI void attn_loop(const bf16_t* kb, long kstride, const bf16_t* vtb, long vstride, int jlo, int jhi,
                  const bf16x8 (&qf)[4], int qpos, unsigned sel, unsigned uni, int W,
                  f32x16 (&o)[2], float& m, float& l, bf16_t* Ks, bf16_t* Vs) {
  const int tid = tidx(), lane = tid & 63, h = lane >> 5, r31 = lane & 31;
  const int lr = tid >> 3, lc = (tid & 7) * 8;
  int j = jlo;
  if (MODE == 1) { while (j <= jhi && !((uni >> j) & 1)) ++j; }
  uint4 k0, k1, v0, v1;
  if (j <= jhi) {
    k0 = *(const uint4*)(kb + (long)(64 * j + lr) * kstride + lc); k1 = *(const uint4*)(kb + (long)(64 * j + lr + 32) * kstride + lc);
    v0 = *(const uint4*)(vtb + (long)lr * vstride + 64 * j + lc); v1 = *(const uint4*)(vtb + (long)(lr + 32) * vstride + 64 * j + lc);
  }
  while (j <= jhi) {
    __syncthreads();
    *(uint4*)(Ks + lr * LDT + lc) = k0; *(uint4*)(Ks + (lr + 32) * LDT + lc) = k1;
    *(uint4*)(Vs + lr * LDT + lc) = v0; *(uint4*)(Vs + (lr + 32) * LDT + lc) = v1;
    __syncthreads();
    int jn = j + 1;
    if (MODE == 1) { while (jn <= jhi && !((uni >> jn) & 1)) ++jn; }
    if (jn <= jhi) {
      k0 = *(const uint4*)(kb + (long)(64 * jn + lr) * kstride + lc); k1 = *(const uint4*)(kb + (long)(64 * jn + lr + 32) * kstride + lc);
      v0 = *(const uint4*)(vtb + (long)lr * vstride + 64 * jn + lc); v1 = *(const uint4*)(vtb + (long)(lr + 32) * vstride + 64 * jn + lc);
    }
    __builtin_amdgcn_sched_barrier(0);
    f32x16 s[2];
#pragma unroll
    for (int kt = 0; kt < 2; ++kt) {
#pragma unroll
      for (int e = 0; e < 16; ++e) s[kt][e] = 0.f;
#pragma unroll
      for (int si = 0; si < 4; ++si) {
        const bf16x8 fa = *(const bf16x8*)(Ks + (32 * kt + r31) * LDT + 16 * si + 8 * h);
        s[kt] = MFMA32(fa, qf[si], s[kt]);
      }
    }
    const bool selj = (MODE == 1) ? (((sel >> j) & 1) != 0) : true;
    float mx = -1e30f;
#pragma unroll
    for (int kt = 0; kt < 2; ++kt)
#pragma unroll
      for (int e = 0; e < 16; ++e) {
        const int key = 64 * j + 32 * kt + crow(e, h);
        bool valid;
        if (MODE == 0) valid = (16 * key + 31 <= qpos);
        else if (MODE == 1) valid = selj && (key <= qpos);
        else valid = (key <= qpos) && (qpos - key < W);
        const float v = valid ? s[kt][e] * SL2 : -1e30f;
        s[kt][e] = v; mx = fmaxf(mx, v);
      }
    mx = fmaxf(mx, __shfl_xor(mx, 32, 64));
    const float mnew = fmaxf(m, mx);
    const float alpha = __builtin_amdgcn_exp2f(m - mnew);
    m = mnew; l *= alpha;
#pragma unroll
    for (int e = 0; e < 16; ++e) { o[0][e] *= alpha; o[1][e] *= alpha; }
#pragma unroll
    for (int kt = 0; kt < 2; ++kt)
#pragma unroll
      for (int e = 0; e < 16; ++e) {
        const float pv = (s[kt][e] > -1e29f) ? __builtin_amdgcn_exp2f(s[kt][e] - mnew) : 0.f;
        l += pv; s[kt][e] = pv;
      }
#pragma unroll
    for (int kt = 0; kt < 2; ++kt)
#pragma unroll
      for (int sp = 0; sp < 2; ++sp) {
        const bf16x8 fb = __builtin_bit_cast(bf16x8, make_uint4(pack2(s[kt][8 * sp + 0], s[kt][8 * sp + 1]), pack2(s[kt][8 * sp + 2], s[kt][8 * sp + 3]),
                                                               pack2(s[kt][8 * sp + 4], s[kt][8 * sp + 5]), pack2(s[kt][8 * sp + 6], s[kt][8 * sp + 7])));
#pragma unroll
        for (int dt = 0; dt < 2; ++dt) {
          const bf16_t* vr = Vs + (32 * dt + r31) * LDT + 32 * kt + 16 * sp + 4 * h;
          const uint2 lo = *(const uint2*)vr; const uint2 hi = *(const uint2*)(vr + 8);
          const bf16x8 fa = __builtin_bit_cast(bf16x8, make_uint4(lo.x, lo.y, hi.x, hi.y));
          o[dt] = MFMA32(fa, fb, o[dt]);
        }
      }
    j = jn;
  }
}

DI void zero_o(f32x16 (&o)[2]) {
#pragma unroll
  for (int e = 0; e < 16; ++e) { o[0][e] = 0.f; o[1][e] = 0.f; }
}

DI void nsa_item(const Params& p, int item, char* smraw, bool wr = true) {
  const int qb = 63 - (item >> 4), bg = item & 15, b = bg >> 1, g = bg & 1;
  bf16_t* Ks = (bf16_t*)smraw; bf16_t* Vs = Ks + 64 * LDT;
  float* imp = (float*)(smraw + 18432);
  float* scs = (float*)(smraw + 18432 + 16896);
  unsigned* selm = (unsigned*)(smraw + 18432 + 16896 + 4224);
  const bf16_t* hb = (const bf16_t*)(p.ws + O_H);
  bf16_t* hw = (bf16_t*)(p.ws + O_H);
  const bf16_t* vt = (const bf16_t*)(p.ws + O_VT);
  const int tid = tidx(), lane = tid & 63, w = tid >> 6, h = lane >> 5, r31 = lane & 31;
  const int H = g * 4 + w;
  const int qpos = 32 * qb + r31;
  const size_t mrow = (size_t)b * 2048 + qpos;
  const int cur = qb >> 1;
  bf16x8 qf[4];
#pragma unroll
  for (int s = 0; s < 4; ++s) qf[s] = *(const bf16x8*)(hb + mrow * HS + C_AQ + H * 64 + 16 * s + 8 * h);
  const float g0 = sigmoidf_(bf2f(hb[mrow * HS + C_GATE + 0 * 8 + H]));
  const float g1 = sigmoidf_(bf2f(hb[mrow * HS + C_GATE + 1 * 8 + H]));
  const float g2 = sigmoidf_(bf2f(hb[mrow * HS + C_GATE + 2 * 8 + H]));
  f32x16 ot[2], o[2];
  float m, l;
  const bf16_t* kcb = (const bf16_t*)(p.ws + O_KC) + (size_t)bg * 128 * 64;
  const bf16_t* vcb = (const bf16_t*)(p.ws + O_VCT) + (size_t)bg * 64 * 128;
  const int ntile = (2 * qb + 1 + 63) >> 6;
  zero_o(o); m = -1e30f; l = 0.f;
  attn_loop<0>(kcb, 64, vcb, 128, 0, ntile - 1, qf, qpos, 0u, 0u, 0, o, m, l, Ks, Vs);
  float lt = l + __shfl_xor(l, 32, 64);
  float inv = (lt > 0.f) ? 1.f / lt : 0.f;
#pragma unroll
  for (int e = 0; e < 16; ++e) { ot[0][e] = g0 * inv * o[0][e]; ot[1][e] = g0 * inv * o[1][e]; }
  unsigned sel, uni;
  if (cur < 16) {
    sel = (1u << (cur + 1)) - 1u; uni = sel;
  } else {
    float p3[16];
    const int lr = tid >> 3, lc = (tid & 7) * 8;
    float* impw = imp + w * 32 * 33 + r31 * 33;
#pragma unroll
    for (int jt = 0; jt < 2; ++jt) {
      __syncthreads();
      *(uint4*)(Ks + lr * LDT + lc) = *(const uint4*)(kcb + (size_t)(64 * jt + lr) * 64 + lc);
      *(uint4*)(Ks + (lr + 32) * LDT + lc) = *(const uint4*)(kcb + (size_t)(64 * jt + lr + 32) * 64 + lc);
      __syncthreads();
#pragma unroll
      for (int kt = 0; kt < 2; ++kt) {
        f32x16 s;
#pragma unroll
        for (int e = 0; e < 16; ++e) s[e] = 0.f;
#pragma unroll
        for (int si = 0; si < 4; ++si) {
          const bf16x8 fa = *(const bf16x8*)(Ks + (32 * kt + r31) * LDT + 16 * si + 8 * h);
          s = MFMA32(fa, qf[si], s);
        }
#pragma unroll
        for (int q = 0; q < 4; ++q) {
          float sum4 = 0.f, last = 0.f;
#pragma unroll
          for (int e = 0; e < 4; ++e) {
            const int key = 64 * jt + 32 * kt + 8 * q + 4 * h + e;
            const bool valid = (16 * key + 31 <= qpos);
            const float pv = valid ? __builtin_amdgcn_exp2f(s[4 * q + e] * SL2 - m) * inv : 0.f;
            sum4 += pv; last = pv;
          }
          impw[16 * jt + 8 * kt + 2 * q + h] = sum4;
          p3[jt * 8 + kt * 4 + q] = last;
        }
      }
    }
    __syncthreads();
#pragma unroll
    for (int jt = 0; jt < 2; ++jt)
#pragma unroll
      for (int kt = 0; kt < 2; ++kt)
#pragma unroll
        for (int q = 0; q < 4; ++q) {
          const int j1 = 16 * jt + 8 * kt + 2 * q + h + 1;
          if (j1 < 32) impw[j1] += p3[jt * 8 + kt * 4 + q];
        }
    __syncthreads();
    {
      const int ql = tid >> 3, jj = tid & 7;
#pragma unroll
      for (int e = 0; e < 4; ++e) {
        const int j = jj * 4 + e;
        float sc;
        if (j == 0 || j == cur || j == cur - 1) sc = 1e9f;
        else if (j <= cur) sc = ((imp[(0 * 32 + ql) * 33 + j] + imp[(1 * 32 + ql) * 33 + j]) + imp[(2 * 32 + ql) * 33 + j]) + imp[(3 * 32 + ql) * 33 + j];
        else sc = -1e9f;
        scs[ql * 33 + j] = sc;
      }
      if (tid < 33) selm[tid] = 0u;
    }
    __syncthreads();
    {
      const int ql = tid >> 3, jj = tid & 7;
      unsigned bits = 0u;
#pragma unroll
      for (int e = 0; e < 4; ++e) {
        const int j = jj * 4 + e;
        const float my = scs[ql * 33 + j];
        int rank = 0;
        for (int j2 = 0; j2 < 32; ++j2) {
          const float o2 = scs[ql * 33 + j2];
          rank += (o2 > my || (o2 == my && j2 < j)) ? 1 : 0;
        }
        if (rank < 16) bits |= (1u << j);
      }
      atomicOr(&selm[ql], bits);
      atomicOr(&selm[32], bits);
    }
    __syncthreads();
    sel = selm[r31]; uni = selm[32];
  }
  zero_o(o); m = -1e30f; l = 0.f;
  attn_loop<1>(hb + (size_t)b * 2048 * HS + C_KS + g * 64, HS, vt + ((size_t)((0 * 8 + b) * 128 + g * 64)) * 2048, 2048, 0, cur, qf, qpos, sel, uni, 0, o, m, l, Ks, Vs);
  lt = l + __shfl_xor(l, 32, 64);
  inv = (lt > 0.f) ? 1.f / lt : 0.f;
#pragma unroll
  for (int e = 0; e < 16; ++e) { ot[0][e] += g1 * inv * o[0][e]; ot[1][e] += g1 * inv * o[1][e]; }
  zero_o(o); m = -1e30f; l = 0.f;
  const int lo_ = 32 * qb - 511;
  const int jlo = (lo_ <= 0) ? 0 : (lo_ >> 6);
  attn_loop<2>(hb + (size_t)b * 2048 * HS + C_KW + g * 64, HS, vt + ((size_t)((1 * 8 + b) * 128 + g * 64)) * 2048, 2048, jlo, cur, qf, qpos, 0u, 0u, 512, o, m, l, Ks, Vs);
  lt = l + __shfl_xor(l, 32, 64);
  inv = (lt > 0.f) ? 1.f / lt : 0.f;
#pragma unroll
  for (int e = 0; e < 16; ++e) { ot[0][e] += g2 * inv * o[0][e]; ot[1][e] += g2 * inv * o[1][e]; }
#pragma unroll
  for (int dt = 0; dt < 2; ++dt)
#pragma unroll
    for (int q = 0; q < 4; ++q) {
      const int d = 32 * dt + 8 * q + 4 * h;
      bf16_t* zp = hw + mrow * HS + C_AZ + H * 64 + d;
      const uint2 z = *(const uint2*)zp;
      uint2 ov;
      ov.x = pack2(ot[dt][4 * q] * siluf_(bflo(z.x)), ot[dt][4 * q + 1] * siluf_(bfhi(z.x)));
      ov.y = pack2(ot[dt][4 * q + 2] * siluf_(bflo(z.y)), ot[dt][4 * q + 3] * siluf_(bfhi(z.y)));
      if (wr) *(uint2*)zp = ov;
    }
  __syncthreads();
}

DI void swa_item(const Params& p, int l_, int item, char* smraw, bool wr = true) {
  const int qb = 31 - (item >> 4), bg = item & 15, b = bg >> 1, g = bg & 1;
  bf16_t* Ks = (bf16_t*)smraw; bf16_t* Vs = Ks + 64 * LDT;
  const bf16_t* hb = (const bf16_t*)(p.ws + O_H);
  bf16_t* hw = (bf16_t*)(p.ws + O_H);
  const bf16_t* vt = (const bf16_t*)(p.ws + O_VT);
  const int tid = tidx(), lane = tid & 63, w = tid >> 6, h = lane >> 5, r31 = lane & 31;
  const int H = g * 2 + (w & 1);
  const int qpos = 64 * qb + 32 * (w >> 1) + r31;
  const size_t mrow = (size_t)b * 2048 + qpos;
  bf16x8 qf[4];
#pragma unroll
  for (int s = 0; s < 4; ++s) qf[s] = *(const bf16x8*)(hb + mrow * HS + C_BQ + H * 64 + 16 * s + 8 * h);
  const float sink = p.in[10][l_ * 4 + H] * 1.4426950408889634f;
  f32x16 o[2];
  zero_o(o);
  float m = sink, l = (h == 0) ? 1.f : 0.f;
  const int jlo = (qb >= 2) ? qb - 2 : 0;
  attn_loop<2>(hb + (size_t)b * 2048 * HS + C_BK + g * 64, HS, vt + ((size_t)((2 * 8 + b) * 128 + g * 64)) * 2048, 2048, jlo, qb, qf, qpos, 0u, 0u, 128, o, m, l, Ks, Vs);
  const float lt = l + __shfl_xor(l, 32, 64);
  const float inv = (lt > 0.f) ? 1.f / lt : 0.f;
#pragma unroll
  for (int dt = 0; dt < 2; ++dt)
#pragma unroll
    for (int q = 0; q < 4; ++q) {
      const int d = 32 * dt + 8 * q + 4 * h;
      bf16_t* zp = hw + mrow * HS + C_BZ + H * 64 + d;
      const uint2 z = *(const uint2*)zp;
      uint2 ov;
      ov.x = pack2(inv * o[dt][4 * q] * siluf_(bflo(z.x)), inv * o[dt][4 * q + 1] * siluf_(bfhi(z.x)));
      ov.y = pack2(inv * o[dt][4 * q + 2] * siluf_(bflo(z.y)), inv * o[dt][4 * q + 3] * siluf_(bfhi(z.y)));
      if (wr) *(uint2*)zp = ov;
    }
  __syncthreads();
}

DI void rwkv_post(const Params& p, int l) {
  const int lane = tidx() & 63, hd = tidx() >> 6;
  const bf16_t* yr = (const bf16_t*)(p.ws + O_YR);
  const bf16_t* pr = (const bf16_t*)(p.ws + O_PR);
  const float* bon = (const float*)(p.ws + O_BON);
  bf16_t* hw = (bf16_t*)(p.ws + O_H);
  const float lw = p.in[19][l * 256 + hd * 64 + lane], lb = p.in[20][l * 256 + hd * 64 + lane];
  for (int it = bidx(); it < NTOK / 8; it += gridDim.x) {
    float y[8], v[8], z[8], bo[8];
#pragma unroll
    for (int q = 0; q < 8; ++q) {
      const size_t m = (size_t)it * 8 + q;
      const int b = (int)(m >> 11), t = (int)(m & 2047);
      y[q] = bf2f(yr[m * 256 + hd * 64 + lane]);
      v[q] = bf2f(pr[((size_t)((b * 4 + hd) * 2048 + t)) * 384 + 3 * 64 + lane]);
      z[q] = bf2f(hw[m * HS + C_CZ + hd * 64 + lane]);
      bo[q] = bon[m * 4 + hd];
    }
#pragma unroll
    for (int q = 0; q < 8; ++q) {
      const size_t m = (size_t)it * 8 + q;
      const float mean = wave_sum(y[q]) * (1.f / 64.f);
      const float dlt = y[q] - mean;
      const float var = wave_sum(dlt * dlt) * (1.f / 64.f);
      float o = dlt * rsqrtf(var + 64e-5f) * lw + lb + bo[q] * v[q];
      o *= siluf_(z[q]);
      hw[m * HS + C_CZ + hd * 64 + lane] = f2bf(o);
    }
  }
}

DI void phase5(const Params& p, int l, char* smraw) {
  bf16_t* sm = (bf16_t*)smraw;
  const bf16_t* xn = (const bf16_t*)(p.ws + O_XN);
  const bf16_t* hb = (const bf16_t*)(p.ws + O_H);
  const bf16_t* wtm = (const bf16_t*)(p.ws + O_WTM);
  const bf16_t* wtp = (const bf16_t*)(p.ws + O_WTP);
  bf16_t* mixed = (bf16_t*)(p.ws + O_PR);
  const float* bm = p.in[3] + l * 3072;
  const int lane = tidx() & 63, w = tidx() >> 6, wm = w >> 1, wn = w & 1, h = lane >> 5, r31 = lane & 31;
  for (int round = 0;; ++round) {
    int mt, nt;
    if (!xcd_tile<8, 8>(round, mt, nt)) break;
    unsigned mxp[2][2][8];
#pragma unroll
    for (int i = 0; i < 2; ++i)
#pragma unroll
      for (int j = 0; j < 2; ++j)
#pragma unroll
        for (int e = 0; e < 8; ++e) mxp[i][j][e] = 0u;
    uint4* scr = (uint4*)(p.ws + O_PR + (size_t)NTOK * 1024 * 2) + (size_t)bidx() * 2048 + tidx();
#pragma unroll 1
    for (int br = 0; br < 3; ++br) {
      const int zc = (br == 0) ? C_AZ : (br == 1) ? C_BZ : C_CZ;
      const int kof = (br == 0) ? 0 : (br == 1) ? 512 : 768;
      const int kk = (br == 0) ? 512 : 256;
      f32x16 acc[2][2];
      gemm_plain(acc, hb + zc, HS, mt * 128, wtp + kof, 1024, nt * 128, kk, sm);
#pragma unroll
      for (int i = 0; i < 2; ++i)
#pragma unroll
        for (int j = 0; j < 2; ++j) {
          scr[((i * 2 + j) * 2 + 0) * 256] = make_uint4(pack2(acc[i][j][0], acc[i][j][1]), pack2(acc[i][j][2], acc[i][j][3]), pack2(acc[i][j][4], acc[i][j][5]), pack2(acc[i][j][6], acc[i][j][7]));
          scr[((i * 2 + j) * 2 + 1) * 256] = make_uint4(pack2(acc[i][j][8], acc[i][j][9]), pack2(acc[i][j][10], acc[i][j][11]), pack2(acc[i][j][12], acc[i][j][13]), pack2(acc[i][j][14], acc[i][j][15]));
        }
      gemm_plain(acc, xn, 1024, mt * 128, wtm + (size_t)br * 1024 * 1024, 1024, nt * 128, 1024, sm);
#pragma unroll
      for (int i = 0; i < 2; ++i)
#pragma unroll
        for (int j = 0; j < 2; ++j) {
          const float bias = bm[br * 1024 + nt * 128 + wn * 64 + 32 * j + r31];
#pragma unroll
          for (int hh = 0; hh < 2; ++hh) {
            const uint4 pv = scr[((i * 2 + j) * 2 + hh) * 256];
            const unsigned pw[4] = {pv.x, pv.y, pv.z, pv.w};
#pragma unroll
            for (int e = 0; e < 4; ++e) {
              const int ee = hh * 4 + e;
              mxp[i][j][ee] = pack2(bflo(mxp[i][j][ee]) + sigmoidf_(acc[i][j][2 * ee] + bias) * bflo(pw[e]),
                                    bfhi(mxp[i][j][ee]) + sigmoidf_(acc[i][j][2 * ee + 1] + bias) * bfhi(pw[e]));
            }
          }
        }
    }
#pragma unroll
    for (int i = 0; i < 2; ++i)
#pragma unroll
      for (int j = 0; j < 2; ++j) {
        const int n = nt * 128 + wn * 64 + 32 * j + r31;
#pragma unroll
        for (int e = 0; e < 16; ++e) {
          const int m = mt * 128 + wm * 64 + 32 * i + crow(e, h);
          mixed[(size_t)m * 1024 + n] = (bf16_t)((e & 1) ? (mxp[i][j][e >> 1] >> 16) : (mxp[i][j][e >> 1] & 0xffffu));
        }
      }
  }
}

DI void phase6(const Params& p, int l, char* smraw) {
  bf16_t* sm = (bf16_t*)smraw;
  const bf16_t* mixed = (const bf16_t*)(p.ws + O_PR);
  const bf16_t* wto = (const bf16_t*)(p.ws + O_WTO);
  const float* xin = (l == 0) ? p.in[0] : p.out;
  const int lane = tidx() & 63, w = tidx() >> 6, wm = w >> 1, wn = w & 1, h = lane >> 5, r31 = lane & 31;
  for (int round = 0;; ++round) {
    int mt, nt;
    if (!xcd_tile<8, 8>(round, mt, nt)) break;
    f32x16 acc[2][2];
    gemm_plain(acc, mixed, 1024, mt * 128, wto, 1024, nt * 128, 1024, sm);
#pragma unroll
    for (int i = 0; i < 2; ++i)
#pragma unroll
      for (int j = 0; j < 2; ++j) {
        const int n = nt * 128 + wn * 64 + 32 * j + r31;
#pragma unroll
        for (int e = 0; e < 16; ++e) {
          const int m = mt * 128 + wm * 64 + 32 * i + crow(e, h);
          const size_t idx = (size_t)m * 1024 + n;
          p.out[idx] = xin[idx] + acc[i][j][e];
        }
      }
  }
}

#define XB_TMO      128
#define XB_XCNT(j)  (256  + 64 * (j))
#define XB_XSUB(j)  (1280 + 64 * (j))
#define XB_XGEN(j)  (2304 + 64 * (j))
#define XB_TOP      3328
#define XB_TOPGEN   3392
#define XCD_BAR_WORDS 3456
#define XB_SPIN_CAP (1u << 18)
#define LAS __attribute__((address_space(3)))

__device__ __forceinline__ unsigned xb_ld(unsigned* p)              { return __hip_atomic_load(p, __ATOMIC_RELAXED, __HIP_MEMORY_SCOPE_AGENT); }
__device__ __forceinline__ unsigned xb_add(unsigned* p, unsigned v) { return __hip_atomic_fetch_add(p, v, __ATOMIC_RELAXED, __HIP_MEMORY_SCOPE_AGENT); }
__device__ __forceinline__ unsigned xb_xcc_id() { return (unsigned)__builtin_amdgcn_s_getreg((3 << 11) | 20) & 0xFu; }
#define XB_SPIN(cond, bar) do { unsigned _sp = 0; while (cond) { __builtin_amdgcn_s_sleep(1); \
    if ((++_sp & 255u) == 0u) { if (xb_ld(&(bar)[XB_TMO])) break; if (_sp > XB_SPIN_CAP) { atomicAdd(&(bar)[XB_TMO], 1u); break; } } } } while (0)

struct XcdBarrier {
    unsigned* bar; unsigned x;
    volatile LAS unsigned* st;
};

__device__ __forceinline__ XcdBarrier xcd_barrier_post(unsigned* bar, volatile LAS unsigned* st) {
    XcdBarrier b; b.bar = bar; b.x = xb_xcc_id(); b.st = st;
    if (threadIdx.x == 0) (void)xb_add(&bar[XB_XCNT(b.x)], 1u);
    return b;
}
__device__ __forceinline__ void xcd_barrier_complete(unsigned* bar, unsigned x, unsigned& nloc, unsigned& nx) {
    const unsigned G = gridDim.x * gridDim.y * gridDim.z;
    unsigned sum, cnt, mine, sp = 0u;
    for (;;) {
        sum = 0u; cnt = 0u; mine = 0u;
#pragma unroll
        for (unsigned j = 0; j < 16; ++j) { const unsigned c = xb_ld(&bar[XB_XCNT(j)]); sum += c; cnt += (c > 0u) ? 1u : 0u; mine = (j == x) ? c : mine; }
        if (sum == G) break;
        __builtin_amdgcn_s_sleep(1);
        if ((++sp & 255u) == 0u) { if (xb_ld(&bar[XB_TMO])) break; if (sp > XB_SPIN_CAP) { atomicAdd(&bar[XB_TMO], 1u); break; } }
    }
    nloc = mine > 0u ? mine : 1u; nx = cnt > 0u ? cnt : 1u;
}

__device__ __forceinline__ void xcd_barrier(const XcdBarrier& b) {
    asm volatile("s_waitcnt vmcnt(0)" ::: "memory");
    __syncthreads();
    if (threadIdx.x == 0) {
        unsigned* bar = b.bar;
        __builtin_amdgcn_s_waitcnt(0);
        unsigned nloc = b.st[0], nx = b.st[1];
        if (nloc == 0u) { xcd_barrier_complete(bar, b.x, nloc, nx); b.st[0] = nloc; b.st[1] = nx; }
        const unsigned old = xb_add(&bar[XB_XSUB(b.x)], 1u);
        const unsigned gen = old / nloc;
        if (old + 1u == (gen + 1u) * nloc) {
            __builtin_amdgcn_fence(__ATOMIC_RELEASE, "agent");
            asm volatile("s_waitcnt vmcnt(0)" ::: "memory");
            const unsigned og = xb_add(&bar[XB_TOP], 1u);
            const unsigned tg = og / nx;
            if (og + 1u == (tg + 1u) * nx) xb_add(&bar[XB_TOPGEN], 1u);
            else XB_SPIN(xb_ld(&bar[XB_TOPGEN]) == tg, bar);
            __builtin_amdgcn_fence(__ATOMIC_ACQUIRE, "agent");
            xb_add(&bar[XB_XGEN(b.x)], 1u);
            asm volatile("s_waitcnt vmcnt(0)" ::: "memory");
        } else {
            XB_SPIN(xb_ld(&bar[XB_XGEN(b.x)]) == gen, bar);
            __builtin_amdgcn_fence(__ATOMIC_ACQUIRE, "agent");
            asm volatile("s_waitcnt vmcnt(0)" ::: "memory");
        }
    }
    __syncthreads();
}


__global__ void __launch_bounds__(256, 2) fwd_megakernel(Params p) {
  cg::grid_group grid = cg::this_grid();
  __shared__ __attribute__((aligned(16))) char smraw[SMEM_BYTES];
  __shared__ int s_item;
  __shared__ uint4 xb_words;
  if (threadIdx.x == 0) xb_words = make_uint4(0u, 0u, 0u, 0u);
  __syncthreads();
  XcdBarrier xb = xcd_barrier_post((unsigned*)(p.ws + O_BAR), (volatile LAS unsigned*)&xb_words);
  if (p.ws == nullptr) grid.sync();
  for (int l = 0; l < 2; ++l) {
    phase0(p, l, smraw);
    if (PROBE == 6) phase0(p, l, smraw);
    xcd_barrier(xb);
    phase1(p, smraw);
    if (PROBE == 2) phase1(p, smraw);
    xcd_barrier(xb);
    if (PROBE == 1) { for (int q = 0; q < 7; ++q) xcd_barrier(xb); }
    for (int it = bidx(); it < 128 + 512; it += gridDim.x) {
      if (it < 128) compress_tile(p, it, smraw, &s_item);
      else rwkv_prep(p, l, it - 128, smraw);
    }
    xcd_barrier(xb);
    {
      int* cnt = (int*)(p.ws + O_CNT) + l;
      for (int it = bidx(); it < 256; it += gridDim.x) { rwkv_scan(p, it, smraw); if (PROBE == 5) rwkv_scan(p, it, smraw); }
      while (true) {
        if (tidx() == 0) s_item = atomicAdd(cnt, 1);
        __syncthreads();
        const int item = s_item;
        __syncthreads();
        if (item >= 1024 + 512) break;
        if (PROBE == 4) { if (item < 1024) nsa_item(p, item, smraw, false); else swa_item(p, l, item - 1024, smraw, false); }
        if (item < 1024) nsa_item(p, item, smraw);
        else swa_item(p, l, item - 1024, smraw);
      }
    }
    xcd_barrier(xb);
    rwkv_post(p, l);
    xcd_barrier(xb);
    phase5(p, l, smraw);
    if (PROBE == 3) phase5(p, l, smraw);
    xcd_barrier(xb);
    phase6(p, l, smraw);
    if (PROBE == 8 && l == 0) phase6(p, l, smraw);
    xcd_barrier(xb);
  }
  rmsnorm_rows(p.out, p.in[28], nullptr, p.out);
}

extern "C" void kernel_launch(void* const* d_in, const int* in_sizes, int n_in, void* d_out, int out_size, void* d_ws,
                              size_t ws_size, hipStream_t stream) {
  static int grid_blocks = 0;
  if (!grid_blocks) {
    int dev = 0, cus = 0, per_cu = 0;
    hipGetDevice(&dev);
    hipDeviceGetAttribute(&cus, hipDeviceAttributeMultiprocessorCount, dev);
    hipOccupancyMaxActiveBlocksPerMultiprocessor(&per_cu, fwd_megakernel, 256, 0);
    if (per_cu > 2) per_cu = 2;
    grid_blocks = (cus * per_cu) & ~7;
    if (grid_blocks > 512) grid_blocks = 512;
  }
  if (ws_size < WS_TOTAL || grid_blocks < 128) {
    fprintf(stderr, "workspace too small or grid too small: %zu < %zu, grid %d\n", ws_size, (size_t)WS_TOTAL, grid_blocks);
    return;
  }
  Params p{};
  for (int i = 0; i < 29; ++i) p.in[i] = (const float*)d_in[i];
  p.out = (float*)d_out;
  p.ws = (char*)d_ws;
  hipMemsetAsync((char*)d_ws + O_BAR, 0, 16384, stream);
  void* args[] = {&p};
  hipError_t e = hipLaunchCooperativeKernel((void*)fwd_megakernel, dim3(grid_blocks), dim3(256), args, 0, stream);
  if (e != hipSuccess) fprintf(stderr, "cooperative launch failed: %s (grid %d)\n", hipGetErrorString(e), grid_blocks);
}
```

```cpp
#include <hip/hip_runtime.h>
#include <hip/hip_cooperative_groups.h>
#include <cstdio>
namespace cg = cooperative_groups;

#define DI __device__ __forceinline__
typedef unsigned short bf16_t;
typedef short bf16x8 __attribute__((ext_vector_type(8)));
typedef short s16x4 __attribute__((ext_vector_type(4)));
typedef float f32x16 __attribute__((ext_vector_type(16)));
typedef float f32x4 __attribute__((ext_vector_type(4)));
typedef unsigned u32x4 __attribute__((ext_vector_type(4)));
#define LAS __attribute__((address_space(3)))
typedef __bf16 bfv2 __attribute__((ext_vector_type(2)));
typedef float fv2 __attribute__((ext_vector_type(2)));
#define MFMA32(a, b, c) __builtin_amdgcn_mfma_f32_32x32x16_bf16((a), (b), (c), 0, 0, 0)

DI unsigned pack2(float a, float b) { fv2 v = {a, b}; return __builtin_bit_cast(unsigned, __builtin_convertvector(v, bfv2)); }
DI bf16_t f2bf(float a) { return (bf16_t)(pack2(a, 0.f) & 0xffffu); }
DI float bflo(unsigned u) { return __uint_as_float(u << 16); }
DI float bfhi(unsigned u) { return __uint_as_float(u & 0xffff0000u); }
DI float bf2f(bf16_t u) { return __uint_as_float(((unsigned)u) << 16); }
DI float sigmoidf_(float x) { return __builtin_amdgcn_rcpf(1.f + __expf(-x)); }
DI float siluf_(float x) { return x * __builtin_amdgcn_rcpf(1.f + __expf(-x)); }
DI int tidx() { int t = threadIdx.x; asm volatile("" : "+v"(t)); return t; }
DI int bidx() { int b = blockIdx.x; asm volatile("" : "+s"(b)); return b; }
DI float xor32_sum(float x) { auto r = __builtin_amdgcn_permlane32_swap(__float_as_uint(x), __float_as_uint(x), false, false); return __uint_as_float(r[0]) + __uint_as_float(r[1]); }
DI float xor32_max(float x) { auto r = __builtin_amdgcn_permlane32_swap(__float_as_uint(x), __float_as_uint(x), false, false); return fmaxf(__uint_as_float(r[0]), __uint_as_float(r[1])); }
DI float xor16_sum(float x) { auto r = __builtin_amdgcn_permlane16_swap(__float_as_uint(x), __float_as_uint(x), false, false); return __uint_as_float(r[0]) + __uint_as_float(r[1]); }
DI float fdpp_add(float x, const int sel) {
  int xi = __float_as_int(x), yi;
  if (sel == 0) yi = __builtin_amdgcn_update_dpp(0, xi, 0xB1, 0xF, 0xF, true);
  else if (sel == 1) yi = __builtin_amdgcn_update_dpp(0, xi, 0x4E, 0xF, 0xF, true);
  else if (sel == 2) yi = __builtin_amdgcn_update_dpp(0, xi, 0x141, 0xF, 0xF, true);
  else yi = __builtin_amdgcn_update_dpp(0, xi, 0x140, 0xF, 0xF, true);
  return x + __int_as_float(yi);
}
DI float wave_sum_fast(float v) { v = fdpp_add(v, 0); v = fdpp_add(v, 1); v = fdpp_add(v, 2); v = fdpp_add(v, 3); v = xor16_sum(v); return xor32_sum(v); }
DI int crow(int i, int h) { return (i & 3) + 8 * (i >> 2) + 4 * h; }

constexpr int T_ = 2048, NTOK = 16384, HS = 3840, NIN = 6808;
constexpr int C_AQ = 0, C_KC = 512, C_VC = 640, C_KS = 768, C_KW = 1024, C_AZ = 1280, C_BQ = 1792, C_BK = 2048,
              C_BZ = 2304, C_R = 2560, C_K = 2816, C_V = 3072, C_WD = 3328, C_CZ = 3456, C_GATE = 3712;

constexpr size_t al256(size_t x) { return (x + 255) & ~(size_t)255; }
constexpr size_t O_WTA = 0;
constexpr size_t O_WTM = O_WTA + (size_t)3840 * 1024 * 2;
constexpr size_t O_WTP = O_WTM + (size_t)3072 * 1024 * 2;
constexpr size_t O_WTO = O_WTP + (size_t)1024 * 1024 * 2;
constexpr size_t O_W1K = O_WTO + (size_t)1024 * 1024 * 2;
constexpr size_t O_W1V = O_W1K + (size_t)128 * 2048 * 2;
constexpr size_t O_W2K = O_W1V + (size_t)128 * 2048 * 2;
constexpr size_t O_W2V = O_W2K + (size_t)64 * 128 * 2;
constexpr size_t O_PEB = O_W2V + (size_t)64 * 128 * 2;
constexpr size_t O_LW2 = O_PEB + 1024;
constexpr size_t O_LA2 = O_LW2 + 256 * 64 * 2;
constexpr size_t O_V1T = O_LA2 + 256 * 64 * 2;
constexpr size_t O_V2T = O_V1T + 32 * 256 * 2;
constexpr size_t O_CNT = O_V2T + 256 * 32 * 2;
constexpr size_t O_BAR = O_CNT + 256;
constexpr size_t O_XN = O_BAR + 16384;
constexpr size_t O_H = O_XN + (size_t)NTOK * 1024 * 2;
constexpr size_t O_VT = O_H + (size_t)NTOK * HS * 2;
constexpr size_t O_KC = O_VT + (size_t)3 * 8 * 2 * 64 * 2048 * 2;
constexpr size_t O_VCT = O_KC + (size_t)16 * 128 * 64 * 2;
constexpr size_t O_VF = O_VCT + (size_t)16 * 128 * 64 * 2;
constexpr size_t O_YR = O_VF + (size_t)NTOK * 256 * 2;
constexpr size_t O_BON = O_YR + (size_t)NTOK * 256 * 2;
constexpr size_t O_PR = O_BON + (size_t)NTOK * 4 * 4;
constexpr size_t WS_TOTAL = O_PR + (size_t)NTOK * 4 * 384 * 2;

#ifndef PROBE
#define PROBE 0
#define PROBE_T 0
#define PROBE_TSCALE 0.0001f
#endif
struct Params {
  const float* in[29];
  float* out;
  char* ws;
};

typedef const __attribute__((address_space(4))) char* kaptr_t;
DI kaptr_t KA() { kaptr_t k = (kaptr_t)__builtin_amdgcn_kernarg_segment_ptr(); asm volatile("" : "+s"(k)); return k; }
DI const float* IN(int i) { return *(const float* const __attribute__((address_space(4)))*)(KA() + 8 * i); }
DI float* OUTP() { return *(float* const __attribute__((address_space(4)))*)(KA() + 8 * 29); }
DI char* WS(const Params&) { return *(char* const __attribute__((address_space(4)))*)(KA() + 8 * 30); }
constexpr int SMEM_BYTES = 73728;
constexpr int DYN_XB = 155648;
constexpr int DYN_LDS = DYN_XB + 64;
constexpr int LDT = 72;

#define G_LOAD(P, ao_, bo_) do { const long ao__ = (ao_); const int bo__ = (bo_); \
  P##a0 = *(const uint4*)(a0 + ao__); P##a1 = *(const uint4*)(a1 + ao__); P##a2 = *(const uint4*)(a2 + ao__); P##a3 = *(const uint4*)(a3 + ao__); \
  P##b0 = *(const uint4*)(b0 + bo__); P##b1 = *(const uint4*)(b1 + bo__); P##b2 = *(const uint4*)(b2 + bo__); P##b3 = *(const uint4*)(b3 + bo__); } while (0)
#define G_STORE(P, A_, B_) do { bf16_t* A__ = (A_); bf16_t* B__ = (B_); \
  *(uint4*)(A__ + (wr)*LDT + wc) = P##a0; *(uint4*)(A__ + (wr + 32) * LDT + wc) = P##a1; \
  *(uint4*)(A__ + (wr + 64) * LDT + wc) = P##a2; *(uint4*)(A__ + (wr + 96) * LDT + wc) = P##a3; \
  *(uint4*)(B__ + (wr)*LDT + wc) = P##b0; *(uint4*)(B__ + (wr + 32) * LDT + wc) = P##b1; \
  *(uint4*)(B__ + (wr + 64) * LDT + wc) = P##b2; *(uint4*)(B__ + (wr + 96) * LDT + wc) = P##b3; } while (0)
DI void g_compute(f32x16 (&acc)[2][2], const bf16_t* A_, const bf16_t* B_) {
  __builtin_amdgcn_s_setprio(1);
#pragma unroll
  for (int s = 0; s < 4; ++s) {
    bf16x8 fa0 = *(const bf16x8*)(A_ + 16 * s);
    bf16x8 fa1 = *(const bf16x8*)(A_ + 32 * LDT + 16 * s);
    bf16x8 fb0 = *(const bf16x8*)(B_ + 16 * s);
    bf16x8 fb1 = *(const bf16x8*)(B_ + 32 * LDT + 16 * s);
    acc[0][0] = MFMA32(fa0, fb0, acc[0][0]);
    acc[0][1] = MFMA32(fa0, fb1, acc[0][1]);
    acc[1][0] = MFMA32(fa1, fb0, acc[1][0]);
    acc[1][1] = MFMA32(fa1, fb1, acc[1][1]);
  }
  __builtin_amdgcn_s_setprio(0);
}
DI void gemm_core(f32x16 (&acc)[2][2], const bf16_t* a0, const bf16_t* a1, const bf16_t* a2, const bf16_t* a3, long aks,
                  const bf16_t* b0, const bf16_t* b1, const bf16_t* b2, const bf16_t* b3, int KT, bf16_t* sm, int tid) {
  const int lane = tid & 63, w = tid >> 6, wm = w >> 1, wn = w & 1, h = lane >> 5, r31 = lane & 31;
  bf16_t* As = sm;
  bf16_t* Bs = sm + 2 * 128 * LDT;
  const int wr = (tid >> 3), wc = (tid & 7) * 8;
#pragma unroll
  for (int i = 0; i < 2; ++i)
#pragma unroll
    for (int j = 0; j < 2; ++j)
#pragma unroll
      for (int e = 0; e < 16; ++e) acc[i][j][e] = 0.f;
  uint4 pa0, pa1, pa2, pa3, pb0, pb1, pb2, pb3, qa0, qa1, qa2, qa3, qb0, qb1, qb2, qb3;
  G_LOAD(p, 0, 0);
  G_LOAD(q, aks, 64);
  __syncthreads();
  G_STORE(p, As, Bs);
  __syncthreads();
  const int aoff = (wm * 64 + r31) * LDT + 8 * h, boff = (wn * 64 + r31) * LDT + 8 * h;
  for (int kt = 0; kt < KT; kt += 2) {
    if (kt + 2 < KT) G_LOAD(p, (long)(kt + 2) * aks, (kt + 2) * 64);
    __builtin_amdgcn_sched_barrier(0);
    g_compute(acc, As + aoff, Bs + boff);
    __builtin_amdgcn_sched_barrier(0);
    G_STORE(q, As + 128 * LDT, Bs + 128 * LDT);
    __syncthreads();
    if (kt + 3 < KT) G_LOAD(q, (long)(kt + 3) * aks, (kt + 3) * 64);
    __builtin_amdgcn_sched_barrier(0);
    g_compute(acc, As + 128 * LDT + aoff, Bs + 128 * LDT + boff);
    __builtin_amdgcn_sched_barrier(0);
    if (kt + 2 < KT) G_STORE(p, As, Bs);
    __syncthreads();
  }
}


constexpr int BM = 256, BK = 64, HALF = 128, HTB = HALF * BK * 2, STAGE_BYTES = 8 * HTB, NXCD = 8, WGM = 8;
DI int lds_byte(int r, int c) { const int st = (r >> 4) * 2 + (c >> 5), rr = r & 15, cc = c & 31, ob = rr * 64 + cc * 2; return st * 1024 + (ob ^ (((ob >> 9) & 1) << 5)); }
DI void stage_rc(int b, int& R, int& C) { const int st = b / 1024, sb = b % 1024, swz = sb ^ (((sb >> 9) & 1) << 5); R = (st >> 1) * 16 + swz / 64; C = (st & 1) * 32 + (swz % 64) / 2; }
DI int perm32(int rho) { const int n = rho >> 4, i = rho & 15; return 8 * (i >> 2) + 4 * n + (i & 3); }
struct Unit { int pm, pn; };
struct Gemm { const bf16_t* A; const bf16_t* Bt; int lda, ldb, K; };
struct StaticOrder {
    int nM, nN, nwg, G, c;
    DI void init(int M, int N, int G_, int c_) { nM = M / BM; nN = N / BM; nwg = nM * nN; G = G_; c = c_; }
    DI bool next(int i, Unit& u) const {
        const long L = (long)i * G + c; if (L >= nwg) return false;
        int wgid = (int)L; { const int q = nwg / NXCD, r = nwg % NXCD, xcd = wgid % NXCD, off = wgid / NXCD; wgid = (xcd < r ? xcd * (q + 1) : r * (q + 1) + (xcd - r) * q) + off; }
        const int nig = WGM * nN, gid = wgid / nig, fm = gid * WGM, gsz = (nM - fm) < WGM ? (nM - fm) : WGM;
        u.pm = fm + ((wgid % nig) % gsz); u.pn = (wgid % nig) / gsz; return true;
    }
    DI void a_ready(const Unit&) const {}
    DI void done(const Unit&) const {}
};
struct OneUnit { Unit u; DI bool next(int i, Unit& o) const { if (i) return false; o = u; return true; } DI void a_ready(const Unit&) const {} DI void done(const Unit&) const {} };
template <class Epi, class Sched>
DI void gemm_phase(LAS unsigned char* lds, const Gemm g, const Sched& S, const Epi& E) {
    const int tid = tidx(), wid = __builtin_amdgcn_readfirstlane(tid >> 6), lane = tid & 63, wr = wid >> 2, wc = wid & 3, fr = lane & 15, fq = lane >> 4;
    const int K = g.K, nt = K / BK;
    unsigned voffA[2], voffB[2];
#pragma unroll
    for (int i = 0; i < 2; ++i) { int R, C; stage_rc(tid * 16 + i * 8192, R, C); const int Rb = Epi::PERM ? ((R & ~31) + perm32(R & 31)) : R;
        voffA[i] = (unsigned)(R * g.lda + C) * 2u; voffB[i] = (unsigned)(Rb * g.ldb + C) * 2u; }
    const size_t kstep = (size_t)(BK * 2);
    const size_t hstepA = (size_t)HALF * g.lda * 2, hstepB = (size_t)HALF * g.ldb * 2;
    const size_t tstepA = 2 * hstepA, tstepB = 2 * hstepB;
    const unsigned ldsw = (unsigned)wid * 1024u;
    const int aoff = lds_byte(wr * 64 + fr, fq * 8), boff = lds_byte(wc * 32 + fr, fq * 8);
#define PG8_SA(b, h) (((b) * 2 + (h)) * HTB)
#define PG8_SB(b, h) ((4 + (b) * 2 + (h)) * HTB)
#define PG8_STAGE(bufoff, gbase, voff) do { _Pragma("unroll") for (int _i = 0; _i < 2; ++_i) \
        __builtin_amdgcn_global_load_lds((const unsigned*)((const char*)(gbase) + (voff)[_i]), (LAS unsigned*)(lds + (bufoff) + ldsw + _i * 8192), 16, 0, 0); } while (0)
#define PG8_LDA(dst, b, h) do { _Pragma("unroll") for (int m = 0; m < 4; ++m) _Pragma("unroll") for (int k = 0; k < 2; ++k) dst[m][k] = *(const LAS bf16x8*)(lds + PG8_SA(b, h) + aoff + m * 2048 + k * 1024); } while (0)
#define PG8_LDB(dst, b, h) do { _Pragma("unroll") for (int n = 0; n < 2; ++n) _Pragma("unroll") for (int k = 0; k < 2; ++k) dst[n][k] = *(const LAS bf16x8*)(lds + PG8_SB(b, h) + boff + n * 2048 + k * 1024); } while (0)
#define PG8_MMA(ai, bj, At, Bt) do { __builtin_amdgcn_s_setprio(1); _Pragma("unroll") for (int m = 0; m < 4; ++m) _Pragma("unroll") for (int n = 0; n < 2; ++n) _Pragma("unroll") for (int k = 0; k < 2; ++k) \
        acc[ai][bj][m][n] = __builtin_amdgcn_mfma_f32_16x16x32_bf16(Bt[n][k], At[m][k], acc[ai][bj][m][n], 0, 0, 0); __builtin_amdgcn_s_setprio(0); } while (0)
#define PG8_WAIT_V(n) asm volatile("s_waitcnt vmcnt(" #n ")" ::: "memory")
#define PG8_WAIT_L(n) asm volatile("s_waitcnt lgkmcnt(" #n ")" ::: "memory")
#define PG8_BAR __builtin_amdgcn_s_barrier()
#define PG8_SCHED __builtin_amdgcn_sched_barrier(0)
    Unit cur, nxt; int ui = 0;
    if (!S.next(0, cur)) return;
    f32x4 acc[2][2][4][2];
#pragma unroll
    for (int a = 0; a < 2; ++a)
#pragma unroll
        for (int b = 0; b < 2; ++b)
#pragma unroll
            for (int m = 0; m < 4; ++m)
#pragma unroll
                for (int n = 0; n < 2; ++n) acc[a][b][m][n] = (f32x4){0.f, 0.f, 0.f, 0.f};
    bf16x8 At[4][2], B0[2][2], B1[2][2];
    const char* cA = (const char*)g.A + (size_t)cur.pm * tstepA; const char* cB = (const char*)g.Bt + (size_t)cur.pn * tstepB;
    S.a_ready(cur);
    PG8_STAGE(PG8_SB(0, 0), cB, voffB); PG8_STAGE(PG8_SA(0, 0), cA, voffA); PG8_STAGE(PG8_SB(0, 1), cB + hstepB, voffB); PG8_STAGE(PG8_SA(0, 1), cA + hstepA, voffA);
    if (wr == 1) PG8_BAR;
    PG8_WAIT_V(4); PG8_BAR;
    PG8_STAGE(PG8_SB(1, 0), cB + kstep, voffB); PG8_STAGE(PG8_SA(1, 0), cA + kstep, voffA); PG8_STAGE(PG8_SB(1, 1), cB + hstepB + kstep, voffB);
    PG8_WAIT_V(6); PG8_BAR;
    for (;;) {
        const bool has_next = S.next(ui + 1, nxt);
        const char* nA = has_next ? (const char*)g.A + (size_t)nxt.pm * tstepA : cA; const char* nB = has_next ? (const char*)g.Bt + (size_t)nxt.pn * tstepB : cB;
        for (int t = 0; t < nt; t += 2) {
            const bool last = (t == nt - 2);
            const char* a1 = cA + (size_t)(t + 1) * kstep;
            const char* a2 = last ? nA : cA + (size_t)(t + 2) * kstep; const char* b2 = last ? nB : cB + (size_t)(t + 2) * kstep;
            const char* a3 = a2 + kstep; const char* b3 = b2 + kstep;
            if (last && has_next) S.a_ready(nxt);
            PG8_LDB(B0, 0, 0); PG8_SCHED; PG8_LDA(At, 0, 0); PG8_STAGE(PG8_SA(1, 1), a1 + hstepA, voffA);
            PG8_WAIT_L(8); PG8_BAR; PG8_WAIT_L(0); PG8_MMA(0, 0, At, B0); PG8_BAR; PG8_SCHED;
            PG8_LDB(B1, 0, 1); PG8_STAGE(PG8_SB(0, 0), b2, voffB);
            PG8_BAR; PG8_WAIT_L(0); PG8_MMA(0, 1, At, B1); PG8_BAR;
            PG8_LDA(At, 0, 1); PG8_STAGE(PG8_SA(0, 0), a2, voffA);
            PG8_BAR; PG8_WAIT_L(0); PG8_MMA(1, 0, At, B0); PG8_BAR; PG8_SCHED;
            PG8_STAGE(PG8_SB(0, 1), b2 + hstepB, voffB);
            PG8_WAIT_V(6); PG8_BAR; PG8_MMA(1, 1, At, B1); PG8_BAR;
            PG8_LDB(B0, 1, 0); PG8_SCHED; PG8_LDA(At, 1, 0); PG8_STAGE(PG8_SA(0, 1), a2 + hstepA, voffA);
            PG8_WAIT_L(8); PG8_BAR; PG8_WAIT_L(0); PG8_MMA(0, 0, At, B0); PG8_BAR; PG8_SCHED;
            PG8_LDB(B1, 1, 1); PG8_STAGE(PG8_SB(1, 0), b3, voffB);
            PG8_BAR; PG8_WAIT_L(0); PG8_MMA(0, 1, At, B1); PG8_BAR;
            PG8_LDA(At, 1, 1); PG8_STAGE(PG8_SA(1, 0), a3, voffA);
            PG8_BAR; PG8_WAIT_L(0); PG8_MMA(1, 0, At, B0); PG8_BAR; PG8_SCHED;
            PG8_STAGE(PG8_SB(1, 1), b3 + hstepB, voffB);
            PG8_WAIT_V(6); PG8_BAR; PG8_MMA(1, 1, At, B1); PG8_BAR;
        }
        if constexpr (!Epi::AFTER_DRAIN) { E(acc, cur, wr, wc, fr, fq); S.done(cur); }
        if (!has_next) break;
#pragma unroll
        for (int a = 0; a < 2; ++a)
#pragma unroll
            for (int b = 0; b < 2; ++b)
#pragma unroll
                for (int m = 0; m < 4; ++m)
#pragma unroll
                    for (int n = 0; n < 2; ++n) acc[a][b][m][n] = (f32x4){0.f, 0.f, 0.f, 0.f};
        cur = nxt; cA = nA; cB = nB; ++ui;
    }
    PG8_WAIT_V(0);
    if (wr == 0) PG8_BAR;
    PG8_BAR;
    if constexpr (Epi::AFTER_DRAIN) { E.fused(acc, cur, wr, wc, fr, fq, lds, wid, lane); S.done(cur); }
#undef PG8_SA
#undef PG8_SB
#undef PG8_STAGE
#undef PG8_LDA
#undef PG8_LDB
#undef PG8_MMA
#undef PG8_WAIT_V
#undef PG8_WAIT_L
#undef PG8_BAR
#undef PG8_SCHED
}

struct TJob { const float* src; int ld; int mode; bf16_t* dst; int ldd; int ntn; int ntk; };

DI TJob get_job(int j, const Params& p, int l) {
  char* ws = WS(p);
  TJob t;
  switch (j) {
    case 0: t = {IN(2) + (size_t)l * 1024 * NIN, NIN, 1, (bf16_t*)(ws + O_WTA), 1024, 60, 16}; break;
    case 1: t = {IN(2) + (size_t)l * 1024 * NIN + 3736, NIN, 0, (bf16_t*)(ws + O_WTM), 1024, 48, 16}; break;
    case 2: t = {IN(24) + (size_t)l * 512 * 1024, 1024, 0, (bf16_t*)(ws + O_WTP), 1024, 16, 8}; break;
    case 3: t = {IN(25) + (size_t)l * 256 * 1024, 1024, 0, (bf16_t*)(ws + O_WTP) + 512, 1024, 16, 4}; break;
    case 4: t = {IN(26) + (size_t)l * 256 * 1024, 1024, 0, (bf16_t*)(ws + O_WTP) + 768, 1024, 16, 4}; break;
    case 5: t = {IN(27) + (size_t)l * 1024 * 1024, 1024, 0, (bf16_t*)(ws + O_WTO), 1024, 16, 16}; break;
    case 6: t = {IN(5) + (size_t)l * 2048 * 128, 128, 0, (bf16_t*)(ws + O_W1K), 2048, 2, 32}; break;
    case 7: t = {IN(8) + (size_t)l * 2048 * 128, 128, 0, (bf16_t*)(ws + O_W1V), 2048, 2, 32}; break;
    case 8: t = {IN(6) + (size_t)l * 128 * 64, 64, 0, (bf16_t*)(ws + O_W2K), 128, 1, 2}; break;
    case 9: t = {IN(9) + (size_t)l * 128 * 64, 64, 0, (bf16_t*)(ws + O_W2V), 128, 1, 2}; break;
    case 10: t = {IN(13) + (size_t)l * 64 * 256, 256, 0, (bf16_t*)(ws + O_LW2), 64, 4, 1}; break;
    default: t = {IN(15) + (size_t)l * 64 * 256, 256, 0, (bf16_t*)(ws + O_LA2), 64, 4, 1}; break;
  }
  return t;
}

struct TrTile { TJob jb; int n0, k0; bool valid; };
DI TrTile tr_find(const Params& p, int l, int id) {
  TrTile t; t.valid = id < 2380;
  int rem = t.valid ? id : 0;
  t.jb = get_job(0, p, l);
  for (int j = 0; j < 12; ++j) {
    t.jb = get_job(j, p, l);
    const int cnt = t.jb.ntn * t.jb.ntk;
    if (rem < cnt) break;
    rem -= cnt;
  }
  t.n0 = (rem / t.jb.ntk) * 64; t.k0 = (rem % t.jb.ntk) * 64;
  return t;
}
DI void tr_load(const TrTile& t, int tid, float4 (&r)[4]) {
  const int n4 = (tid & 15) * 4;
  const int c = t.n0 + n4;
  int oc = c; bool cv = t.valid;
  if (t.jb.mode == 1) {
    if (c < 1280) oc = c; else if (c < 3712) oc = c + 24; else if (c < 3736) oc = c - 3712 + 1280; else { oc = 0; cv = false; }
  }
#pragma unroll
  for (int pz = 0; pz < 4; ++pz) {
    const int kk = (tid >> 4) + 16 * pz;
    r[pz] = make_float4(0.f, 0.f, 0.f, 0.f);
    if (cv) r[pz] = *(const float4*)(t.jb.src + (size_t)(t.k0 + kk) * t.jb.ld + oc);
  }
}
DI void tr_put(float* tile, int tid, const float4 (&r)[4]) {
  const int n4 = (tid & 15) * 4;
#pragma unroll
  for (int pz = 0; pz < 4; ++pz) {
    const int kk = (tid >> 4) + 16 * pz;
    tile[kk * 65 + n4 + 0] = r[pz].x; tile[kk * 65 + n4 + 1] = r[pz].y; tile[kk * 65 + n4 + 2] = r[pz].z; tile[kk * 65 + n4 + 3] = r[pz].w;
  }
}
DI void tr_store(const TrTile& t, const float* tile, int tid) {
  if (t.valid) {
#pragma unroll
    for (int pz = 0; pz < 2; ++pz) {
      const int q = tid + 256 * pz;
      const int nn = q >> 3, kc = (q & 7) * 8;
      uint4 o;
      o.x = pack2(tile[(kc + 0) * 65 + nn], tile[(kc + 1) * 65 + nn]);
      o.y = pack2(tile[(kc + 2) * 65 + nn], tile[(kc + 3) * 65 + nn]);
      o.z = pack2(tile[(kc + 4) * 65 + nn], tile[(kc + 5) * 65 + nn]);
      o.w = pack2(tile[(kc + 6) * 65 + nn], tile[(kc + 7) * 65 + nn]);
      *(uint4*)(t.jb.dst + (size_t)(t.n0 + nn) * t.jb.ldd + t.k0 + kc) = o;
    }
  }
}

DI float wave_sum(float v) {
#pragma unroll
  for (int o = 32; o > 0; o >>= 1) v += __shfl_xor(v, o, 64);
  return v;
}

DI void rmsnorm_rows(const float* x, const float* g, bf16_t* outb, float* outf) {
  const int lane = tidx() & 63, w = tidx() >> 6;
  for (int it = bidx(); it < NTOK / 16; it += gridDim.x) {
    float4 v[2][4]; float ss[2] = {0.f, 0.f};
#pragma unroll
    for (int rr = 0; rr < 2; ++rr) {
      const float* xr = x + (size_t)(it * 16 + rr * 8 + w) * 1024;
#pragma unroll
      for (int i = 0; i < 4; ++i) v[rr][i] = *(const float4*)(xr + lane * 4 + 256 * i);
    }
    float4 gg[4];
#pragma unroll
    for (int i = 0; i < 4; ++i) gg[i] = *(const float4*)(g + lane * 4 + 256 * i);
#pragma unroll
    for (int rr = 0; rr < 2; ++rr) {
#pragma unroll
      for (int i = 0; i < 4; ++i) ss[rr] += v[rr][i].x * v[rr][i].x + v[rr][i].y * v[rr][i].y + v[rr][i].z * v[rr][i].z + v[rr][i].w * v[rr][i].w;
      ss[rr] = wave_sum_fast(ss[rr]);
    }
#pragma unroll
    for (int rr = 0; rr < 2; ++rr) {
      const int row = it * 16 + rr * 8 + w;
      const float rs = rsqrtf(ss[rr] * (1.f / 1024.f) + 1e-6f);
#pragma unroll
      for (int i = 0; i < 4; ++i) {
        const float o0 = v[rr][i].x * rs * gg[i].x, o1 = v[rr][i].y * rs * gg[i].y, o2 = v[rr][i].z * rs * gg[i].z, o3 = v[rr][i].w * rs * gg[i].w;
        if (outf) { *(float4*)(outf + (size_t)row * 1024 + lane * 4 + 256 * i) = make_float4(o0, o1, o2, o3); }
        else { uint2 o; o.x = pack2(o0, o1); o.y = pack2(o2, o3); *(uint2*)(outb + (size_t)row * 1024 + lane * 4 + 256 * i) = o; }
      }
    }
  }
}

DI void phase0(const Params& p, int l, char* smraw) {
  const int half = tidx() >> 8, ltid = tidx() & 255;
  float* tile = (float*)(smraw + half * 17408);
  {
    int id0 = bidx() * 2;
    TrTile cur = tr_find(p, l, id0 + half);
    float4 rg[4];
    tr_load(cur, ltid, rg);
    while (id0 < 2380) {
      tr_put(tile, ltid, rg);
      __syncthreads();
      const int id1 = id0 + gridDim.x * 2;
      TrTile nxt = tr_find(p, l, id1 + half);
      if (id1 < 2380) tr_load(nxt, ltid, rg);
      tr_store(cur, tile, ltid);
      __syncthreads();
      cur = nxt; id0 = id1;
    }
  }
  const float* xin = (l == 0) ? IN(0) : OUTP();
  rmsnorm_rows(xin, IN(1) + l * 1024, (bf16_t*)(WS(p) + O_XN), nullptr);
  const int gtid = bidx() * 512 + tidx(), nth = gridDim.x * 512;
  if (l == 1) {
    bf16_t* v1t = (bf16_t*)(WS(p) + O_V1T); bf16_t* v2t = (bf16_t*)(WS(p) + O_V2T);
    const float* v1 = IN(22); const float* v2 = IN(23);
    for (int idx = gtid; idx < 8192; idx += nth) {
      { const int j = idx >> 8, c = idx & 255; v1t[idx] = f2bf(v1[c * 32 + j]); }
      { const int c = idx >> 5, j = idx & 31; v2t[idx] = f2bf(v2[j * 256 + c]); }
    }
  }
  {
    bf16_t* kc = (bf16_t*)(WS(p) + O_KC); bf16_t* vct = (bf16_t*)(WS(p) + O_VCT);
    for (int idx = gtid; idx < 1024; idx += nth) {
      const int bg = idx >> 6, d = idx & 63;
      kc[(bg * 128 + 127) * 64 + d] = 0; vct[(bg * 64 + d) * 128 + 127] = 0;
    }
    if (gtid == 0) { ((int*)(WS(p) + O_CNT))[l] = 0; }
    if (gtid == 1) { ((int*)(WS(p) + O_CNT))[4 + l] = 0; }
  }
  {
    const int lane = tidx() & 63, gw = bidx() * 8 + (tidx() >> 6), nw = gridDim.x * 8;
    float* peb = (float*)(WS(p) + O_PEB);
    for (int o = gw; o < 256; o += nw) {
      const int which = o >> 7, n = o & 127;
      const float* pe = (which ? IN(7) : IN(4)) + (size_t)l * 2048;
      const float* w1 = (which ? IN(8) : IN(5)) + (size_t)l * 2048 * 128;
      float s = 0.f;
      float pa[32], pb[32];
#pragma unroll
      for (int i = 0; i < 32; ++i) { const int k = lane + 64 * i; pa[i] = pe[k]; pb[i] = w1[(size_t)k * 128 + n]; }
#pragma unroll
      for (int i = 0; i < 32; ++i) s += pa[i] * pb[i];
      s = wave_sum(s);
      if (lane == 0) peb[o] = s;
    }
  }
}

DI u32x4 pack8(const f32x4& a, const f32x4& b) {
  u32x4 w; w.x = pack2(a[0], a[1]); w.y = pack2(a[2], a[3]); w.z = pack2(b[0], b[1]); w.w = pack2(b[2], b[3]); return w;
}
struct EpiH {
  static constexpr bool PERM = true, AFTER_DRAIN = false;
  bf16_t* H; bf16_t* VT;
  DI void operator()(const f32x4 (&acc)[2][2][4][2], const Unit& u, int wr, int wc, int fr, int fq) const {
    const int row0 = u.pm * BM + wr * 64 + fr;
    const int cl = wc * 32 + 8 * fq;
    const int which = (u.pn == 3) ? 0 : (u.pn == 4) ? 1 : (u.pn == 8) ? 2 : -1;
#pragma unroll
    for (int ai = 0; ai < 2; ++ai)
#pragma unroll
      for (int m = 0; m < 4; ++m) {
        const int row = row0 + ai * HALF + m * 16;
        *(u32x4*)(H + (size_t)row * HS + u.pn * BM + cl) = pack8(acc[ai][0][m][0], acc[ai][0][m][1]);
        if (which < 0) {
          *(u32x4*)(H + (size_t)row * HS + u.pn * BM + HALF + cl) = pack8(acc[ai][1][m][0], acc[ai][1][m][1]);
        } else {
          const int b = row >> 11, t = row & 2047;
          bf16_t* vp = VT + ((size_t)((which * 8 + b) * 128 + cl)) * 2048 + t;
#pragma unroll
          for (int j = 0; j < 4; ++j) { vp[(size_t)j * 2048] = f2bf(acc[ai][1][m][0][j]); vp[(size_t)(4 + j) * 2048] = f2bf(acc[ai][1][m][1][j]); }
        }
      }
  }
};
DI void phase1(const Params& p, char* smraw) {
  Gemm g{(const bf16_t*)(WS(p) + O_XN), (const bf16_t*)(WS(p) + O_WTA), 1024, 1024, 1024};
  StaticOrder S; S.init(NTOK, HS, gridDim.x, bidx());
  EpiH E{(bf16_t*)(WS(p) + O_H), (bf16_t*)(WS(p) + O_VT)};
  gemm_phase<EpiH, StaticOrder>((LAS unsigned char*)smraw, g, S, E);
}

DI void compress_tile2(const Params& p, int l_, int tix, char* smraw) {
  const int half = tidx() >> 8, tid = tidx() & 255;
  const int which = tix >> 4, mt = tix & 15;
  bf16_t* sm = (bf16_t*)(smraw + half * SMEM_BYTES);
  const bf16_t* hb = (const bf16_t*)(WS(p) + O_H);
  const bf16_t* w1t = (const bf16_t*)(WS(p) + (which ? O_W1V : O_W1K));
  const bf16_t* w2t = (const bf16_t*)(WS(p) + (which ? O_W2V : O_W2K));
  const float* peb = (const float*)(WS(p) + O_PEB) + which * 128;
  const int lane = tid & 63, w = tid >> 6, wm = w >> 1, wn = w & 1, h = lane >> 5, r31 = lane & 31;
  const int wr = tid >> 3, wc = (tid & 7) * 8;
  const int col0 = which ? C_VC : C_KC;
  const bf16_t* ap[4];
#pragma unroll
  for (int i = 0; i < 4; ++i) {
    int m = mt * 128 + wr + 32 * i; if (m >= 2032) m = 0;
    const int b = m / 254, rem = m - b * 254, n = rem >> 1, g = rem & 1;
    ap[i] = hb + ((size_t)(b * 2048 + 16 * n + 16 * half)) * HS + col0 + g * 64 + wc;
  }
  const bf16_t* b0 = w1t + (size_t)wr * 2048 + wc + half * 1024;
  f32x16 acc[2][2];
  gemm_core(acc, ap[0], ap[1], ap[2], ap[3], HS, b0, b0 + 32 * 2048, b0 + 64 * 2048, b0 + 96 * 2048, 16, sm, tid);
  float4* part = (float4*)(smraw + SMEM_BYTES);
  if (half == 1) {
#pragma unroll
    for (int i = 0; i < 2; ++i)
#pragma unroll
      for (int j = 0; j < 2; ++j)
#pragma unroll
        for (int q = 0; q < 4; ++q)
          part[((i * 2 + j) * 4 + q) * 256 + tid] = make_float4(acc[i][j][4 * q], acc[i][j][4 * q + 1], acc[i][j][4 * q + 2], acc[i][j][4 * q + 3]);
  }
  __syncthreads();
  bf16_t* Hs = (bf16_t*)smraw;
  if (half == 0) {
#pragma unroll
    for (int i = 0; i < 2; ++i)
#pragma unroll
      for (int j = 0; j < 2; ++j) {
        const int n = wn * 64 + 32 * j + r31;
        const float bias = peb[n];
#pragma unroll
        for (int q = 0; q < 4; ++q) {
          const float4 o = part[((i * 2 + j) * 4 + q) * 256 + tid];
          const int r = wm * 64 + 32 * i + 8 * q + 4 * h;
          Hs[(r + 0) * 136 + n] = f2bf(siluf_(acc[i][j][4 * q + 0] + o.x + bias));
          Hs[(r + 1) * 136 + n] = f2bf(siluf_(acc[i][j][4 * q + 1] + o.y + bias));
          Hs[(r + 2) * 136 + n] = f2bf(siluf_(acc[i][j][4 * q + 2] + o.z + bias));
          Hs[(r + 3) * 136 + n] = f2bf(siluf_(acc[i][j][4 * q + 3] + o.w + bias));
        }
      }
  }
  __syncthreads();
  if (half == 0) {
    f32x16 o2[2];
#pragma unroll
    for (int j = 0; j < 2; ++j)
#pragma unroll
      for (int e = 0; e < 16; ++e) o2[j][e] = 0.f;
#pragma unroll
    for (int s = 0; s < 8; ++s) {
      const bf16x8 fa = *(const bf16x8*)(Hs + (w * 32 + r31) * 136 + 16 * s + 8 * h);
#pragma unroll
      for (int j = 0; j < 2; ++j) {
        const bf16x8 fb = *(const bf16x8*)(w2t + (32 * j + r31) * 128 + 16 * s + 8 * h);
        o2[j] = MFMA32(fa, fb, o2[j]);
      }
    }
    bf16_t* kc = (bf16_t*)(WS(p) + O_KC); bf16_t* vct = (bf16_t*)(WS(p) + O_VCT);
#pragma unroll
    for (int j = 0; j < 2; ++j) {
      const int d = 32 * j + r31;
#pragma unroll
      for (int e = 0; e < 16; ++e) {
        const int m = mt * 128 + w * 32 + crow(e, h);
        if (m < 2032) {
          const int b = m / 254, rem = m - b * 254, n = rem >> 1, g = rem & 1;
          if (which == 0) kc[((size_t)((b * 2 + g) * 128 + n)) * 64 + d] = f2bf(o2[j][e]);
          else vct[((size_t)((b * 2 + g) * 64 + d)) * 128 + n] = f2bf(o2[j][e]);
        }
      }
    }
  }
  __builtin_amdgcn_fence(__ATOMIC_RELEASE, "agent");
  __syncthreads();
  if (tidx() == 0) atomicAdd((int*)(WS(p) + O_CNT) + 4 + l_, 1);
}

DI void rwkv_prep(const Params& p, int l, int item, char* smraw) {
  const bf16_t* hb = (const bf16_t*)(WS(p) + O_H);
  bf16_t* A1 = (bf16_t*)smraw;
  bf16_t* A2 = A1 + 64 * LDT;
  bf16_t* A3 = A2 + 64 * LDT;
  const int tid = tidx(), lane = tid & 63, w = (tid >> 6) & 3, tt = tid >> 8, h = lane >> 5, r31 = lane & 31;
  const int T0 = item * 64;
  const float* mu = IN(11) + l * 896;
  __syncthreads();
  bf16_t* SR = A3 + 64 * 264;
  {
    const bool seqstart = (T0 & 2047) == 0;
    uint4 sv[13];
#pragma unroll
    for (int i = 0; i < 13; ++i) {
      const int idx = tid + 512 * i, row = idx / 96, c = idx - row * 96;
      sv[i] = make_uint4(0, 0, 0, 0);
      if (idx < 65 * 96 && (row > 0 || !seqstart)) sv[i] = *(const uint4*)(hb + (size_t)(T0 - 1 + row) * HS + C_R + c * 8);
    }
#pragma unroll
    for (int i = 0; i < 13; ++i) {
      const int idx = tid + 512 * i, row = idx / 96, c = idx - row * 96;
      if (idx < 65 * 96) *(uint4*)(SR + row * 776 + c * 8) = sv[i];
    }
  }
#pragma unroll
  for (int idx = tid; idx < 64 * 16; idx += 512) {
    const int tok = idx >> 4, c8 = idx & 15;
    const size_t m = (size_t)(T0 + tok);
    const uint4 z = *(const uint4*)(hb + m * HS + C_WD + c8 * 8);
    uint4 zp = make_uint4(0, 0, 0, 0);
    if (((T0 + tok) & 2047) != 0) zp = *(const uint4*)(hb + (m - 1) * HS + C_WD + c8 * 8);
    const unsigned zz[4] = {z.x, z.y, z.z, z.w}, pp[4] = {zp.x, zp.y, zp.z, zp.w};
    unsigned oo[4];
#pragma unroll
    for (int e = 0; e < 4; ++e) {
      const float m0 = mu[768 + c8 * 8 + 2 * e], m1 = mu[768 + c8 * 8 + 2 * e + 1];
      float x0 = bflo(zz[e]), x1 = bfhi(zz[e]);
      x0 = x0 + (bflo(pp[e]) - x0) * m0; x1 = x1 + (bfhi(pp[e]) - x1) * m1;
      if (c8 < 8) { x0 = 1.f - 2.f * __builtin_amdgcn_rcpf(__expf(2.f * x0) + 1.f); x1 = 1.f - 2.f * __builtin_amdgcn_rcpf(__expf(2.f * x1) + 1.f); }
      oo[e] = pack2(x0, x1);
    }
    bf16_t* dst = (c8 < 8) ? (A1 + tok * LDT + c8 * 8) : (A2 + tok * LDT + (c8 - 8) * 8);
    *(uint4*)dst = make_uint4(oo[0], oo[1], oo[2], oo[3]);
  }
  __syncthreads();
  if (l == 1) {
    for (int idx = tid; idx < 64 * 32; idx += 512) {
      const int tok = idx >> 5, c8 = idx & 31;
      const size_t m = (size_t)(T0 + tok);
      const uint4 z = *(const uint4*)(SR + (tok + 1) * 776 + 512 + c8 * 8);
      const uint4 zp = *(const uint4*)(SR + tok * 776 + 512 + c8 * 8);
      const unsigned zz[4] = {z.x, z.y, z.z, z.w}, pp[4] = {zp.x, zp.y, zp.z, zp.w};
      unsigned oo[4];
#pragma unroll
      for (int e = 0; e < 4; ++e) {
        const float m0 = mu[512 + c8 * 8 + 2 * e], m1 = mu[512 + c8 * 8 + 2 * e + 1];
        float x0 = bflo(zz[e]), x1 = bfhi(zz[e]);
        x0 = x0 + (bflo(pp[e]) - x0) * m0; x1 = x1 + (bfhi(pp[e]) - x1) * m1;
        oo[e] = pack2(x0, x1);
      }
      *(uint4*)(A3 + tok * 264 + c8 * 8) = make_uint4(oo[0], oo[1], oo[2], oo[3]);
    }
  }
  __syncthreads();
  const bf16_t* lw2 = (const bf16_t*)(WS(p) + O_LW2);
  const bf16_t* la2 = (const bf16_t*)(WS(p) + O_LA2);
  const bf16_t* v1t = (const bf16_t*)(WS(p) + O_V1T);
  const bf16_t* v2t = (const bf16_t*)(WS(p) + O_V2T);
  const float* w0 = IN(12) + l * 256; const float* a0 = IN(14) + l * 256;
  const float* kkw = IN(16) + l * 256; const float* kaw = IN(17) + l * 256; const float* rkw = IN(18) + l * 256;
  const float* v0 = IN(21);
  bf16_t* vf = (bf16_t*)(WS(p) + O_VF);
  bf16_t* pr = (bf16_t*)(WS(p) + O_PR);
  float* bon = (float*)(WS(p) + O_BON);
  {
    const int tokl = 32 * tt + r31;
    const size_t m = (size_t)(T0 + tokl);
    const bool first = (((T0 + tokl) & 2047) == 0);
    const int b = (int)(m >> 11), t = (int)(m & 2047);
    float ss = 0.f;
#pragma unroll
    for (int nt = 0; nt < 2; ++nt)
#pragma unroll
      for (int q = 0; q < 4; ++q) {
        const int c = w * 64 + 32 * nt + 8 * q + 4 * h;
        const uint2 zk = *(const uint2*)(SR + (tokl + 1) * 776 + 256 + c);
        const uint2 pk_ = *(const uint2*)(SR + tokl * 776 + 256 + c);
        const float4 muk = *(const float4*)(mu + 256 + c);
        const float4 kw4 = *(const float4*)(kkw + c);
        float x0 = bflo(zk.x), x1 = bfhi(zk.x), x2 = bflo(zk.y), x3 = bfhi(zk.y);
        x0 = (x0 + (bflo(pk_.x) - x0) * muk.x) * kw4.x; x1 = (x1 + (bfhi(pk_.x) - x1) * muk.y) * kw4.y;
        x2 = (x2 + (bflo(pk_.y) - x2) * muk.z) * kw4.z; x3 = (x3 + (bfhi(pk_.y) - x3) * muk.w) * kw4.w;
        ss += x0 * x0 + x1 * x1 + x2 * x2 + x3 * x3;
      }
    ss = xor32_sum(ss);
    const float inv = 1.f / fmaxf(sqrtf(ss), 1e-12f);
    float bsum = 0.f;
    bf16_t* prow = pr + ((size_t)((b * 4 + w) * 2048 + t)) * 384;
#pragma unroll 1
    for (int nt = 0; nt < 2; ++nt) {
      f32x16 aw, aa, av;
#pragma unroll
      for (int e = 0; e < 16; ++e) { aw[e] = 0.f; aa[e] = 0.f; av[e] = 0.f; }
#pragma unroll
      for (int s = 0; s < 4; ++s) {
        const bf16x8 f1 = *(const bf16x8*)(A1 + (32 * tt + r31) * LDT + 16 * s + 8 * h);
        const bf16x8 f2 = *(const bf16x8*)(A2 + (32 * tt + r31) * LDT + 16 * s + 8 * h);
        const bf16x8 gw = *(const bf16x8*)(lw2 + (w * 64 + 32 * nt + r31) * 64 + 16 * s + 8 * h);
        const bf16x8 ga = *(const bf16x8*)(la2 + (w * 64 + 32 * nt + r31) * 64 + 16 * s + 8 * h);
        aw = MFMA32(gw, f1, aw);
        aa = MFMA32(ga, f2, aa);
      }
      if (l == 1) {
        f32x16 t1;
#pragma unroll
        for (int e = 0; e < 16; ++e) t1[e] = 0.f;
#pragma unroll
        for (int s = 0; s < 16; ++s) {
          const bf16x8 fv = *(const bf16x8*)(A3 + (32 * tt + r31) * 264 + 16 * s + 8 * h);
          const bf16x8 g1 = *(const bf16x8*)(v1t + r31 * 256 + 16 * s + 8 * h);
          t1 = MFMA32(g1, fv, t1);
        }
#pragma unroll
        for (int s = 0; s < 2; ++s) {
          unsigned pk[4];
#pragma unroll
          for (int e = 0; e < 4; ++e) pk[e] = pack2(t1[8 * s + 2 * e], t1[8 * s + 2 * e + 1]);
          const bf16x8 fb = __builtin_bit_cast(bf16x8, make_uint4(pk[0], pk[1], pk[2], pk[3]));
          const bf16_t* vr = v2t + (w * 64 + 32 * nt + r31) * 32 + 16 * s + 4 * h;
          const uint2 lo = *(const uint2*)vr; const uint2 hi = *(const uint2*)(vr + 8);
          const bf16x8 fa = __builtin_bit_cast(bf16x8, make_uint4(lo.x, lo.y, hi.x, hi.y));
          av = MFMA32(fa, fb, av);
        }
      }
      uint2 sto[4][6];
#pragma unroll
      for (int q = 0; q < 4; ++q) {
        const int cl = 32 * nt + 8 * q + 4 * h;
        const int c = w * 64 + cl;
        const uint2 zr = *(const uint2*)(SR + (tokl + 1) * 776 + c);
        const uint2 zk = *(const uint2*)(SR + (tokl + 1) * 776 + 256 + c);
        const uint2 zv = *(const uint2*)(SR + (tokl + 1) * 776 + 512 + c);
        const uint2 pr_ = *(const uint2*)(SR + tokl * 776 + c);
        const uint2 pk_ = *(const uint2*)(SR + tokl * 776 + 256 + c);
        const uint2 pv_ = *(const uint2*)(SR + tokl * 776 + 512 + c);
        uint2 vfl = make_uint2(0, 0);
        if (l == 1) vfl = *(const uint2*)(vf + m * 256 + c);
        float orr[4], ou[4], okp[4], ovv[4], oa[4], ob[4];
#pragma unroll
        for (int e = 0; e < 4; ++e) {
          const int cc = c + e; const int i = 4 * q + e;
          const unsigned zru = (e < 2) ? zr.x : zr.y, zku = (e < 2) ? zk.x : zk.y, zvu = (e < 2) ? zv.x : zv.y;
          const unsigned pru = (e < 2) ? pr_.x : pr_.y, pku = (e < 2) ? pk_.x : pk_.y, pvu = (e < 2) ? pv_.x : pv_.y;
          const unsigned vfu = (e < 2) ? vfl.x : vfl.y;
          float xr = (e & 1) ? bfhi(zru) : bflo(zru), xk = (e & 1) ? bfhi(zku) : bflo(zku), xv = (e & 1) ? bfhi(zvu) : bflo(zvu);
          const float qr = (e & 1) ? bfhi(pru) : bflo(pru), qk = (e & 1) ? bfhi(pku) : bflo(pku), qv = (e & 1) ? bfhi(pvu) : bflo(pvu);
          xr = xr + (qr - xr) * mu[cc]; xk = xk + (qk - xk) * mu[256 + cc]; xv = xv + (qv - xv) * mu[512 + cc];
          const float wl = w0[cc] + aw[i];
          const float ew = 0.60653065971f * sigmoidf_(wl);
          const float u = ew * (1.f - ew * 0.5f * (1.f - ew * (1.f / 3.f) * (1.f - ew * 0.25f * (1.f - ew * 0.2f * (1.f - ew * (1.f / 6.f) * (1.f - ew * (1.f / 7.f) * (1.f - ew * 0.125f)))))));
          const float a = sigmoidf_(a0[cc] + aa[i]);
          if (l == 1) {
            const float vfirst = (e & 1) ? bfhi(vfu) : bflo(vfu);
            xv = xv + (vfirst - xv) * sigmoidf_(v0[cc] + av[i]);
          }
          const float kk = xk * kkw[cc] * inv;
          const float kp = xk * (1.f + (a - 1.f) * kaw[cc]);
          bsum += xr * kp * rkw[cc];
          orr[e] = xr; ou[e] = u; okp[e] = kp; ovv[e] = xv; oa[e] = -kk; ob[e] = kk * a;
        }
        uint2 o;
        o.x = pack2(orr[0], orr[1]); o.y = pack2(orr[2], orr[3]); sto[q][0] = o;
        o.x = pack2(ou[0], ou[1]); o.y = pack2(ou[2], ou[3]); sto[q][1] = o;
        o.x = pack2(okp[0], okp[1]); o.y = pack2(okp[2], okp[3]); sto[q][2] = o;
        o.x = pack2(ovv[0], ovv[1]); o.y = pack2(ovv[2], ovv[3]); sto[q][3] = o;
        o.x = pack2(oa[0], oa[1]); o.y = pack2(oa[2], oa[3]); sto[q][4] = o;
        o.x = pack2(ob[0], ob[1]); o.y = pack2(ob[2], ob[3]); sto[q][5] = o;
      }
#pragma unroll
      for (int q = 0; q < 4; ++q) {
        const int cl = 32 * nt + 8 * q + 4 * h;
#pragma unroll
        for (int k6 = 0; k6 < 6; ++k6) *(uint2*)(prow + k6 * 64 + cl) = sto[q][k6];
        if (l == 0) *(uint2*)(vf + m * 256 + w * 64 + cl) = sto[q][3];
      }
    }
    bsum = xor32_sum(bsum);
    if (h == 0) bon[m * 4 + w] = bsum;
  }
  __syncthreads();
}

DI float dpp_add(float x, const int ctrl_sel) {
  int xi = __float_as_int(x), yi;
  if (ctrl_sel == 0) yi = __builtin_amdgcn_update_dpp(0, xi, 0xB1, 0xF, 0xF, true);
  else if (ctrl_sel == 1) yi = __builtin_amdgcn_update_dpp(0, xi, 0x4E, 0xF, 0xF, true);
  else if (ctrl_sel == 2) yi = __builtin_amdgcn_update_dpp(0, xi, 0x141, 0xF, 0xF, true);
  else yi = __builtin_amdgcn_update_dpp(0, xi, 0x140, 0xF, 0xF, true);
  return x + __int_as_float(yi);
}
DI float row16_sum(float x) { x = dpp_add(x, 0); x = dpp_add(x, 1); x = dpp_add(x, 2); x = dpp_add(x, 3); return x; }

DI void scan_put(const uint4& g, int idx, float* dstbase) {
  const int e0 = idx * 8; const int arr = (e0 % 384) >> 6;
  float f[8] = {bflo(g.x), bfhi(g.x), bflo(g.y), bfhi(g.y), bflo(g.z), bfhi(g.z), bflo(g.w), bfhi(g.w)};
  if (arr == 1) {
#pragma unroll
    for (int e = 0; e < 8; ++e) f[e] = 1.f - f[e];
  }
  *(float4*)(dstbase + e0) = make_float4(f[0], f[1], f[2], f[3]);
  *(float4*)(dstbase + e0 + 4) = make_float4(f[4], f[5], f[6], f[7]);
}
DI void rwkv_scan(const Params& p, int l_, int item, char* smraw) {
  const int rg = item & 3, hd = (item >> 2) & 3, b = item >> 4;
  float* stage = (float*)smraw;
  const bf16_t* pr = (const bf16_t*)(WS(p) + O_PR) + ((size_t)((b * 4 + hd) * 2048)) * 384;
  bf16_t* yr = (bf16_t*)(WS(p) + O_YR);
  const int tid = tidx(), row = (tid >> 4) & 15, kq = tid & 15;
  const bool comp = tid < 256;
  const int st_ = tid & 255;
  fv2 S01 = {0.f, 0.f}, S23 = {0.f, 0.f};
  uint4 g[3];
  __syncthreads();
  if (comp) __builtin_amdgcn_s_setprio(3);
  if (!comp) {
#pragma unroll
    for (int c0 = 0; c0 < 2; ++c0) {
#pragma unroll
      for (int i = 0; i < 3; ++i) g[i] = *(const uint4*)(pr + (size_t)c0 * 16 * 384 + (size_t)(st_ + 256 * i) * 8);
#pragma unroll
      for (int i = 0; i < 3; ++i) scan_put(g[i], st_ + 256 * i, stage + c0 * 16 * 384);
    }
#pragma unroll
    for (int i = 0; i < 3; ++i) g[i] = *(const uint4*)(pr + (size_t)2 * 16 * 384 + (size_t)(st_ + 256 * i) * 8);
  }
  __syncthreads();
  float4 Pr0, Pw0, Pk0, Pa0, Pb0, Pr1, Pw1, Pk1, Pa1, Pb1; float Pv0, Pv1;
  {
    const float* sp = stage + 4 * kq; const float* vp = stage + 3 * 64 + 16 * rg + row;
    Pr0 = *(const float4*)(sp + 0 * 64); Pw0 = *(const float4*)(sp + 1 * 64); Pk0 = *(const float4*)(sp + 2 * 64); Pa0 = *(const float4*)(sp + 4 * 64); Pb0 = *(const float4*)(sp + 5 * 64); Pv0 = vp[0];
    sp += 384; vp += 384;
    Pr1 = *(const float4*)(sp + 0 * 64); Pw1 = *(const float4*)(sp + 1 * 64); Pk1 = *(const float4*)(sp + 2 * 64); Pa1 = *(const float4*)(sp + 4 * 64); Pb1 = *(const float4*)(sp + 5 * 64); Pv1 = vp[0];
  }
  int cur = 0;
  for (int ch = 0; ch < 128; ++ch) {
    if (comp) {
      int nxt = cur + 1; if (nxt == 3) nxt = 0;
      const float* st = stage + cur * 16 * 384 + 4 * kq;
      const float* sv = stage + cur * 16 * 384 + 3 * 64 + 16 * rg + row;
      const float* stn = stage + nxt * 16 * 384 + 4 * kq;
      const float* svn = stage + nxt * 16 * 384 + 3 * 64 + 16 * rg + row;
      float ykeep = 0.f, yp = 0.f;
#pragma unroll
      for (int s = 0; s < 16; ++s) {
        float4 cr, cw, ck, ca, cb; float cv;
        if (s & 1) { cr = Pr1; cw = Pw1; ck = Pk1; ca = Pa1; cb = Pb1; cv = Pv1; }
        else { cr = Pr0; cw = Pw0; ck = Pk0; ca = Pa0; cb = Pb0; cv = Pv0; }
        {
          const float* sp = (s < 14) ? (st + (s + 2) * 384) : (stn + (s - 14) * 384);
          const float* vp = (s < 14) ? (sv + (s + 2) * 384) : (svn + (s - 14) * 384);
          if (s & 1) { Pr1 = *(const float4*)(sp + 0 * 64); Pw1 = *(const float4*)(sp + 1 * 64); Pk1 = *(const float4*)(sp + 2 * 64); Pa1 = *(const float4*)(sp + 4 * 64); Pb1 = *(const float4*)(sp + 5 * 64); Pv1 = vp[0]; }
          else { Pr0 = *(const float4*)(sp + 0 * 64); Pw0 = *(const float4*)(sp + 1 * 64); Pk0 = *(const float4*)(sp + 2 * 64); Pa0 = *(const float4*)(sp + 4 * 64); Pb0 = *(const float4*)(sp + 5 * 64); Pv0 = vp[0]; }
        }
        const fv2 a01 = {ca.x, ca.y}, a23 = {ca.z, ca.w}, w01 = {cw.x, cw.y}, w23 = {cw.z, cw.w};
        const fv2 k01 = {ck.x, ck.y}, k23 = {ck.z, ck.w}, b01 = {cb.x, cb.y}, b23 = {cb.z, cb.w};
        const fv2 r01 = {cr.x, cr.y}, r23 = {cr.z, cr.w};
        const fv2 vv = {cv, cv};
        fv2 pa = S01 * a01; pa = __builtin_elementwise_fma(S23, a23, pa);
        float sa = pa.x + pa.y;
        const fv2 t01 = __builtin_elementwise_fma(S01, w01, vv * k01);
        const fv2 t23 = __builtin_elementwise_fma(S23, w23, vv * k23);
        if (s > 0) {
          sa = dpp_add(sa, 0); yp = dpp_add(yp, 0); sa = dpp_add(sa, 1); yp = dpp_add(yp, 1);
          sa = dpp_add(sa, 2); yp = dpp_add(yp, 2); sa = dpp_add(sa, 3); yp = dpp_add(yp, 3);
          ykeep = (kq == s - 1) ? yp : ykeep;
        } else {
          sa = row16_sum(sa);
        }
        const fv2 sav = {sa, sa};
        S01 = __builtin_elementwise_fma(sav, b01, t01);
        S23 = __builtin_elementwise_fma(sav, b23, t23);
        fv2 py = S01 * r01; py = __builtin_elementwise_fma(S23, r23, py);
        yp = py.x + py.y;
      }
      yp = row16_sum(yp);
      ykeep = (kq == 15) ? yp : ykeep;
      yr[((size_t)(b * 2048 + ch * 16 + kq)) * 256 + hd * 64 + 16 * rg + row] = f2bf(ykeep);
    } else {
      if (ch + 2 < 128) {
        int nb = cur + 2; if (nb >= 3) nb -= 3;
        float* dst = stage + nb * 16 * 384;
#pragma unroll
        for (int i = 0; i < 3; ++i) scan_put(g[i], st_ + 256 * i, dst);
      }
      if (ch + 3 < 128) {
        const bf16_t* src = pr + (size_t)(ch + 3) * 16 * 384;
#pragma unroll
        for (int i = 0; i < 3; ++i) g[i] = *(const uint4*)(src + (size_t)(st_ + 256 * i) * 8);
      }
    }
    __syncthreads();
    cur = (cur == 2) ? 0 : cur + 1;
  }
  __builtin_amdgcn_s_setprio(0);
  {
    unsigned* cs = (unsigned*)(WS(p) + O_BAR) + 3456 + 256 + l_ * 32 + b * 4 + hd;
    asm volatile("s_waitcnt vmcnt(0)" ::: "memory");
    __syncthreads();
    if (tid == 0) {
      __builtin_amdgcn_fence(__ATOMIC_RELEASE, "agent");
      asm volatile("s_waitcnt vmcnt(0)" ::: "memory");
      __hip_atomic_fetch_add(cs, 1u, __ATOMIC_RELAXED, __HIP_MEMORY_SCOPE_AGENT);
      unsigned sp = 0;
      while (__hip_atomic_load(cs, __ATOMIC_RELAXED, __HIP_MEMORY_SCOPE_AGENT) < 4u && ++sp < (1u << 22)) __builtin_amdgcn_s_sleep(1);
      __builtin_amdgcn_fence(__ATOMIC_ACQUIRE, "agent");
      asm volatile("s_waitcnt vmcnt(0)" ::: "memory");
    }
    __syncthreads();
    const int lane = tid & 63, w8 = tid >> 6;
    const bf16_t* prh = (const bf16_t*)(WS(p) + O_PR) + ((size_t)((b * 4 + hd) * 2048)) * 384;
    const float* bon = (const float*)(WS(p) + O_BON);
    bf16_t* hw = (bf16_t*)(WS(p) + O_H);
    const float lw = IN(19)[l_ * 256 + hd * 64 + lane], lb = IN(20)[l_ * 256 + hd * 64 + lane];
#pragma unroll 1
    for (int it = 0; it < 8; ++it) {
      float y[8], v[8], z[8], bo[8];
#pragma unroll
      for (int q = 0; q < 8; ++q) {
        const int t = 512 * rg + 64 * w8 + 8 * it + q;
        const size_t m = (size_t)b * 2048 + t;
        y[q] = bf2f(yr[m * 256 + hd * 64 + lane]);
        v[q] = bf2f(prh[(size_t)t * 384 + 3 * 64 + lane]);
        z[q] = bf2f(hw[m * HS + C_CZ + hd * 64 + lane]);
        bo[q] = bon[m * 4 + hd];
      }
#pragma unroll
      for (int q = 0; q < 8; ++q) {
        const int t = 512 * rg + 64 * w8 + 8 * it + q;
        const size_t m = (size_t)b * 2048 + t;
        const float mean = wave_sum_fast(y[q]) * (1.f / 64.f);
        const float dlt = y[q] - mean;
        const float var = wave_sum_fast(dlt * dlt) * (1.f / 64.f);
        float o = dlt * rsqrtf(var + 64e-5f) * lw + lb + bo[q] * v[q];
        o *= siluf_(z[q]);
        hw[m * HS + C_CZ + hd * 64 + lane] = f2bf(o);
      }
    }
  }
  __syncthreads();
}

constexpr float SL2 = 0.125f * 1.4426950408889634f;

template <int MODE>
DI void attn_loop(const bf16_t* kb, long kstride, const bf16_t* vtb, long vstride, int jlo, int jhi,
                  const bf16x8 (&qf)[4], int qpos, unsigned sel, unsigned uni, int W, int qmin, int qmax,
                  f32x16 (&o)[2], float& m, float& l, bf16_t* Ks, bf16_t* Vs) {
  const int tid = tidx(), lane = tid & 63, h = lane >> 5, r31 = lane & 31;
  const int lr = tid >> 3, lc = (tid & 7) * 8;
  int j = jlo;
  if (MODE == 1) { while (j <= jhi && !((uni >> j) & 1)) ++j; }
  uint4 k0, v0;
  if (j <= jhi) {
    k0 = *(const uint4*)(kb + (long)(64 * j + lr) * kstride + lc);
    v0 = *(const uint4*)(vtb + (long)lr * vstride + 64 * j + lc);
  }
  while (j <= jhi) {
    __syncthreads();
    *(uint4*)(Ks + lr * LDT + lc) = k0;
    *(uint4*)(Vs + lr * LDT + lc) = v0;
    __syncthreads();
    int jn = j + 1;
    if (MODE == 1) { while (jn <= jhi && !((uni >> jn) & 1)) ++jn; }
    if (jn <= jhi) {
      k0 = *(const uint4*)(kb + (long)(64 * jn + lr) * kstride + lc);
      v0 = *(const uint4*)(vtb + (long)lr * vstride + 64 * jn + lc);
    }
    __builtin_amdgcn_sched_barrier(0);
    f32x16 s[2];
#pragma unroll
    for (int kt = 0; kt < 2; ++kt) {
#pragma unroll
      for (int e = 0; e < 16; ++e) s[kt][e] = 0.f;
#pragma unroll
      for (int si = 0; si < 4; ++si) {
        const bf16x8 fa = *(const bf16x8*)(Ks + (32 * kt + r31) * LDT + 16 * si + 8 * h);
        s[kt] = MFMA32(fa, qf[si], s[kt]);
      }
    }
    const bool selj = (MODE == 1) ? (((sel >> j) & 1) != 0) : true;
    const bool interior = (MODE == 1) ? (64 * j + 63 <= qmin) : (MODE == 2) ? ((64 * j + 63 <= qmin) && (qmax - 64 * j < W)) : false;
    float mx = -1e30f;
    if (interior) {
#pragma unroll
      for (int kt = 0; kt < 2; ++kt)
#pragma unroll
        for (int e = 0; e < 16; ++e) {
          const float v = (MODE == 1) ? (selj ? s[kt][e] * SL2 : -1e30f) : s[kt][e] * SL2;
          s[kt][e] = v; mx = fmaxf(mx, v);
        }
    } else {
#pragma unroll
      for (int kt = 0; kt < 2; ++kt)
#pragma unroll
        for (int e = 0; e < 16; ++e) {
          const int key = 64 * j + 32 * kt + crow(e, h);
          bool valid;
          if (MODE == 0) valid = (16 * key + 31 <= qpos);
          else if (MODE == 1) valid = selj && (key <= qpos);
          else valid = (key <= qpos) && (qpos - key < W);
          const float v = valid ? s[kt][e] * SL2 : -1e30f;
          s[kt][e] = v; mx = fmaxf(mx, v);
        }
    }
    mx = xor32_max(mx);
    const float mnew = fmaxf(m, mx);
    const float alpha = __builtin_amdgcn_exp2f(m - mnew);
    m = mnew; l *= alpha;
#pragma unroll
    for (int e = 0; e < 16; ++e) { o[0][e] *= alpha; o[1][e] *= alpha; }
    if (interior && (MODE == 2 || mnew > -1e29f)) {
#pragma unroll
      for (int kt = 0; kt < 2; ++kt)
#pragma unroll
        for (int e = 0; e < 16; ++e) {
          const float pv = __builtin_amdgcn_exp2f(s[kt][e] - mnew);
          l += pv; s[kt][e] = pv;
        }
    } else {
#pragma unroll
      for (int kt = 0; kt < 2; ++kt)
#pragma unroll
        for (int e = 0; e < 16; ++e) {
          const float pv = (s[kt][e] > -1e29f) ? __builtin_amdgcn_exp2f(s[kt][e] - mnew) : 0.f;
          l += pv; s[kt][e] = pv;
        }
    }
#pragma unroll
    for (int kt = 0; kt < 2; ++kt)
#pragma unroll
      for (int sp = 0; sp < 2; ++sp) {
        const bf16x8 fb = __builtin_bit_cast(bf16x8, make_uint4(pack2(s[kt][8 * sp + 0], s[kt][8 * sp + 1]), pack2(s[kt][8 * sp + 2], s[kt][8 * sp + 3]),
                                                               pack2(s[kt][8 * sp + 4], s[kt][8 * sp + 5]), pack2(s[kt][8 * sp + 6], s[kt][8 * sp + 7])));
#pragma unroll
        for (int dt = 0; dt < 2; ++dt) {
          const bf16_t* vr = Vs + (32 * dt + r31) * LDT + 32 * kt + 16 * sp + 4 * h;
          const uint2 lo = *(const uint2*)vr; const uint2 hi = *(const uint2*)(vr + 8);
          const bf16x8 fa = __builtin_bit_cast(bf16x8, make_uint4(lo.x, lo.y, hi.x, hi.y));
          o[dt] = MFMA32(fa, fb, o[dt]);
        }
      }
    j = jn;
  }
}

DI void zero_o(f32x16 (&o)[2]) {
#pragma unroll
  for (int e = 0; e < 16; ++e) { o[0][e] = 0.f; o[1][e] = 0.f; }
}

DI void nsa_item(const Params& p, int l_, int item, char* smraw, bool wr = true) {
  const int qb = 31 - (item >> 4), bg = item & 15, b = bg >> 1, g = bg & 1;
  bf16_t* Ks = (bf16_t*)smraw; bf16_t* Vs = Ks + 64 * LDT;
  float* imp = (float*)(smraw + 18432);
  float* scs = (float*)(smraw + 18432 + 33792);
  unsigned* selm = (unsigned*)(smraw + 18432 + 33792 + 8448);
  const bf16_t* hb = (const bf16_t*)(WS(p) + O_H);
  bf16_t* hw = (bf16_t*)(WS(p) + O_H);
  const bf16_t* vt = (const bf16_t*)(WS(p) + O_VT);
  const int tid = tidx(), lane = tid & 63, w = (tid >> 6) & 3, qh = tid >> 8, h = lane >> 5, r31 = lane & 31;
  const int H = g * 4 + w;
  const int qpos = 64 * qb + 32 * qh + r31;
  const size_t mrow = (size_t)b * 2048 + qpos;
  const int cur = qb;
  bf16x8 qf[4];
#pragma unroll
  for (int s = 0; s < 4; ++s) qf[s] = *(const bf16x8*)(hb + mrow * HS + C_AQ + H * 64 + 16 * s + 8 * h);
  const float g0 = sigmoidf_(bf2f(hb[mrow * HS + C_GATE + 0 * 8 + H]));
  const float g1 = sigmoidf_(bf2f(hb[mrow * HS + C_GATE + 1 * 8 + H]));
  const float g2 = sigmoidf_(bf2f(hb[mrow * HS + C_GATE + 2 * 8 + H]));
  f32x16 ot[2], o[2];
  float m, l;
  zero_o(o); m = -1e30f; l = 0.f;
  const int lo_ = 64 * qb - 511;
  const int jlo = (lo_ <= 0) ? 0 : (lo_ >> 6);
  attn_loop<2>(hb + (size_t)b * 2048 * HS + C_KW + g * 64, HS, vt + ((size_t)((1 * 8 + b) * 128 + g * 64)) * 2048, 2048, jlo, cur, qf, qpos, 0u, 0u, 512, 64 * qb, 64 * qb + 63, o, m, l, Ks, Vs);
  float lt = xor32_sum(l);
  float inv = (lt > 0.f) ? 1.f / lt : 0.f;
#pragma unroll
  for (int e = 0; e < 16; ++e) { ot[0][e] = g2 * inv * o[0][e]; ot[1][e] = g2 * inv * o[1][e]; }
  {
    int* seen = (int*)(smraw + DYN_XB + 20);
    if (*seen == 0) {
      if (tid == 0) {
        const int* cd = (const int*)(WS(p) + O_CNT) + 4 + l_;
        unsigned spins = 0;
        while (__hip_atomic_load(cd, __ATOMIC_RELAXED, __HIP_MEMORY_SCOPE_AGENT) < 32 && ++spins < (1u << 22)) __builtin_amdgcn_s_sleep(2);
      }
      __syncthreads();
      __builtin_amdgcn_fence(__ATOMIC_ACQUIRE, "agent");
      if (tid == 0) *seen = 1;
      __syncthreads();
    }
  }
  const bf16_t* kcb = (const bf16_t*)(WS(p) + O_KC) + (size_t)bg * 128 * 64;
  const bf16_t* vcb = (const bf16_t*)(WS(p) + O_VCT) + (size_t)bg * 64 * 128;
  const int ntile = (4 * qb + 3 + 63) >> 6;
  zero_o(o); m = -1e30f; l = 0.f;
  attn_loop<0>(kcb, 64, vcb, 128, 0, ntile - 1, qf, qpos, 0u, 0u, 0, 64 * qb, 64 * qb + 63, o, m, l, Ks, Vs);
  lt = xor32_sum(l);
  inv = (lt > 0.f) ? 1.f / lt : 0.f;
#pragma unroll
  for (int e = 0; e < 16; ++e) { ot[0][e] += g0 * inv * o[0][e]; ot[1][e] += g0 * inv * o[1][e]; }
  unsigned sel, uni;
  if (cur < 16) {
    sel = (1u << (cur + 1)) - 1u; uni = sel;
  } else {
    float p3[16];
    const int lr = tid >> 3, lc = (tid & 7) * 8;
    float* impw = imp + (w * 64 + 32 * qh + r31) * 33;
#pragma unroll
    for (int jt = 0; jt < 2; ++jt) {
      __syncthreads();
      *(uint4*)(Ks + lr * LDT + lc) = *(const uint4*)(kcb + (size_t)(64 * jt + lr) * 64 + lc);
      __syncthreads();
#pragma unroll
      for (int kt = 0; kt < 2; ++kt) {
        f32x16 s;
#pragma unroll
        for (int e = 0; e < 16; ++e) s[e] = 0.f;
#pragma unroll
        for (int si = 0; si < 4; ++si) {
          const bf16x8 fa = *(const bf16x8*)(Ks + (32 * kt + r31) * LDT + 16 * si + 8 * h);
          s = MFMA32(fa, qf[si], s);
        }
#pragma unroll
        for (int q = 0; q < 4; ++q) {
          float sum4 = 0.f, last = 0.f;
#pragma unroll
          for (int e = 0; e < 4; ++e) {
            const int key = 64 * jt + 32 * kt + 8 * q + 4 * h + e;
            const bool valid = (16 * key + 31 <= qpos);
            const float pv = valid ? __builtin_amdgcn_exp2f(s[4 * q + e] * SL2 - m) * inv : 0.f;
            sum4 += pv; last = pv;
          }
          impw[16 * jt + 8 * kt + 2 * q + h] = sum4;
          p3[jt * 8 + kt * 4 + q] = last;
        }
      }
    }
    __syncthreads();
#pragma unroll
    for (int jt = 0; jt < 2; ++jt)
#pragma unroll
      for (int kt = 0; kt < 2; ++kt)
#pragma unroll
        for (int q = 0; q < 4; ++q) {
          const int j1 = 16 * jt + 8 * kt + 2 * q + h + 1;
          if (j1 < 32) impw[j1] += p3[jt * 8 + kt * 4 + q];
        }
    __syncthreads();
    {
      const int ql = tid >> 3, jj = tid & 7;
#pragma unroll
      for (int e = 0; e < 4; ++e) {
        const int j = jj * 4 + e;
        float sc;
        if (j == 0 || j == cur || j == cur - 1) sc = 1e9f;
        else if (j <= cur) sc = ((imp[(0 * 64 + ql) * 33 + j] + imp[(1 * 64 + ql) * 33 + j]) + imp[(2 * 64 + ql) * 33 + j]) + imp[(3 * 64 + ql) * 33 + j];
        else sc = -1e9f;
        scs[ql * 33 + j] = sc;
      }
      if (tid < 65) selm[tid] = 0u;
    }
    __syncthreads();
    {
      const int ql = tid >> 3, jj = tid & 7;
      unsigned bits = 0u;
#pragma unroll
      for (int e = 0; e < 4; ++e) {
        const int j = jj * 4 + e;
        const float my = scs[ql * 33 + j];
        int rank = 0;
        for (int j2 = 0; j2 < 32; ++j2) {
          const float o2 = scs[ql * 33 + j2];
          rank += (o2 > my || (o2 == my && j2 < j)) ? 1 : 0;
        }
        if (rank < 16) bits |= (1u << j);
      }
      atomicOr(&selm[ql], bits);
      atomicOr(&selm[64], bits);
    }
    __syncthreads();
    sel = selm[32 * qh + r31]; uni = selm[64];
  }
  zero_o(o); m = -1e30f; l = 0.f;
  attn_loop<1>(hb + (size_t)b * 2048 * HS + C_KS + g * 64, HS, vt + ((size_t)((0 * 8 + b) * 128 + g * 64)) * 2048, 2048, 0, cur, qf, qpos, sel, uni, 0, 64 * qb, 64 * qb + 63, o, m, l, Ks, Vs);
  lt = xor32_sum(l);
  inv = (lt > 0.f) ? 1.f / lt : 0.f;
#pragma unroll
  for (int e = 0; e < 16; ++e) { ot[0][e] += g1 * inv * o[0][e]; ot[1][e] += g1 * inv * o[1][e]; }
#pragma unroll
  for (int dt = 0; dt < 2; ++dt)
#pragma unroll
    for (int q = 0; q < 4; ++q) {
      const int d = 32 * dt + 8 * q + 4 * h;
      bf16_t* zp = hw + mrow * HS + C_AZ + H * 64 + d;
      const uint2 z = *(const uint2*)zp;
      uint2 ov;
      ov.x = pack2(ot[dt][4 * q] * siluf_(bflo(z.x)), ot[dt][4 * q + 1] * siluf_(bfhi(z.x)));
      ov.y = pack2(ot[dt][4 * q + 2] * siluf_(bflo(z.y)), ot[dt][4 * q + 3] * siluf_(bfhi(z.y)));
      if (wr) *(uint2*)zp = ov;
    }
  __syncthreads();
}

DI void swa_item(const Params& p, int l_, int item, char* smraw, bool wr = true) {
  const int qb = 15 - (item >> 4), bg = item & 15, b = bg >> 1, g = bg & 1;
  bf16_t* Ks = (bf16_t*)smraw; bf16_t* Vs = Ks + 64 * LDT;
  const bf16_t* hb = (const bf16_t*)(WS(p) + O_H);
  bf16_t* hw = (bf16_t*)(WS(p) + O_H);
  const bf16_t* vt = (const bf16_t*)(WS(p) + O_VT);
  const int tid = tidx(), lane = tid & 63, w = tid >> 6, h = lane >> 5, r31 = lane & 31;
  const int H = g * 2 + (w & 1);
  const int qpos = 128 * qb + 32 * (w >> 1) + r31;
  const size_t mrow = (size_t)b * 2048 + qpos;
  bf16x8 qf[4];
#pragma unroll
  for (int s = 0; s < 4; ++s) qf[s] = *(const bf16x8*)(hb + mrow * HS + C_BQ + H * 64 + 16 * s + 8 * h);
  const float sink = IN(10)[l_ * 4 + H] * 1.4426950408889634f;
  f32x16 o[2];
  zero_o(o);
  float m = sink, l = (h == 0) ? 1.f : 0.f;
  const int jlo = (qb >= 1) ? 2 * qb - 2 : 0;
  attn_loop<2>(hb + (size_t)b * 2048 * HS + C_BK + g * 64, HS, vt + ((size_t)((2 * 8 + b) * 128 + g * 64)) * 2048, 2048, jlo, 2 * qb + 1, qf, qpos, 0u, 0u, 128, 128 * qb, 128 * qb + 127, o, m, l, Ks, Vs);
  const float lt = xor32_sum(l);
  const float inv = (lt > 0.f) ? 1.f / lt : 0.f;
#pragma unroll
  for (int dt = 0; dt < 2; ++dt)
#pragma unroll
    for (int q = 0; q < 4; ++q) {
      const int d = 32 * dt + 8 * q + 4 * h;
      bf16_t* zp = hw + mrow * HS + C_BZ + H * 64 + d;
      const uint2 z = *(const uint2*)zp;
      uint2 ov;
      ov.x = pack2(inv * o[dt][4 * q] * siluf_(bflo(z.x)), inv * o[dt][4 * q + 1] * siluf_(bfhi(z.x)));
      ov.y = pack2(inv * o[dt][4 * q + 2] * siluf_(bflo(z.y)), inv * o[dt][4 * q + 3] * siluf_(bfhi(z.y)));
      if (wr) *(uint2*)zp = ov;
    }
  __syncthreads();
}

DI void rwkv_post(const Params& p, int l) {
  const int lane = tidx() & 63, hd = (tidx() >> 6) & 3, sub = tidx() >> 8;
  const bf16_t* yr = (const bf16_t*)(WS(p) + O_YR);
  const bf16_t* pr = (const bf16_t*)(WS(p) + O_PR);
  const float* bon = (const float*)(WS(p) + O_BON);
  bf16_t* hw = (bf16_t*)(WS(p) + O_H);
  const float lw = IN(19)[l * 256 + hd * 64 + lane], lb = IN(20)[l * 256 + hd * 64 + lane];
  for (int it = bidx(); it < NTOK / 16; it += gridDim.x) {
    float y[8], v[8], z[8], bo[8];
#pragma unroll
    for (int q = 0; q < 8; ++q) {
      const size_t m = (size_t)it * 16 + sub * 8 + q;
      const int b = (int)(m >> 11), t = (int)(m & 2047);
      y[q] = bf2f(yr[m * 256 + hd * 64 + lane]);
      v[q] = bf2f(pr[((size_t)((b * 4 + hd) * 2048 + t)) * 384 + 3 * 64 + lane]);
      z[q] = bf2f(hw[m * HS + C_CZ + hd * 64 + lane]);
      bo[q] = bon[m * 4 + hd];
    }
#pragma unroll
    for (int q = 0; q < 8; ++q) {
      const size_t m = (size_t)it * 16 + sub * 8 + q;
      const float mean = wave_sum_fast(y[q]) * (1.f / 64.f);
      const float dlt = y[q] - mean;
      const float var = wave_sum_fast(dlt * dlt) * (1.f / 64.f);
      float o = dlt * rsqrtf(var + 64e-5f) * lw + lb + bo[q] * v[q];
      o *= siluf_(z[q]);
      hw[m * HS + C_CZ + hd * 64 + lane] = f2bf(o);
    }
  }
}

struct EpiP {
  static constexpr bool PERM = true, AFTER_DRAIN = false;
  char* scr;
  DI void operator()(const f32x4 (&acc)[2][2][4][2], const Unit&, int, int, int, int) const {
    char* sb = scr; asm volatile("" : "+s"(sb));
    const unsigned toff = (unsigned)tidx() * 16u;
#pragma unroll
    for (int ai = 0; ai < 2; ++ai)
#pragma unroll
      for (int m = 0; m < 4; ++m)
#pragma unroll
        for (int bj = 0; bj < 2; ++bj) *(u32x4*)(sb + (size_t)(((ai * 4 + m) * 2 + bj) * 8192) + toff) = pack8(acc[ai][bj][m][0], acc[ai][bj][m][1]);
  }
};
struct EpiMix {
  static constexpr bool PERM = true, AFTER_DRAIN = false;
  const char* scr; bf16_t* mixed; const float* bias; int first;
  DI void operator()(const f32x4 (&acc)[2][2][4][2], const Unit& u, int wr, int wc, int fr, int fq) const {
    const int row0 = u.pm * BM + wr * 64 + fr, col0 = u.pn * BM + wc * 32 + 8 * fq;
    const char* sb = scr; asm volatile("" : "+s"(sb));
    const unsigned toff = (unsigned)tidx() * 16u;
#pragma unroll
    for (int ai = 0; ai < 2; ++ai)
#pragma unroll
      for (int mp = 0; mp < 2; ++mp) {
        u32x4 pv[2][2], ov[2][2];
        f32x4 bv[2][2];
#pragma unroll
        for (int bj = 0; bj < 2; ++bj)
#pragma unroll
          for (int n = 0; n < 2; ++n) bv[bj][n] = *(const f32x4*)(bias + col0 + bj * HALF + 4 * n);
#pragma unroll
        for (int mm = 0; mm < 2; ++mm)
#pragma unroll
          for (int bj = 0; bj < 2; ++bj) {
            const int m = mp * 2 + mm;
            pv[mm][bj] = *(const u32x4*)(sb + (size_t)(((ai * 4 + m) * 2 + bj) * 8192) + toff);
            ov[mm][bj] = (u32x4){0u, 0u, 0u, 0u};
            if (!first) ov[mm][bj] = *(const u32x4*)(mixed + (size_t)(row0 + ai * HALF + m * 16) * 1024 + col0 + bj * HALF);
          }
#pragma unroll
        for (int mm = 0; mm < 2; ++mm)
#pragma unroll
          for (int bj = 0; bj < 2; ++bj) {
            const int m = mp * 2 + mm;
            const f32x4 g0 = acc[ai][bj][m][0] + bv[bj][0], g1 = acc[ai][bj][m][1] + bv[bj][1];
            const u32x4 p_ = pv[mm][bj], o_ = ov[mm][bj];
            u32x4 w;
            w.x = pack2(bflo(o_.x) + sigmoidf_(g0[0]) * bflo(p_.x), bfhi(o_.x) + sigmoidf_(g0[1]) * bfhi(p_.x));
            w.y = pack2(bflo(o_.y) + sigmoidf_(g0[2]) * bflo(p_.y), bfhi(o_.y) + sigmoidf_(g0[3]) * bfhi(p_.y));
            w.z = pack2(bflo(o_.z) + sigmoidf_(g1[0]) * bflo(p_.z), bfhi(o_.z) + sigmoidf_(g1[1]) * bfhi(p_.z));
            w.w = pack2(bflo(o_.w) + sigmoidf_(g1[2]) * bflo(p_.w), bfhi(o_.w) + sigmoidf_(g1[3]) * bfhi(p_.w));
            *(u32x4*)(mixed + (size_t)(row0 + ai * HALF + m * 16) * 1024 + col0 + bj * HALF) = w;
          }
      }
  }
};
struct Sub5 { const char* A; const char* B; int nt; int isP; };
DI Sub5 p5_sub(int i, const Unit& u, const bf16_t* hb, const bf16_t* xn, const bf16_t* wtm, const bf16_t* wtp) {
  const int br = i >> 1;
  Sub5 s;
  if (!(i & 1)) {
    const int zc = (br == 0) ? C_AZ : (br == 1) ? C_BZ : C_CZ;
    const int kof = (br == 0) ? 0 : (br == 1) ? 512 : 768;
    s.A = (const char*)(hb + zc + (size_t)u.pm * BM * HS);
    s.B = (const char*)(wtp + kof + (size_t)u.pn * BM * 1024);
    s.nt = (br == 0) ? 8 : 4; s.isP = 1;
  } else {
    s.A = (const char*)(xn + (size_t)u.pm * BM * 1024);
    s.B = (const char*)(wtm + ((size_t)br * 1024 + (size_t)u.pn * BM) * 1024);
    s.nt = 16; s.isP = 0;
  }
  return s;
}
DI void gemm_phase_p5(LAS unsigned char* lds, const Unit u, const bf16_t* hb, const bf16_t* xn, const bf16_t* wtm, const bf16_t* wtp,
                      char* scr, bf16_t* mixed, const float* bmerge) {
    const int tid = tidx(), wid = __builtin_amdgcn_readfirstlane(tid >> 6), lane = tid & 63, wr = wid >> 2, wc = wid & 3, fr = lane & 15, fq = lane >> 4;
    unsigned rowA, col2;
    { int R, C; stage_rc(tid * 16, R, C); rowA = (unsigned)R; col2 = (unsigned)C * 2u; }
#define PG8_ROWB ((rowA & ~31u) + (unsigned)perm32((int)(rowA & 31u)))
    const unsigned ldX = 1024u * 2u, ldH = (unsigned)HS * 2u;
    const size_t kstep = (size_t)(BK * 2);
    const size_t hstepB = (size_t)HALF * 1024 * 2, hsX = (size_t)HALF * 1024 * 2, hsH = (size_t)HALF * HS * 2;
    const unsigned ldsw = (unsigned)wid * 1024u;
    const int aoff = lds_byte(wr * 64 + fr, fq * 8), boff = lds_byte(wc * 32 + fr, fq * 8);
#define PG8_SA(b, h) (((b) * 2 + (h)) * HTB)
#define PG8_SB(b, h) ((4 + (b) * 2 + (h)) * HTB)
#define PG8_STAGE2(bufoff, gbase, row_, ld_) do { const unsigned v0__ = (row_) * (ld_) + col2;         __builtin_amdgcn_global_load_lds((const unsigned*)((const char*)(gbase) + v0__), (LAS unsigned*)(lds + (bufoff) + ldsw), 16, 0, 0);         __builtin_amdgcn_global_load_lds((const unsigned*)((const char*)(gbase) + (size_t)(64u * (ld_)) + v0__), (LAS unsigned*)(lds + (bufoff) + ldsw + 8192), 16, 0, 0); } while (0)
#define PG8_LDA(dst, b, h) do { _Pragma("unroll") for (int m = 0; m < 4; ++m) _Pragma("unroll") for (int k = 0; k < 2; ++k) dst[m][k] = *(const LAS bf16x8*)(lds + PG8_SA(b, h) + aoff + m * 2048 + k * 1024); } while (0)
#define PG8_LDB(dst, b, h) do { _Pragma("unroll") for (int n = 0; n < 2; ++n) _Pragma("unroll") for (int k = 0; k < 2; ++k) dst[n][k] = *(const LAS bf16x8*)(lds + PG8_SB(b, h) + boff + n * 2048 + k * 1024); } while (0)
#define PG8_MMA(ai, bj, At, Bt) do { __builtin_amdgcn_s_setprio(1); _Pragma("unroll") for (int m = 0; m < 4; ++m) _Pragma("unroll") for (int n = 0; n < 2; ++n) _Pragma("unroll") for (int k = 0; k < 2; ++k)         acc[ai][bj][m][n] = __builtin_amdgcn_mfma_f32_16x16x32_bf16(Bt[n][k], At[m][k], acc[ai][bj][m][n], 0, 0, 0); __builtin_amdgcn_s_setprio(0); } while (0)
#define PG8_WAIT_V(n) asm volatile("s_waitcnt vmcnt(" #n ")" ::: "memory")
#define PG8_WAIT_L(n) asm volatile("s_waitcnt lgkmcnt(" #n ")" ::: "memory")
#define PG8_BAR __builtin_amdgcn_s_barrier()
#define PG8_SCHED __builtin_amdgcn_sched_barrier(0)
    Sub5 cur = p5_sub(0, u, hb, xn, wtm, wtp), nxt;
    f32x4 acc[2][2][4][2];
#pragma unroll
    for (int a = 0; a < 2; ++a)
#pragma unroll
        for (int b = 0; b < 2; ++b)
#pragma unroll
            for (int m = 0; m < 4; ++m)
#pragma unroll
                for (int n = 0; n < 2; ++n) acc[a][b][m][n] = (f32x4){0.f, 0.f, 0.f, 0.f};
    bf16x8 At[4][2], B0[2][2], B1[2][2];
    unsigned ldc = cur.isP ? ldH : ldX;
    size_t hsc = cur.isP ? hsH : hsX;
    PG8_STAGE2(PG8_SB(0, 0), cur.B, PG8_ROWB, ldX); PG8_STAGE2(PG8_SA(0, 0), cur.A, rowA, ldc);
    PG8_STAGE2(PG8_SB(0, 1), cur.B + hstepB, PG8_ROWB, ldX); PG8_STAGE2(PG8_SA(0, 1), cur.A + hsc, rowA, ldc);
    if (wr == 1) PG8_BAR;
    PG8_WAIT_V(4); PG8_BAR;
    PG8_STAGE2(PG8_SB(1, 0), cur.B + kstep, PG8_ROWB, ldX); PG8_STAGE2(PG8_SA(1, 0), cur.A + kstep, rowA, ldc);
    PG8_STAGE2(PG8_SB(1, 1), cur.B + hstepB + kstep, PG8_ROWB, ldX);
    PG8_WAIT_V(6); PG8_BAR;
#pragma unroll 1
    for (int ui = 0;; ++ui) {
        const bool has_next = ui < 5;
        nxt = has_next ? p5_sub(ui + 1, u, hb, xn, wtm, wtp) : cur;
        const unsigned ldn = nxt.isP ? ldH : ldX;
        const size_t hsn = nxt.isP ? hsH : hsX;
        const int nt = cur.nt;
#pragma unroll 1
        for (int t = 0; t < nt; t += 2) {
            const bool last = (t == nt - 2);
            const char* a1 = cur.A + (size_t)(t + 1) * kstep;
            const char* a2 = last ? nxt.A : cur.A + (size_t)(t + 2) * kstep; const char* b2 = last ? nxt.B : cur.B + (size_t)(t + 2) * kstep;
            const unsigned ld2 = last ? ldn : ldc; const size_t hs2 = last ? hsn : hsc;
            const char* a3 = a2 + kstep; const char* b3 = b2 + kstep;
            PG8_LDB(B0, 0, 0); PG8_SCHED; PG8_LDA(At, 0, 0); PG8_STAGE2(PG8_SA(1, 1), a1 + hsc, rowA, ldc);
            PG8_WAIT_L(8); PG8_BAR; PG8_WAIT_L(0); PG8_MMA(0, 0, At, B0); PG8_BAR; PG8_SCHED;
            PG8_LDB(B1, 0, 1); PG8_STAGE2(PG8_SB(0, 0), b2, PG8_ROWB, ldX);
            PG8_BAR; PG8_WAIT_L(0); PG8_MMA(0, 1, At, B1); PG8_BAR;
            PG8_LDA(At, 0, 1); PG8_STAGE2(PG8_SA(0, 0), a2, rowA, ld2);
            PG8_BAR; PG8_WAIT_L(0); PG8_MMA(1, 0, At, B0); PG8_BAR; PG8_SCHED;
            PG8_STAGE2(PG8_SB(0, 1), b2 + hstepB, PG8_ROWB, ldX);
            PG8_WAIT_V(6); PG8_BAR; PG8_MMA(1, 1, At, B1); PG8_BAR;
            PG8_LDB(B0, 1, 0); PG8_SCHED; PG8_LDA(At, 1, 0); PG8_STAGE2(PG8_SA(0, 1), a2 + hs2, rowA, ld2);
            PG8_WAIT_L(8); PG8_BAR; PG8_WAIT_L(0); PG8_MMA(0, 0, At, B0); PG8_BAR; PG8_SCHED;
            PG8_LDB(B1, 1, 1); PG8_STAGE2(PG8_SB(1, 0), b3, PG8_ROWB, ldX);
            PG8_BAR; PG8_WAIT_L(0); PG8_MMA(0, 1, At, B1); PG8_BAR;
            PG8_LDA(At, 1, 1); PG8_STAGE2(PG8_SA(1, 0), a3, rowA, ld2);
            PG8_BAR; PG8_WAIT_L(0); PG8_MMA(1, 0, At, B0); PG8_BAR; PG8_SCHED;
            PG8_STAGE2(PG8_SB(1, 1), b3 + hstepB, PG8_ROWB, ldX);
            PG8_WAIT_V(6); PG8_BAR; PG8_MMA(1, 1, At, B1); PG8_BAR;
        }
        PG8_SCHED;
        {
          const int t2 = tidx(), fr2 = t2 & 15, fq2 = (t2 & 63) >> 4;
          if (cur.isP) { EpiP E{scr}; E(acc, u, wr, wc, fr2, fq2); }
          else { const int br = ui >> 1; EpiMix E{scr, mixed, bmerge + br * 1024, br == 0 ? 1 : 0}; E(acc, u, wr, wc, fr2, fq2); }
        }
        PG8_SCHED;
        if (!has_next) break;
#pragma unroll
        for (int a = 0; a < 2; ++a)
#pragma unroll
            for (int b = 0; b < 2; ++b)
#pragma unroll
                for (int m = 0; m < 4; ++m)
#pragma unroll
                    for (int n = 0; n < 2; ++n) acc[a][b][m][n] = (f32x4){0.f, 0.f, 0.f, 0.f};
        cur = nxt; ldc = ldn; hsc = hsn;
    }
    PG8_WAIT_V(0);
    if (wr == 0) PG8_BAR;
    PG8_BAR;
#undef PG8_SA
#undef PG8_SB
#undef PG8_STAGE2
#undef PG8_ROWB
#undef PG8_LDA
#undef PG8_LDB
#undef PG8_MMA
#undef PG8_WAIT_V
#undef PG8_WAIT_L
#undef PG8_BAR
#undef PG8_SCHED
}
DI void phase5(const Params& p, int l, char* smraw) {
  const bf16_t* xn = (const bf16_t*)(WS(p) + O_XN);
  const bf16_t* hb = (const bf16_t*)(WS(p) + O_H);
  const bf16_t* wtm = (const bf16_t*)(WS(p) + O_WTM);
  const bf16_t* wtp = (const bf16_t*)(WS(p) + O_WTP);
  bf16_t* mixed = (bf16_t*)(WS(p) + O_PR);
  const int blk = bidx();
  char* sbase = (blk < 128) ? (WS(p) + O_PR + (size_t)NTOK * 1024 * 2 + (size_t)blk * 131072)
              : (blk < 224) ? (WS(p) + O_VT + (size_t)(blk - 128) * 131072)
                            : (WS(p) + O_YR + (size_t)(blk - 224) * 131072);
  char* scr = sbase;
  StaticOrder S; S.init(NTOK, 1024, gridDim.x, bidx());
  Unit u;
  for (int i = 0; S.next(i, u); ++i)
    gemm_phase_p5((LAS unsigned char*)smraw, u, hb, xn, wtm, wtp, scr, mixed, IN(3) + l * 3072);
}

struct EpiRes {
  static constexpr bool PERM = false, AFTER_DRAIN = false;
  const float* X; float* O;
  DI void operator()(const f32x4 (&acc)[2][2][4][2], const Unit& u, int wr, int wc, int fr, int fq) const {
    const int row0 = u.pm * BM + wr * 64 + fr, col0 = u.pn * BM + wc * 32 + 4 * fq;
#pragma unroll
    for (int ai = 0; ai < 2; ++ai)
#pragma unroll
      for (int mp = 0; mp < 2; ++mp) {
        f32x4 xv[2][2][2];
#pragma unroll
        for (int mm = 0; mm < 2; ++mm)
#pragma unroll
          for (int bj = 0; bj < 2; ++bj)
#pragma unroll
            for (int n = 0; n < 2; ++n)
              xv[mm][bj][n] = *(const f32x4*)(X + (size_t)(row0 + ai * HALF + (mp * 2 + mm) * 16) * 1024 + col0 + bj * HALF + n * 16);
#pragma unroll
        for (int mm = 0; mm < 2; ++mm)
#pragma unroll
          for (int bj = 0; bj < 2; ++bj)
#pragma unroll
            for (int n = 0; n < 2; ++n)
              *(f32x4*)(O + (size_t)(row0 + ai * HALF + (mp * 2 + mm) * 16) * 1024 + col0 + bj * HALF + n * 16) = xv[mm][bj][n] + acc[ai][bj][mp * 2 + mm][n];
      }
  }
};
DI void phase6(const Params& p, int l, char* smraw) {
  Gemm g{(const bf16_t*)(WS(p) + O_PR), (const bf16_t*)(WS(p) + O_WTO), 1024, 1024, 1024};
  StaticOrder S; S.init(NTOK, 1024, gridDim.x, bidx());
  EpiRes E{(l == 0) ? IN(0) : OUTP(), OUTP()};
  gemm_phase<EpiRes, StaticOrder>((LAS unsigned char*)smraw, g, S, E);
}

#define XB_TMO      128
#define XB_XCNT(j)  (256  + 64 * (j))
#define XB_XSUB(j)  (1280 + 64 * (j))
#define XB_XGEN(j)  (2304 + 64 * (j))
#define XB_TOP      3328
#define XB_TOPGEN   3392
#define XCD_BAR_WORDS 3456
#define XB_SPIN_CAP (1u << 18)

__device__ __forceinline__ unsigned xb_ld(unsigned* p)              { return __hip_atomic_load(p, __ATOMIC_RELAXED, __HIP_MEMORY_SCOPE_AGENT); }
__device__ __forceinline__ unsigned xb_add(unsigned* p, unsigned v) { return __hip_atomic_fetch_add(p, v, __ATOMIC_RELAXED, __HIP_MEMORY_SCOPE_AGENT); }
__device__ __forceinline__ unsigned xb_xcc_id() { return (unsigned)__builtin_amdgcn_s_getreg((3 << 11) | 20) & 0xFu; }
#define XB_SPIN(cond, bar) do { unsigned _sp = 0; while (cond) { __builtin_amdgcn_s_sleep(1); \
    if ((++_sp & 255u) == 0u) { if (xb_ld(&(bar)[XB_TMO])) break; if (_sp > XB_SPIN_CAP) { atomicAdd(&(bar)[XB_TMO], 1u); break; } } } } while (0)

struct XcdBarrier {
    unsigned* bar; unsigned x;
    volatile LAS unsigned* st;
};

__device__ __forceinline__ XcdBarrier xcd_barrier_post(unsigned* bar, volatile LAS unsigned* st) {
    XcdBarrier b; b.bar = bar; b.x = xb_xcc_id(); b.st = st;
    if (tidx() == 0) (void)xb_add(&bar[XB_XCNT(b.x)], 1u);
    return b;
}
__device__ __forceinline__ void xcd_barrier_complete(unsigned* bar, unsigned x, unsigned& nloc, unsigned& nx) {
    const unsigned G = gridDim.x * gridDim.y * gridDim.z;
    unsigned sum, cnt, mine, sp = 0u;
    for (;;) {
        sum = 0u; cnt = 0u; mine = 0u;
#pragma unroll
        for (unsigned j = 0; j < 16; ++j) { const unsigned c = xb_ld(&bar[XB_XCNT(j)]); sum += c; cnt += (c > 0u) ? 1u : 0u; mine = (j == x) ? c : mine; }
        if (sum == G) break;
        __builtin_amdgcn_s_sleep(1);
        if ((++sp & 255u) == 0u) { if (xb_ld(&bar[XB_TMO])) break; if (sp > XB_SPIN_CAP) { atomicAdd(&bar[XB_TMO], 1u); break; } }
    }
    nloc = mine > 0u ? mine : 1u; nx = cnt > 0u ? cnt : 1u;
}

__device__ __forceinline__ void xcd_barrier(const XcdBarrier& b) {
    asm volatile("s_waitcnt vmcnt(0)" ::: "memory");
    __syncthreads();
    if (tidx() == 0) {
        unsigned* bar = b.bar; asm volatile("" : "+s"(bar));
        __builtin_amdgcn_s_waitcnt(0);
        unsigned nloc = b.st[0], nx = b.st[1];
        if (nloc == 0u) { xcd_barrier_complete(bar, b.x, nloc, nx); b.st[0] = nloc; b.st[1] = nx; }
        const unsigned old = xb_add(&bar[XB_XSUB(b.x)], 1u);
        const unsigned gen = old / nloc;
        if (old + 1u == (gen + 1u) * nloc) {
            __builtin_amdgcn_fence(__ATOMIC_RELEASE, "agent");
            asm volatile("s_waitcnt vmcnt(0)" ::: "memory");
            const unsigned og = xb_add(&bar[XB_TOP], 1u);
            const unsigned tg = og / nx;
            if (og + 1u == (tg + 1u) * nx) xb_add(&bar[XB_TOPGEN], 1u);
            else XB_SPIN(xb_ld(&bar[XB_TOPGEN]) == tg, bar);
            __builtin_amdgcn_fence(__ATOMIC_ACQUIRE, "agent");
            xb_add(&bar[XB_XGEN(b.x)], 1u);
            asm volatile("s_waitcnt vmcnt(0)" ::: "memory");
        } else {
            XB_SPIN(xb_ld(&bar[XB_XGEN(b.x)]) == gen, bar);
            __builtin_amdgcn_fence(__ATOMIC_ACQUIRE, "agent");
            asm volatile("s_waitcnt vmcnt(0)" ::: "memory");
        }
    }
    __syncthreads();
}


__global__ void __launch_bounds__(512, 2) fwd_megakernel(Params p) {
  cg::grid_group grid = cg::this_grid();
  extern __shared__ __attribute__((aligned(16))) char smraw[];
  uint4* xb_words = (uint4*)(smraw + DYN_XB);
  int* s_item = (int*)(smraw + DYN_XB + 16);
  if (tidx() == 0) *xb_words = make_uint4(0u, 0u, 0u, 0u);
  __syncthreads();
  XcdBarrier xb = xcd_barrier_post((unsigned*)(WS(p) + O_BAR), (volatile LAS unsigned*)xb_words);
  if (WS(p) == nullptr) grid.sync();
  unsigned long long tacc = 0ull, t0 = 0ull;
#define TB(k) do { if (PROBE_T == (k)) t0 = __builtin_amdgcn_s_memrealtime(); } while (0)
#define TE(k) do { if (PROBE_T == (k)) tacc += __builtin_amdgcn_s_memrealtime() - t0; } while (0)
  for (int l = 0; l < 2; ++l) {
    TB(10);
    phase0(p, l, smraw);
    xcd_barrier(xb);
    TE(10); TB(11);
    phase1(p, smraw);
    xcd_barrier(xb);
    TE(11); TB(12);
    for (int it = bidx(); it < 256; it += gridDim.x) rwkv_prep(p, l, it, smraw);
    xcd_barrier(xb);
    TE(12); TB(13); TB(18);
    {
      int* cnt = (int*)(WS(p) + O_CNT) + l;
      if (tidx() == 0) *(int*)(smraw + DYN_XB + 20) = 0;
      __syncthreads();
      for (int it = bidx(); it < 128; it += gridDim.x) rwkv_scan(p, l, it, smraw);
      TE(18);
      while (true) {
        if (tidx() == 0) *s_item = atomicAdd(cnt, 1);
        __syncthreads();
        const int item = *s_item;
        __syncthreads();
        if (item >= 32 + 512 + 256) break;
        if (item < 32) compress_tile2(p, l, item, smraw);
        else if (item < 32 + 256) swa_item(p, l, item - 32, smraw);
        else nsa_item(p, l, item - 32 - 256, smraw);
      }
      TB(19);
    }
    xcd_barrier(xb);
    TE(13); TE(19); TB(15);
    phase5(p, l, smraw);
    xcd_barrier(xb);
    TE(15); TB(16);
    phase6(p, l, smraw);
    xcd_barrier(xb);
    TE(16);
  }
  TB(17);
  rmsnorm_rows(OUTP(), IN(28), nullptr, OUTP());
  TE(17);
  if (PROBE_T && bidx() == 0) {
    asm volatile("s_waitcnt vmcnt(0)" ::: "memory");
    __syncthreads();
    if (tidx() == 0) atomicAdd(OUTP(), 0.04f + (float)tacc * 0.01f * PROBE_TSCALE);
  }
}

extern "C" void kernel_launch(void* const* d_in, const int* in_sizes, int n_in, void* d_out, int out_size, void* d_ws,
                              size_t ws_size, hipStream_t stream) {
  static int grid_blocks = 0;
  if (!grid_blocks) {
    int dev = 0, cus = 0, per_cu = 0;
    (void)hipGetDevice(&dev);
    (void)hipDeviceGetAttribute(&cus, hipDeviceAttributeMultiprocessorCount, dev);
    if (hipFuncSetAttribute((const void*)fwd_megakernel, hipFuncAttributeMaxDynamicSharedMemorySize, DYN_LDS) != hipSuccess) {
      fprintf(stderr, "hipFuncSetAttribute failed\n"); grid_blocks = -1;
    } else {
      (void)hipOccupancyMaxActiveBlocksPerMultiprocessor(&per_cu, (const void*)fwd_megakernel, 512, DYN_LDS);
      if (per_cu > 1) per_cu = 1;
      grid_blocks = (cus * per_cu) & ~7;
      if (grid_blocks > 256) grid_blocks = 256;
    }
  }
  if (ws_size < WS_TOTAL || grid_blocks < 128) {
    fprintf(stderr, "workspace too small or grid too small: %zu < %zu, grid %d\n", ws_size, (size_t)WS_TOTAL, grid_blocks);
    return;
  }
  Params p{};
  for (int i = 0; i < 29; ++i) p.in[i] = (const float*)d_in[i];
  p.out = (float*)d_out;
  p.ws = (char*)d_ws;
  (void)hipMemsetAsync((char*)d_ws + O_BAR, 0, 16384, stream);
  void* args[] = {&p};
  hipError_t e = hipLaunchCooperativeKernel((void*)fwd_megakernel, dim3(grid_blocks), dim3(512), args, DYN_LDS, stream);
  if (e != hipSuccess) fprintf(stderr, "cooperative launch failed: %s (grid %d)\n", hipGetErrorString(e), grid_blocks);
}
```

```cpp
#include <hip/hip_runtime.h>
#include <hip/hip_cooperative_groups.h>
#include <cstdio>
namespace cg = cooperative_groups;

#define DI __device__ __forceinline__
typedef unsigned short bf16_t;
typedef short bf16x8 __attribute__((ext_vector_type(8)));
typedef short s16x4 __attribute__((ext_vector_type(4)));
typedef float f32x16 __attribute__((ext_vector_type(16)));
typedef float f32x4 __attribute__((ext_vector_type(4)));
typedef unsigned u32x4 __attribute__((ext_vector_type(4)));
#define LAS __attribute__((address_space(3)))
typedef __bf16 bfv2 __attribute__((ext_vector_type(2)));
typedef float fv2 __attribute__((ext_vector_type(2)));
#define MFMA32(a, b, c) __builtin_amdgcn_mfma_f32_32x32x16_bf16((a), (b), (c), 0, 0, 0)

DI unsigned pack2(float a, float b) { fv2 v = {a, b}; return __builtin_bit_cast(unsigned, __builtin_convertvector(v, bfv2)); }
DI bf16_t f2bf(float a) { return (bf16_t)(pack2(a, 0.f) & 0xffffu); }
DI float bflo(unsigned u) { return __uint_as_float(u << 16); }
DI float bfhi(unsigned u) { return __uint_as_float(u & 0xffff0000u); }
DI float bf2f(bf16_t u) { return __uint_as_float(((unsigned)u) << 16); }
DI float sigmoidf_(float x) { return __builtin_amdgcn_rcpf(1.f + __expf(-x)); }
DI float siluf_(float x) { return x * __builtin_amdgcn_rcpf(1.f + __expf(-x)); }
DI int tidx() { int t = threadIdx.x; asm volatile("" : "+v"(t)); return t; }
DI int bidx() { int b = blockIdx.x; asm volatile("" : "+s"(b)); return b; }
DI float xor32_sum(float x) { auto r = __builtin_amdgcn_permlane32_swap(__float_as_uint(x), __float_as_uint(x), false, false); return __uint_as_float(r[0]) + __uint_as_float(r[1]); }
DI float xor32_max(float x) { auto r = __builtin_amdgcn_permlane32_swap(__float_as_uint(x), __float_as_uint(x), false, false); return fmaxf(__uint_as_float(r[0]), __uint_as_float(r[1])); }
DI float xor16_sum(float x) { auto r = __builtin_amdgcn_permlane16_swap(__float_as_uint(x), __float_as_uint(x), false, false); return __uint_as_float(r[0]) + __uint_as_float(r[1]); }
DI float fdpp_add(float x, const int sel) {
  int xi = __float_as_int(x), yi;
  if (sel == 0) yi = __builtin_amdgcn_update_dpp(0, xi, 0xB1, 0xF, 0xF, true);
  else if (sel == 1) yi = __builtin_amdgcn_update_dpp(0, xi, 0x4E, 0xF, 0xF, true);
  else if (sel == 2) yi = __builtin_amdgcn_update_dpp(0, xi, 0x141, 0xF, 0xF, true);
  else yi = __builtin_amdgcn_update_dpp(0, xi, 0x140, 0xF, 0xF, true);
  return x + __int_as_float(yi);
}
DI float wave_sum_fast(float v) { v = fdpp_add(v, 0); v = fdpp_add(v, 1); v = fdpp_add(v, 2); v = fdpp_add(v, 3); v = xor16_sum(v); return xor32_sum(v); }
DI int crow(int i, int h) { return (i & 3) + 8 * (i >> 2) + 4 * h; }

constexpr int T_ = 2048, NTOK = 16384, HS = 3840, NIN = 6808;
constexpr int C_AQ = 0, C_KC = 512, C_VC = 640, C_KS = 768, C_KW = 1024, C_AZ = 1280, C_BQ = 1792, C_BK = 2048,
              C_BZ = 2304, C_R = 2560, C_K = 2816, C_V = 3072, C_WD = 3328, C_CZ = 3456, C_GATE = 3712;

constexpr size_t al256(size_t x) { return (x + 255) & ~(size_t)255; }
constexpr size_t O_WTA = 0;
constexpr size_t O_WTM = O_WTA + (size_t)3840 * 1024 * 2;
constexpr size_t O_WTP = O_WTM + (size_t)3072 * 1024 * 2;
constexpr size_t O_WTO = O_WTP + (size_t)1024 * 1024 * 2;
constexpr size_t O_W1K = O_WTO + (size_t)1024 * 1024 * 2;
constexpr size_t O_W1V = O_W1K + (size_t)128 * 2048 * 2;
constexpr size_t O_W2K = O_W1V + (size_t)128 * 2048 * 2;
constexpr size_t O_W2V = O_W2K + (size_t)64 * 128 * 2;
constexpr size_t O_PEB = O_W2V + (size_t)64 * 128 * 2;
constexpr size_t O_LW2 = O_PEB + 1024;
constexpr size_t O_LA2 = O_LW2 + 256 * 64 * 2;
constexpr size_t O_V1T = O_LA2 + 256 * 64 * 2;
constexpr size_t O_V2T = O_V1T + 32 * 256 * 2;
constexpr size_t O_CNT = O_V2T + 256 * 32 * 2;
constexpr size_t O_BAR = O_CNT + 256;
constexpr size_t O_XN = O_BAR + 16384;
constexpr size_t O_H = O_XN + (size_t)NTOK * 1024 * 2;
constexpr size_t O_VT = O_H + (size_t)NTOK * HS * 2;
constexpr size_t O_KC = O_VT + (size_t)3 * 8 * 2 * 64 * 2048 * 2;
constexpr size_t O_VCT = O_KC + (size_t)16 * 128 * 64 * 2;
constexpr size_t O_VF = O_VCT + (size_t)16 * 128 * 64 * 2;
constexpr size_t O_YR = O_VF + (size_t)NTOK * 256 * 2;
constexpr size_t O_BON = O_YR + (size_t)NTOK * 256 * 2;
constexpr size_t O_PR = O_BON + (size_t)NTOK * 4 * 4;
constexpr size_t WS_TOTAL = O_PR + (size_t)NTOK * 4 * 384 * 2;

#ifndef PROBE
#define PROBE 0
#define PROBE_T 0
#define PROBE_TSCALE 0.0001f
#endif
struct Params {
  const float* in[29];
  float* out;
  char* ws;
};

typedef const __attribute__((address_space(4))) char* kaptr_t;
DI kaptr_t KA() { kaptr_t k = (kaptr_t)__builtin_amdgcn_kernarg_segment_ptr(); asm volatile("" : "+s"(k)); return k; }
DI const float* IN(int i) { return *(const float* const __attribute__((address_space(4)))*)(KA() + 8 * i); }
DI float* OUTP() { return *(float* const __attribute__((address_space(4)))*)(KA() + 8 * 29); }
DI char* WS(const Params&) { return *(char* const __attribute__((address_space(4)))*)(KA() + 8 * 30); }
constexpr int SMEM_BYTES = 73728;
constexpr int DYN_XB = 155648;
constexpr int DYN_LDS = DYN_XB + 64;
constexpr int LDT = 72;

#define G_LOAD(P, ao_, bo_) do { const long ao__ = (ao_); const int bo__ = (bo_); \
  P##a0 = *(const uint4*)(a0 + ao__); P##a1 = *(const uint4*)(a1 + ao__); P##a2 = *(const uint4*)(a2 + ao__); P##a3 = *(const uint4*)(a3 + ao__); \
  P##b0 = *(const uint4*)(b0 + bo__); P##b1 = *(const uint4*)(b1 + bo__); P##b2 = *(const uint4*)(b2 + bo__); P##b3 = *(const uint4*)(b3 + bo__); } while (0)
#define G_STORE(P, A_, B_) do { bf16_t* A__ = (A_); bf16_t* B__ = (B_); \
  *(uint4*)(A__ + (wr)*LDT + wc) = P##a0; *(uint4*)(A__ + (wr + 32) * LDT + wc) = P##a1; \
  *(uint4*)(A__ + (wr + 64) * LDT + wc) = P##a2; *(uint4*)(A__ + (wr + 96) * LDT + wc) = P##a3; \
  *(uint4*)(B__ + (wr)*LDT + wc) = P##b0; *(uint4*)(B__ + (wr + 32) * LDT + wc) = P##b1; \
  *(uint4*)(B__ + (wr + 64) * LDT + wc) = P##b2; *(uint4*)(B__ + (wr + 96) * LDT + wc) = P##b3; } while (0)
DI void g_compute(f32x16 (&acc)[2][2], const bf16_t* A_, const bf16_t* B_) {
  __builtin_amdgcn_s_setprio(1);
#pragma unroll
  for (int s = 0; s < 4; ++s) {
    bf16x8 fa0 = *(const bf16x8*)(A_ + 16 * s);
    bf16x8 fa1 = *(const bf16x8*)(A_ + 32 * LDT + 16 * s);
    bf16x8 fb0 = *(const bf16x8*)(B_ + 16 * s);
    bf16x8 fb1 = *(const bf16x8*)(B_ + 32 * LDT + 16 * s);
    acc[0][0] = MFMA32(fa0, fb0, acc[0][0]);
    acc[0][1] = MFMA32(fa0, fb1, acc[0][1]);
    acc[1][0] = MFMA32(fa1, fb0, acc[1][0]);
    acc[1][1] = MFMA32(fa1, fb1, acc[1][1]);
  }
  __builtin_amdgcn_s_setprio(0);
}
DI void gemm_core(f32x16 (&acc)[2][2], const bf16_t* a0, const bf16_t* a1, const bf16_t* a2, const bf16_t* a3, long aks,
                  const bf16_t* b0, const bf16_t* b1, const bf16_t* b2, const bf16_t* b3, int KT, bf16_t* sm, int tid) {
  const int lane = tid & 63, w = tid >> 6, wm = w >> 1, wn = w & 1, h = lane >> 5, r31 = lane & 31;
  bf16_t* As = sm;
  bf16_t* Bs = sm + 2 * 128 * LDT;
  const int wr = (tid >> 3), wc = (tid & 7) * 8;
#pragma unroll
  for (int i = 0; i < 2; ++i)
#pragma unroll
    for (int j = 0; j < 2; ++j)
#pragma unroll
      for (int e = 0; e < 16; ++e) acc[i][j][e] = 0.f;
  uint4 pa0, pa1, pa2, pa3, pb0, pb1, pb2, pb3, qa0, qa1, qa2, qa3, qb0, qb1, qb2, qb3;
  G_LOAD(p, 0, 0);
  G_LOAD(q, aks, 64);
  __syncthreads();
  G_STORE(p, As, Bs);
  __syncthreads();
  const int aoff = (wm * 64 + r31) * LDT + 8 * h, boff = (wn * 64 + r31) * LDT + 8 * h;
  for (int kt = 0; kt < KT; kt += 2) {
    if (kt + 2 < KT) G_LOAD(p, (long)(kt + 2) * aks, (kt + 2) * 64);
    __builtin_amdgcn_sched_barrier(0);
    g_compute(acc, As + aoff, Bs + boff);
    __builtin_amdgcn_sched_barrier(0);
    G_STORE(q, As + 128 * LDT, Bs + 128 * LDT);
    __syncthreads();
    if (kt + 3 < KT) G_LOAD(q, (long)(kt + 3) * aks, (kt + 3) * 64);
    __builtin_amdgcn_sched_barrier(0);
    g_compute(acc, As + 128 * LDT + aoff, Bs + 128 * LDT + boff);
    __builtin_amdgcn_sched_barrier(0);
    if (kt + 2 < KT) G_STORE(p, As, Bs);
    __syncthreads();
  }
}


constexpr int BM = 256, BK = 64, HALF = 128, HTB = HALF * BK * 2, STAGE_BYTES = 8 * HTB, NXCD = 8, WGM = 8;
DI int lds_byte(int r, int c) { const int st = (r >> 4) * 2 + (c >> 5), rr = r & 15, cc = c & 31, ob = rr * 64 + cc * 2; return st * 1024 + (ob ^ (((ob >> 9) & 1) << 5)); }
DI void stage_rc(int b, int& R, int& C) { const int st = b / 1024, sb = b % 1024, swz = sb ^ (((sb >> 9) & 1) << 5); R = (st >> 1) * 16 + swz / 64; C = (st & 1) * 32 + (swz % 64) / 2; }
DI int perm32(int rho) { const int n = rho >> 4, i = rho & 15; return 8 * (i >> 2) + 4 * n + (i & 3); }
struct Unit { int pm, pn; };
struct Gemm { const bf16_t* A; const bf16_t* Bt; int lda, ldb, K; };
struct StaticOrder {
    int nM, nN, nwg, G, c;
    DI void init(int M, int N, int G_, int c_) { nM = M / BM; nN = N / BM; nwg = nM * nN; G = G_; c = c_; }
    DI bool next(int i, Unit& u) const {
        const long L = (long)i * G + c; if (L >= nwg) return false;
        int wgid = (int)L; { const int q = nwg / NXCD, r = nwg % NXCD, xcd = wgid % NXCD, off = wgid / NXCD; wgid = (xcd < r ? xcd * (q + 1) : r * (q + 1) + (xcd - r) * q) + off; }
        const int nig = WGM * nN, gid = wgid / nig, fm = gid * WGM, gsz = (nM - fm) < WGM ? (nM - fm) : WGM;
        u.pm = fm + ((wgid % nig) % gsz); u.pn = (wgid % nig) / gsz; return true;
    }
    DI void a_ready(const Unit&) const {}
    DI void done(const Unit&) const {}
};
struct OneUnit { Unit u; DI bool next(int i, Unit& o) const { if (i) return false; o = u; return true; } DI void a_ready(const Unit&) const {} DI void done(const Unit&) const {} };
template <class Epi, class Sched>
DI void gemm_phase(LAS unsigned char* lds, const Gemm g, const Sched& S, const Epi& E) {
    const int tid = tidx(), wid = __builtin_amdgcn_readfirstlane(tid >> 6), lane = tid & 63, wr = wid >> 2, wc = wid & 3, fr = lane & 15, fq = lane >> 4;
    const int K = g.K, nt = K / BK;
    unsigned voffA[2], voffB[2];
#pragma unroll
    for (int i = 0; i < 2; ++i) { int R, C; stage_rc(tid * 16 + i * 8192, R, C); const int Rb = Epi::PERM ? ((R & ~31) + perm32(R & 31)) : R;
        voffA[i] = (unsigned)(R * g.lda + C) * 2u; voffB[i] = (unsigned)(Rb * g.ldb + C) * 2u; }
    const size_t kstep = (size_t)(BK * 2);
    const size_t hstepA = (size_t)HALF * g.lda * 2, hstepB = (size_t)HALF * g.ldb * 2;
    const size_t tstepA = 2 * hstepA, tstepB = 2 * hstepB;
    const unsigned ldsw = (unsigned)wid * 1024u;
    const int aoff = lds_byte(wr * 64 + fr, fq * 8), boff = lds_byte(wc * 32 + fr, fq * 8);
#define PG8_SA(b, h) (((b) * 2 + (h)) * HTB)
#define PG8_SB(b, h) ((4 + (b) * 2 + (h)) * HTB)
#define PG8_STAGE(bufoff, gbase, voff) do { _Pragma("unroll") for (int _i = 0; _i < 2; ++_i) \
        __builtin_amdgcn_global_load_lds((const unsigned*)((const char*)(gbase) + (voff)[_i]), (LAS unsigned*)(lds + (bufoff) + ldsw + _i * 8192), 16, 0, 0); } while (0)
#define PG8_LDA(dst, b, h) do { _Pragma("unroll") for (int m = 0; m < 4; ++m) _Pragma("unroll") for (int k = 0; k < 2; ++k) dst[m][k] = *(const LAS bf16x8*)(lds + PG8_SA(b, h) + aoff + m * 2048 + k * 1024); } while (0)
#define PG8_LDB(dst, b, h) do { _Pragma("unroll") for (int n = 0; n < 2; ++n) _Pragma("unroll") for (int k = 0; k < 2; ++k) dst[n][k] = *(const LAS bf16x8*)(lds + PG8_SB(b, h) + boff + n * 2048 + k * 1024); } while (0)
#define PG8_MMA(ai, bj, At, Bt) do { __builtin_amdgcn_s_setprio(1); _Pragma("unroll") for (int m = 0; m < 4; ++m) _Pragma("unroll") for (int n = 0; n < 2; ++n) _Pragma("unroll") for (int k = 0; k < 2; ++k) \
        acc[ai][bj][m][n] = __builtin_amdgcn_mfma_f32_16x16x32_bf16(Bt[n][k], At[m][k], acc[ai][bj][m][n], 0, 0, 0); __builtin_amdgcn_s_setprio(0); } while (0)
#define PG8_WAIT_V(n) asm volatile("s_waitcnt vmcnt(" #n ")" ::: "memory")
#define PG8_WAIT_L(n) asm volatile("s_waitcnt lgkmcnt(" #n ")" ::: "memory")
#define PG8_BAR __builtin_amdgcn_s_barrier()
#define PG8_SCHED __builtin_amdgcn_sched_barrier(0)
    Unit cur, nxt; int ui = 0;
    if (!S.next(0, cur)) return;
    f32x4 acc[2][2][4][2];
#pragma unroll
    for (int a = 0; a < 2; ++a)
#pragma unroll
        for (int b = 0; b < 2; ++b)
#pragma unroll
            for (int m = 0; m < 4; ++m)
#pragma unroll
                for (int n = 0; n < 2; ++n) acc[a][b][m][n] = (f32x4){0.f, 0.f, 0.f, 0.f};
    bf16x8 At[4][2], B0[2][2], B1[2][2];
    const char* cA = (const char*)g.A + (size_t)cur.pm * tstepA; const char* cB = (const char*)g.Bt + (size_t)cur.pn * tstepB;
    S.a_ready(cur);
    PG8_STAGE(PG8_SB(0, 0), cB, voffB); PG8_STAGE(PG8_SA(0, 0), cA, voffA); PG8_STAGE(PG8_SB(0, 1), cB + hstepB, voffB); PG8_STAGE(PG8_SA(0, 1), cA + hstepA, voffA);
    if (wr == 1) PG8_BAR;
    PG8_WAIT_V(4); PG8_BAR;
    PG8_STAGE(PG8_SB(1, 0), cB + kstep, voffB); PG8_STAGE(PG8_SA(1, 0), cA + kstep, voffA); PG8_STAGE(PG8_SB(1, 1), cB + hstepB + kstep, voffB);
    PG8_WAIT_V(6); PG8_BAR;
    for (;;) {
        const bool has_next = S.next(ui + 1, nxt);
        const char* nA = has_next ? (const char*)g.A + (size_t)nxt.pm * tstepA : cA; const char* nB = has_next ? (const char*)g.Bt + (size_t)nxt.pn * tstepB : cB;
        for (int t = 0; t < nt; t += 2) {
            const bool last = (t == nt - 2);
            const char* a1 = cA + (size_t)(t + 1) * kstep;
            const char* a2 = last ? nA : cA + (size_t)(t + 2) * kstep; const char* b2 = last ? nB : cB + (size_t)(t + 2) * kstep;
            const char* a3 = a2 + kstep; const char* b3 = b2 + kstep;
            if (last && has_next) S.a_ready(nxt);
            PG8_LDB(B0, 0, 0); PG8_SCHED; PG8_LDA(At, 0, 0); PG8_STAGE(PG8_SA(1, 1), a1 + hstepA, voffA);
            PG8_WAIT_L(8); PG8_BAR; PG8_WAIT_L(0); PG8_MMA(0, 0, At, B0); PG8_BAR; PG8_SCHED;
            PG8_LDB(B1, 0, 1); PG8_STAGE(PG8_SB(0, 0), b2, voffB);
            PG8_BAR; PG8_WAIT_L(0); PG8_MMA(0, 1, At, B1); PG8_BAR;
            PG8_LDA(At, 0, 1); PG8_STAGE(PG8_SA(0, 0), a2, voffA);
            PG8_BAR; PG8_WAIT_L(0); PG8_MMA(1, 0, At, B0); PG8_BAR; PG8_SCHED;
            PG8_STAGE(PG8_SB(0, 1), b2 + hstepB, voffB);
            PG8_WAIT_V(6); PG8_BAR; PG8_MMA(1, 1, At, B1); PG8_BAR;
            PG8_LDB(B0, 1, 0); PG8_SCHED; PG8_LDA(At, 1, 0); PG8_STAGE(PG8_SA(0, 1), a2 + hstepA, voffA);
            PG8_WAIT_L(8); PG8_BAR; PG8_WAIT_L(0); PG8_MMA(0, 0, At, B0); PG8_BAR; PG8_SCHED;
            PG8_LDB(B1, 1, 1); PG8_STAGE(PG8_SB(1, 0), b3, voffB);
            PG8_BAR; PG8_WAIT_L(0); PG8_MMA(0, 1, At, B1); PG8_BAR;
            PG8_LDA(At, 1, 1); PG8_STAGE(PG8_SA(1, 0), a3, voffA);
            PG8_BAR; PG8_WAIT_L(0); PG8_MMA(1, 0, At, B0); PG8_BAR; PG8_SCHED;
            PG8_STAGE(PG8_SB(1, 1), b3 + hstepB, voffB);
            PG8_WAIT_V(6); PG8_BAR; PG8_MMA(1, 1, At, B1); PG8_BAR;
        }
        if constexpr (!Epi::AFTER_DRAIN) { E(acc, cur, wr, wc, fr, fq); S.done(cur); }
        if (!has_next) break;
#pragma unroll
        for (int a = 0; a < 2; ++a)
#pragma unroll
            for (int b = 0; b < 2; ++b)
#pragma unroll
                for (int m = 0; m < 4; ++m)
#pragma unroll
                    for (int n = 0; n < 2; ++n) acc[a][b][m][n] = (f32x4){0.f, 0.f, 0.f, 0.f};
        cur = nxt; cA = nA; cB = nB; ++ui;
    }
    PG8_WAIT_V(0);
    if (wr == 0) PG8_BAR;
    PG8_BAR;
    if constexpr (Epi::AFTER_DRAIN) { E.fused(acc, cur, wr, wc, fr, fq, lds, wid, lane); S.done(cur); }
#undef PG8_SA
#undef PG8_SB
#undef PG8_STAGE
#undef PG8_LDA
#undef PG8_LDB
#undef PG8_MMA
#undef PG8_WAIT_V
#undef PG8_WAIT_L
#undef PG8_BAR
#undef PG8_SCHED
}

struct TJob { const float* src; int ld; int mode; bf16_t* dst; int ldd; int ntn; int ntk; };

DI TJob get_job(int j, const Params& p, int l) {
  char* ws = WS(p);
  TJob t;
  switch (j) {
    case 0: t = {IN(2) + (size_t)l * 1024 * NIN, NIN, 1, (bf16_t*)(ws + O_WTA), 1024, 60, 16}; break;
    case 1: t = {IN(2) + (size_t)l * 1024 * NIN + 3736, NIN, 0, (bf16_t*)(ws + O_WTM), 1024, 48, 16}; break;
    case 2: t = {IN(24) + (size_t)l * 512 * 1024, 1024, 0, (bf16_t*)(ws + O_WTP), 1024, 16, 8}; break;
    case 3: t = {IN(25) + (size_t)l * 256 * 1024, 1024, 0, (bf16_t*)(ws + O_WTP) + 512, 1024, 16, 4}; break;
    case 4: t = {IN(26) + (size_t)l * 256 * 1024, 1024, 0, (bf16_t*)(ws + O_WTP) + 768, 1024, 16, 4}; break;
    case 5: t = {IN(27) + (size_t)l * 1024 * 1024, 1024, 0, (bf16_t*)(ws + O_WTO), 1024, 16, 16}; break;
    case 6: t = {IN(5) + (size_t)l * 2048 * 128, 128, 0, (bf16_t*)(ws + O_W1K), 2048, 2, 32}; break;
    case 7: t = {IN(8) + (size_t)l * 2048 * 128, 128, 0, (bf16_t*)(ws + O_W1V), 2048, 2, 32}; break;
    case 8: t = {IN(6) + (size_t)l * 128 * 64, 64, 0, (bf16_t*)(ws + O_W2K), 128, 1, 2}; break;
    case 9: t = {IN(9) + (size_t)l * 128 * 64, 64, 0, (bf16_t*)(ws + O_W2V), 128, 1, 2}; break;
    case 10: t = {IN(13) + (size_t)l * 64 * 256, 256, 0, (bf16_t*)(ws + O_LW2), 64, 4, 1}; break;
    default: t = {IN(15) + (size_t)l * 64 * 256, 256, 0, (bf16_t*)(ws + O_LA2), 64, 4, 1}; break;
  }
  return t;
}

struct TrTile { TJob jb; int n0, k0; bool valid; };
DI TrTile tr_find(const Params& p, int l, int id) {
  TrTile t; t.valid = id < 2380;
  int rem = t.valid ? id : 0;
  t.jb = get_job(0, p, l);
  for (int j = 0; j < 12; ++j) {
    t.jb = get_job(j, p, l);
    const int cnt = t.jb.ntn * t.jb.ntk;
    if (rem < cnt) break;
    rem -= cnt;
  }
  t.n0 = (rem / t.jb.ntk) * 64; t.k0 = (rem % t.jb.ntk) * 64;
  return t;
}
DI void tr_load(const TrTile& t, int tid, float4 (&r)[4]) {
  const int n4 = (tid & 15) * 4;
  const int c = t.n0 + n4;
  int oc = c; bool cv = t.valid;
  if (t.jb.mode == 1) {
    if (c < 1280) oc = c; else if (c < 3712) oc = c + 24; else if (c < 3736) oc = c - 3712 + 1280; else { oc = 0; cv = false; }
  }
#pragma unroll
  for (int pz = 0; pz < 4; ++pz) {
    const int kk = (tid >> 4) + 16 * pz;
    r[pz] = make_float4(0.f, 0.f, 0.f, 0.f);
    if (cv) r[pz] = *(const float4*)(t.jb.src + (size_t)(t.k0 + kk) * t.jb.ld + oc);
  }
}
DI void tr_put(float* tile, int tid, const float4 (&r)[4]) {
  const int n4 = (tid & 15) * 4;
#pragma unroll
  for (int pz = 0; pz < 4; ++pz) {
    const int kk = (tid >> 4) + 16 * pz;
    tile[kk * 65 + n4 + 0] = r[pz].x; tile[kk * 65 + n4 + 1] = r[pz].y; tile[kk * 65 + n4 + 2] = r[pz].z; tile[kk * 65 + n4 + 3] = r[pz].w;
  }
}
DI void tr_store(const TrTile& t, const float* tile, int tid) {
  if (t.valid) {
#pragma unroll
    for (int pz = 0; pz < 2; ++pz) {
      const int q = tid + 256 * pz;
      const int nn = q >> 3, kc = (q & 7) * 8;
      uint4 o;
      o.x = pack2(tile[(kc + 0) * 65 + nn], tile[(kc + 1) * 65 + nn]);
      o.y = pack2(tile[(kc + 2) * 65 + nn], tile[(kc + 3) * 65 + nn]);
      o.z = pack2(tile[(kc + 4) * 65 + nn], tile[(kc + 5) * 65 + nn]);
      o.w = pack2(tile[(kc + 6) * 65 + nn], tile[(kc + 7) * 65 + nn]);
      *(uint4*)(t.jb.dst + (size_t)(t.n0 + nn) * t.jb.ldd + t.k0 + kc) = o;
    }
  }
}

DI float wave_sum(float v) {
#pragma unroll
  for (int o = 32; o > 0; o >>= 1) v += __shfl_xor(v, o, 64);
  return v;
}

DI void rmsnorm_rows(const float* x, const float* g, bf16_t* outb, float* outf) {
  const int lane = tidx() & 63, w = tidx() >> 6;
  for (int it = bidx(); it < NTOK / 16; it += gridDim.x) {
    float4 v[2][4]; float ss[2] = {0.f, 0.f};
#pragma unroll
    for (int rr = 0; rr < 2; ++rr) {
      const float* xr = x + (size_t)(it * 16 + rr * 8 + w) * 1024;
#pragma unroll
      for (int i = 0; i < 4; ++i) v[rr][i] = *(const float4*)(xr + lane * 4 + 256 * i);
    }
    float4 gg[4];
#pragma unroll
    for (int i = 0; i < 4; ++i) gg[i] = *(const float4*)(g + lane * 4 + 256 * i);
#pragma unroll
    for (int rr = 0; rr < 2; ++rr) {
#pragma unroll
      for (int i = 0; i < 4; ++i) ss[rr] += v[rr][i].x * v[rr][i].x + v[rr][i].y * v[rr][i].y + v[rr][i].z * v[rr][i].z + v[rr][i].w * v[rr][i].w;
      ss[rr] = wave_sum_fast(ss[rr]);
    }
#pragma unroll
    for (int rr = 0; rr < 2; ++rr) {
      const int row = it * 16 + rr * 8 + w;
      const float rs = rsqrtf(ss[rr] * (1.f / 1024.f) + 1e-6f);
#pragma unroll
      for (int i = 0; i < 4; ++i) {
        const float o0 = v[rr][i].x * rs * gg[i].x, o1 = v[rr][i].y * rs * gg[i].y, o2 = v[rr][i].z * rs * gg[i].z, o3 = v[rr][i].w * rs * gg[i].w;
        if (outf) { *(float4*)(outf + (size_t)row * 1024 + lane * 4 + 256 * i) = make_float4(o0, o1, o2, o3); }
        else { uint2 o; o.x = pack2(o0, o1); o.y = pack2(o2, o3); *(uint2*)(outb + (size_t)row * 1024 + lane * 4 + 256 * i) = o; }
      }
    }
  }
}

DI void phase0(const Params& p, int l, char* smraw) {
  const int half = tidx() >> 8, ltid = tidx() & 255;
  float* tile = (float*)(smraw + half * 17408);
  {
    int id0 = bidx() * 2;
    TrTile cur = tr_find(p, l, id0 + half);
    float4 rg[4];
    tr_load(cur, ltid, rg);
    while (id0 < 2380) {
      tr_put(tile, ltid, rg);
      __syncthreads();
      const int id1 = id0 + gridDim.x * 2;
      TrTile nxt = tr_find(p, l, id1 + half);
      if (id1 < 2380) tr_load(nxt, ltid, rg);
      tr_store(cur, tile, ltid);
      __syncthreads();
      cur = nxt; id0 = id1;
    }
  }
  const float* xin = (l == 0) ? IN(0) : OUTP();
  rmsnorm_rows(xin, IN(1) + l * 1024, (bf16_t*)(WS(p) + O_XN), nullptr);
  const int gtid = bidx() * 512 + tidx(), nth = gridDim.x * 512;
  if (l == 1) {
    bf16_t* v1t = (bf16_t*)(WS(p) + O_V1T); bf16_t* v2t = (bf16_t*)(WS(p) + O_V2T);
    const float* v1 = IN(22); const float* v2 = IN(23);
    for (int idx = gtid; idx < 8192; idx += nth) {
      { const int j = idx >> 8, c = idx & 255; v1t[idx] = f2bf(v1[c * 32 + j]); }
      { const int c = idx >> 5, j = idx & 31; v2t[idx] = f2bf(v2[j * 256 + c]); }
    }
  }
  {
    bf16_t* kc = (bf16_t*)(WS(p) + O_KC); bf16_t* vct = (bf16_t*)(WS(p) + O_VCT);
    for (int idx = gtid; idx < 1024; idx += nth) {
      const int bg = idx >> 6, d = idx & 63;
      kc[(bg * 128 + 127) * 64 + d] = 0; vct[(bg * 64 + d) * 128 + 127] = 0;
    }
    if (gtid == 0) { ((int*)(WS(p) + O_CNT))[l] = 0; }
    if (gtid == 1) { ((int*)(WS(p) + O_CNT))[4 + l] = 0; }
  }
  {
    const int lane = tidx() & 63, gw = bidx() * 8 + (tidx() >> 6), nw = gridDim.x * 8;
    float* peb = (float*)(WS(p) + O_PEB);
    for (int o = gw; o < 256; o += nw) {
      const int which = o >> 7, n = o & 127;
      const float* pe = (which ? IN(7) : IN(4)) + (size_t)l * 2048;
      const float* w1 = (which ? IN(8) : IN(5)) + (size_t)l * 2048 * 128;
      float s = 0.f;
      float pa[32], pb[32];
#pragma unroll
      for (int i = 0; i < 32; ++i) { const int k = lane + 64 * i; pa[i] = pe[k]; pb[i] = w1[(size_t)k * 128 + n]; }
#pragma unroll
      for (int i = 0; i < 32; ++i) s += pa[i] * pb[i];
      s = wave_sum(s);
      if (lane == 0) peb[o] = s;
    }
  }
}

DI u32x4 pack8(const f32x4& a, const f32x4& b) {
  u32x4 w; w.x = pack2(a[0], a[1]); w.y = pack2(a[2], a[3]); w.z = pack2(b[0], b[1]); w.w = pack2(b[2], b[3]); return w;
}
struct EpiH {
  static constexpr bool PERM = true, AFTER_DRAIN = false;
  bf16_t* H; bf16_t* VT;
  DI void operator()(const f32x4 (&acc)[2][2][4][2], const Unit& u, int wr, int wc, int fr, int fq) const {
    const int row0 = u.pm * BM + wr * 64 + fr;
    const int cl = wc * 32 + 8 * fq;
    const int which = (u.pn == 3) ? 0 : (u.pn == 4) ? 1 : (u.pn == 8) ? 2 : -1;
#pragma unroll
    for (int ai = 0; ai < 2; ++ai)
#pragma unroll
      for (int m = 0; m < 4; ++m) {
        const int row = row0 + ai * HALF + m * 16;
        *(u32x4*)(H + (size_t)row * HS + u.pn * BM + cl) = pack8(acc[ai][0][m][0], acc[ai][0][m][1]);
        if (which < 0) {
          *(u32x4*)(H + (size_t)row * HS + u.pn * BM + HALF + cl) = pack8(acc[ai][1][m][0], acc[ai][1][m][1]);
        } else {
          const int b = row >> 11, t = row & 2047;
          bf16_t* vp = VT + ((size_t)((which * 8 + b) * 128 + cl)) * 2048 + t;
#pragma unroll
          for (int j = 0; j < 4; ++j) { vp[(size_t)j * 2048] = f2bf(acc[ai][1][m][0][j]); vp[(size_t)(4 + j) * 2048] = f2bf(acc[ai][1][m][1][j]); }
        }
      }
  }
};
DI void phase1(const Params& p, char* smraw) {
  Gemm g{(const bf16_t*)(WS(p) + O_XN), (const bf16_t*)(WS(p) + O_WTA), 1024, 1024, 1024};
  StaticOrder S; S.init(NTOK, HS, gridDim.x, bidx());
  EpiH E{(bf16_t*)(WS(p) + O_H), (bf16_t*)(WS(p) + O_VT)};
  gemm_phase<EpiH, StaticOrder>((LAS unsigned char*)smraw, g, S, E);
}

DI void compress_tile2(const Params& p, int l_, int tix, char* smraw) {
  const int half = tidx() >> 8, tid = tidx() & 255;
  const int which = tix >> 4, mt = tix & 15;
  bf16_t* sm = (bf16_t*)(smraw + half * SMEM_BYTES);
  const bf16_t* hb = (const bf16_t*)(WS(p) + O_H);
  const bf16_t* w1t = (const bf16_t*)(WS(p) + (which ? O_W1V : O_W1K));
  const bf16_t* w2t = (const bf16_t*)(WS(p) + (which ? O_W2V : O_W2K));
  const float* peb = (const float*)(WS(p) + O_PEB) + which * 128;
  const int lane = tid & 63, w = tid >> 6, wm = w >> 1, wn = w & 1, h = lane >> 5, r31 = lane & 31;
  const int wr = tid >> 3, wc = (tid & 7) * 8;
  const int col0 = which ? C_VC : C_KC;
  const bf16_t* ap[4];
#pragma unroll
  for (int i = 0; i < 4; ++i) {
    int m = mt * 128 + wr + 32 * i; if (m >= 2032) m = 0;
    const int b = m / 254, rem = m - b * 254, n = rem >> 1, g = rem & 1;
    ap[i] = hb + ((size_t)(b * 2048 + 16 * n + 16 * half)) * HS + col0 + g * 64 + wc;
  }
  const bf16_t* b0 = w1t + (size_t)wr * 2048 + wc + half * 1024;
  f32x16 acc[2][2];
  gemm_core(acc, ap[0], ap[1], ap[2], ap[3], HS, b0, b0 + 32 * 2048, b0 + 64 * 2048, b0 + 96 * 2048, 16, sm, tid);
  float4* part = (float4*)(smraw + SMEM_BYTES);
  if (half == 1) {
#pragma unroll
    for (int i = 0; i < 2; ++i)
#pragma unroll
      for (int j = 0; j < 2; ++j)
#pragma unroll
        for (int q = 0; q < 4; ++q)
          part[((i * 2 + j) * 4 + q) * 256 + tid] = make_float4(acc[i][j][4 * q], acc[i][j][4 * q + 1], acc[i][j][4 * q + 2], acc[i][j][4 * q + 3]);
  }
  __syncthreads();
  bf16_t* Hs = (bf16_t*)smraw;
  if (half == 0) {
#pragma unroll
    for (int i = 0; i < 2; ++i)
#pragma unroll
      for (int j = 0; j < 2; ++j) {
        const int n = wn * 64 + 32 * j + r31;
        const float bias = peb[n];
#pragma unroll
        for (int q = 0; q < 4; ++q) {
          const float4 o = part[((i * 2 + j) * 4 + q) * 256 + tid];
          const int r = wm * 64 + 32 * i + 8 * q + 4 * h;
          Hs[(r + 0) * 136 + n] = f2bf(siluf_(acc[i][j][4 * q + 0] + o.x + bias));
          Hs[(r + 1) * 136 + n] = f2bf(siluf_(acc[i][j][4 * q + 1] + o.y + bias));
          Hs[(r + 2) * 136 + n] = f2bf(siluf_(acc[i][j][4 * q + 2] + o.z + bias));
          Hs[(r + 3) * 136 + n] = f2bf(siluf_(acc[i][j][4 * q + 3] + o.w + bias));
        }
      }
  }
  __syncthreads();
  if (half == 0) {
    f32x16 o2[2];
#pragma unroll
    for (int j = 0; j < 2; ++j)
#pragma unroll
      for (int e = 0; e < 16; ++e) o2[j][e] = 0.f;
#pragma unroll
    for (int s = 0; s < 8; ++s) {
      const bf16x8 fa = *(const bf16x8*)(Hs + (w * 32 + r31) * 136 + 16 * s + 8 * h);
#pragma unroll
      for (int j = 0; j < 2; ++j) {
        const bf16x8 fb = *(const bf16x8*)(w2t + (32 * j + r31) * 128 + 16 * s + 8 * h);
        o2[j] = MFMA32(fa, fb, o2[j]);
      }
    }
    bf16_t* kc = (bf16_t*)(WS(p) + O_KC); bf16_t* vct = (bf16_t*)(WS(p) + O_VCT);
#pragma unroll
    for (int j = 0; j < 2; ++j) {
      const int d = 32 * j + r31;
#pragma unroll
      for (int e = 0; e < 16; ++e) {
        const int m = mt * 128 + w * 32 + crow(e, h);
        if (m < 2032) {
          const int b = m / 254, rem = m - b * 254, n = rem >> 1, g = rem & 1;
          if (which == 0) kc[((size_t)((b * 2 + g) * 128 + n)) * 64 + d] = f2bf(o2[j][e]);
          else vct[((size_t)((b * 2 + g) * 64 + d)) * 128 + n] = f2bf(o2[j][e]);
        }
      }
    }
  }
  __builtin_amdgcn_fence(__ATOMIC_RELEASE, "agent");
  __syncthreads();
  if (tidx() == 0) atomicAdd((int*)(WS(p) + O_CNT) + 4 + l_, 1);
}

DI void rwkv_prep(const Params& p, int l, int item, char* smraw) {
  const bf16_t* hb = (const bf16_t*)(WS(p) + O_H);
  bf16_t* A1 = (bf16_t*)smraw;
  bf16_t* A2 = A1 + 64 * LDT;
  bf16_t* A3 = A2 + 64 * LDT;
  const int tid = tidx(), lane = tid & 63, w = (tid >> 6) & 3, tt = tid >> 8, h = lane >> 5, r31 = lane & 31;
  const int T0 = item * 64;
  const float* mu = IN(11) + l * 896;
  __syncthreads();
  bf16_t* SR = A3 + 64 * 264;
  {
    const bool seqstart = (T0 & 2047) == 0;
    uint4 sv[13];
#pragma unroll
    for (int i = 0; i < 13; ++i) {
      const int idx = tid + 512 * i, row = idx / 96, c = idx - row * 96;
      sv[i] = make_uint4(0, 0, 0, 0);
      if (idx < 65 * 96 && (row > 0 || !seqstart)) sv[i] = *(const uint4*)(hb + (size_t)(T0 - 1 + row) * HS + C_R + c * 8);
    }
#pragma unroll
    for (int i = 0; i < 13; ++i) {
      const int idx = tid + 512 * i, row = idx / 96, c = idx - row * 96;
      if (idx < 65 * 96) *(uint4*)(SR + row * 776 + c * 8) = sv[i];
    }
  }
#pragma unroll
  for (int idx = tid; idx < 64 * 16; idx += 512) {
    const int tok = idx >> 4, c8 = idx & 15;
    const size_t m = (size_t)(T0 + tok);
    const uint4 z = *(const uint4*)(hb + m * HS + C_WD + c8 * 8);
    uint4 zp = make_uint4(0, 0, 0, 0);
    if (((T0 + tok) & 2047) != 0) zp = *(const uint4*)(hb + (m - 1) * HS + C_WD + c8 * 8);
    const unsigned zz[4] = {z.x, z.y, z.z, z.w}, pp[4] = {zp.x, zp.y, zp.z, zp.w};
    unsigned oo[4];
#pragma unroll
    for (int e = 0; e < 4; ++e) {
      const float m0 = mu[768 + c8 * 8 + 2 * e], m1 = mu[768 + c8 * 8 + 2 * e + 1];
      float x0 = bflo(zz[e]), x1 = bfhi(zz[e]);
      x0 = x0 + (bflo(pp[e]) - x0) * m0; x1 = x1 + (bfhi(pp[e]) - x1) * m1;
      if (c8 < 8) { x0 = 1.f - 2.f * __builtin_amdgcn_rcpf(__expf(2.f * x0) + 1.f); x1 = 1.f - 2.f * __builtin_amdgcn_rcpf(__expf(2.f * x1) + 1.f); }
      oo[e] = pack2(x0, x1);
    }
    bf16_t* dst = (c8 < 8) ? (A1 + tok * LDT + c8 * 8) : (A2 + tok * LDT + (c8 - 8) * 8);
    *(uint4*)dst = make_uint4(oo[0], oo[1], oo[2], oo[3]);
  }
  __syncthreads();
  if (l == 1) {
    for (int idx = tid; idx < 64 * 32; idx += 512) {
      const int tok = idx >> 5, c8 = idx & 31;
      const size_t m = (size_t)(T0 + tok);
      const uint4 z = *(const uint4*)(SR + (tok + 1) * 776 + 512 + c8 * 8);
      const uint4 zp = *(const uint4*)(SR + tok * 776 + 512 + c8 * 8);
      const unsigned zz[4] = {z.x, z.y, z.z, z.w}, pp[4] = {zp.x, zp.y, zp.z, zp.w};
      unsigned oo[4];
#pragma unroll
      for (int e = 0; e < 4; ++e) {
        const float m0 = mu[512 + c8 * 8 + 2 * e], m1 = mu[512 + c8 * 8 + 2 * e + 1];
        float x0 = bflo(zz[e]), x1 = bfhi(zz[e]);
        x0 = x0 + (bflo(pp[e]) - x0) * m0; x1 = x1 + (bfhi(pp[e]) - x1) * m1;
        oo[e] = pack2(x0, x1);
      }
      *(uint4*)(A3 + tok * 264 + c8 * 8) = make_uint4(oo[0], oo[1], oo[2], oo[3]);
    }
  }
  __syncthreads();
  const bf16_t* lw2 = (const bf16_t*)(WS(p) + O_LW2);
  const bf16_t* la2 = (const bf16_t*)(WS(p) + O_LA2);
  const bf16_t* v1t = (const bf16_t*)(WS(p) + O_V1T);
  const bf16_t* v2t = (const bf16_t*)(WS(p) + O_V2T);
  const float* w0 = IN(12) + l * 256; const float* a0 = IN(14) + l * 256;
  const float* kkw = IN(16) + l * 256; const float* kaw = IN(17) + l * 256; const float* rkw = IN(18) + l * 256;
  const float* v0 = IN(21);
  bf16_t* vf = (bf16_t*)(WS(p) + O_VF);
  bf16_t* pr = (bf16_t*)(WS(p) + O_PR);
  float* bon = (float*)(WS(p) + O_BON);
  {
    const int tokl = 32 * tt + r31;
    const size_t m = (size_t)(T0 + tokl);
    const bool first = (((T0 + tokl) & 2047) == 0);
    const int b = (int)(m >> 11), t = (int)(m & 2047);
    float ss = 0.f;
#pragma unroll
    for (int nt = 0; nt < 2; ++nt)
#pragma unroll
      for (int q = 0; q < 4; ++q) {
        const int c = w * 64 + 32 * nt + 8 * q + 4 * h;
        const uint2 zk = *(const uint2*)(SR + (tokl + 1) * 776 + 256 + c);
        const uint2 pk_ = *(const uint2*)(SR + tokl * 776 + 256 + c);
        const float4 muk = *(const float4*)(mu + 256 + c);
        const float4 kw4 = *(const float4*)(kkw + c);
        float x0 = bflo(zk.x), x1 = bfhi(zk.x), x2 = bflo(zk.y), x3 = bfhi(zk.y);
        x0 = (x0 + (bflo(pk_.x) - x0) * muk.x) * kw4.x; x1 = (x1 + (bfhi(pk_.x) - x1) * muk.y) * kw4.y;
        x2 = (x2 + (bflo(pk_.y) - x2) * muk.z) * kw4.z; x3 = (x3 + (bfhi(pk_.y) - x3) * muk.w) * kw4.w;
        ss += x0 * x0 + x1 * x1 + x2 * x2 + x3 * x3;
      }
    ss = xor32_sum(ss);
    const float inv = 1.f / fmaxf(sqrtf(ss), 1e-12f);
    float bsum = 0.f;
    bf16_t* prow = pr + ((size_t)((b * 4 + w) * 2048 + t)) * 384;
#pragma unroll 1
    for (int nt = 0; nt < 2; ++nt) {
      f32x16 aw, aa, av;
#pragma unroll
      for (int e = 0; e < 16; ++e) { aw[e] = 0.f; aa[e] = 0.f; av[e] = 0.f; }
#pragma unroll
      for (int s = 0; s < 4; ++s) {
        const bf16x8 f1 = *(const bf16x8*)(A1 + (32 * tt + r31) * LDT + 16 * s + 8 * h);
        const bf16x8 f2 = *(const bf16x8*)(A2 + (32 * tt + r31) * LDT + 16 * s + 8 * h);
        const bf16x8 gw = *(const bf16x8*)(lw2 + (w * 64 + 32 * nt + r31) * 64 + 16 * s + 8 * h);
        const bf16x8 ga = *(const bf16x8*)(la2 + (w * 64 + 32 * nt + r31) * 64 + 16 * s + 8 * h);
        aw = MFMA32(gw, f1, aw);
        aa = MFMA32(ga, f2, aa);
      }
      if (l == 1) {
        f32x16 t1;
#pragma unroll
        for (int e = 0; e < 16; ++e) t1[e] = 0.f;
#pragma unroll
        for (int s = 0; s < 16; ++s) {
          const bf16x8 fv = *(const bf16x8*)(A3 + (32 * tt + r31) * 264 + 16 * s + 8 * h);
          const bf16x8 g1 = *(const bf16x8*)(v1t + r31 * 256 + 16 * s + 8 * h);
          t1 = MFMA32(g1, fv, t1);
        }
#pragma unroll
        for (int s = 0; s < 2; ++s) {
          unsigned pk[4];
#pragma unroll
          for (int e = 0; e < 4; ++e) pk[e] = pack2(t1[8 * s + 2 * e], t1[8 * s + 2 * e + 1]);
          const bf16x8 fb = __builtin_bit_cast(bf16x8, make_uint4(pk[0], pk[1], pk[2], pk[3]));
          const bf16_t* vr = v2t + (w * 64 + 32 * nt + r31) * 32 + 16 * s + 4 * h;
          const uint2 lo = *(const uint2*)vr; const uint2 hi = *(const uint2*)(vr + 8);
          const bf16x8 fa = __builtin_bit_cast(bf16x8, make_uint4(lo.x, lo.y, hi.x, hi.y));
          av = MFMA32(fa, fb, av);
        }
      }
      uint2 sto[4][6];
#pragma unroll
      for (int q = 0; q < 4; ++q) {
        const int cl = 32 * nt + 8 * q + 4 * h;
        const int c = w * 64 + cl;
        const uint2 zr = *(const uint2*)(SR + (tokl + 1) * 776 + c);
        const uint2 zk = *(const uint2*)(SR + (tokl + 1) * 776 + 256 + c);
        const uint2 zv = *(const uint2*)(SR + (tokl + 1) * 776 + 512 + c);
        const uint2 pr_ = *(const uint2*)(SR + tokl * 776 + c);
        const uint2 pk_ = *(const uint2*)(SR + tokl * 776 + 256 + c);
        const uint2 pv_ = *(const uint2*)(SR + tokl * 776 + 512 + c);
        uint2 vfl = make_uint2(0, 0);
        if (l == 1) vfl = *(const uint2*)(vf + m * 256 + c);
        float orr[4], ou[4], okp[4], ovv[4], oa[4], ob[4];
#pragma unroll
        for (int e = 0; e < 4; ++e) {
          const int cc = c + e; const int i = 4 * q + e;
          const unsigned zru = (e < 2) ? zr.x : zr.y, zku = (e < 2) ? zk.x : zk.y, zvu = (e < 2) ? zv.x : zv.y;
          const unsigned pru = (e < 2) ? pr_.x : pr_.y, pku = (e < 2) ? pk_.x : pk_.y, pvu = (e < 2) ? pv_.x : pv_.y;
          const unsigned vfu = (e < 2) ? vfl.x : vfl.y;
          float xr = (e & 1) ? bfhi(zru) : bflo(zru), xk = (e & 1) ? bfhi(zku) : bflo(zku), xv = (e & 1) ? bfhi(zvu) : bflo(zvu);
          const float qr = (e & 1) ? bfhi(pru) : bflo(pru), qk = (e & 1) ? bfhi(pku) : bflo(pku), qv = (e & 1) ? bfhi(pvu) : bflo(pvu);
          xr = xr + (qr - xr) * mu[cc]; xk = xk + (qk - xk) * mu[256 + cc]; xv = xv + (qv - xv) * mu[512 + cc];
          const float wl = w0[cc] + aw[i];
          const float ew = 0.60653065971f * sigmoidf_(wl);
          const float u = ew * (1.f - ew * 0.5f * (1.f - ew * (1.f / 3.f) * (1.f - ew * 0.25f * (1.f - ew * 0.2f * (1.f - ew * (1.f / 6.f) * (1.f - ew * (1.f / 7.f) * (1.f - ew * 0.125f)))))));
          const float a = sigmoidf_(a0[cc] + aa[i]);
          if (l == 1) {
            const float vfirst = (e & 1) ? bfhi(vfu) : bflo(vfu);
            xv = xv + (vfirst - xv) * sigmoidf_(v0[cc] + av[i]);
          }
          const float kk = xk * kkw[cc] * inv;
          const float kp = xk * (1.f + (a - 1.f) * kaw[cc]);
          bsum += xr * kp * rkw[cc];
          orr[e] = xr; ou[e] = u; okp[e] = kp; ovv[e] = xv; oa[e] = -kk; ob[e] = kk * a;
        }
        uint2 o;
        o.x = pack2(orr[0], orr[1]); o.y = pack2(orr[2], orr[3]); sto[q][0] = o;
        o.x = pack2(ou[0], ou[1]); o.y = pack2(ou[2], ou[3]); sto[q][1] = o;
        o.x = pack2(okp[0], okp[1]); o.y = pack2(okp[2], okp[3]); sto[q][2] = o;
        o.x = pack2(ovv[0], ovv[1]); o.y = pack2(ovv[2], ovv[3]); sto[q][3] = o;
        o.x = pack2(oa[0], oa[1]); o.y = pack2(oa[2], oa[3]); sto[q][4] = o;
        o.x = pack2(ob[0], ob[1]); o.y = pack2(ob[2], ob[3]); sto[q][5] = o;
      }
#pragma unroll
      for (int q = 0; q < 4; ++q) {
        const int cl = 32 * nt + 8 * q + 4 * h;
#pragma unroll
        for (int k6 = 0; k6 < 6; ++k6) *(uint2*)(prow + k6 * 64 + cl) = sto[q][k6];
        if (l == 0) *(uint2*)(vf + m * 256 + w * 64 + cl) = sto[q][3];
      }
    }
    bsum = xor32_sum(bsum);
    if (h == 0) bon[m * 4 + w] = bsum;
  }
  __syncthreads();
}

DI float dpp_add(float x, const int ctrl_sel) {
  int xi = __float_as_int(x), yi;
  if (ctrl_sel == 0) yi = __builtin_amdgcn_update_dpp(0, xi, 0xB1, 0xF, 0xF, true);
  else if (ctrl_sel == 1) yi = __builtin_amdgcn_update_dpp(0, xi, 0x4E, 0xF, 0xF, true);
  else if (ctrl_sel == 2) yi = __builtin_amdgcn_update_dpp(0, xi, 0x141, 0xF, 0xF, true);
  else yi = __builtin_amdgcn_update_dpp(0, xi, 0x140, 0xF, 0xF, true);
  return x + __int_as_float(yi);
}
DI float row16_sum(float x) { x = dpp_add(x, 0); x = dpp_add(x, 1); x = dpp_add(x, 2); x = dpp_add(x, 3); return x; }

DI void scan_put(const uint4& g, int idx, float* dstbase) {
  const int e0 = idx * 8; const int arr = (e0 % 384) >> 6;
  float f[8] = {bflo(g.x), bfhi(g.x), bflo(g.y), bfhi(g.y), bflo(g.z), bfhi(g.z), bflo(g.w), bfhi(g.w)};
  if (arr == 1) {
#pragma unroll
    for (int e = 0; e < 8; ++e) f[e] = 1.f - f[e];
  }
  *(float4*)(dstbase + e0) = make_float4(f[0], f[1], f[2], f[3]);
  *(float4*)(dstbase + e0 + 4) = make_float4(f[4], f[5], f[6], f[7]);
}
DI void rwkv_scan(const Params& p, int item, char* smraw) {
  const int rg = item & 3, hd = (item >> 2) & 3, b = item >> 4;
  float* stage = (float*)smraw;
  const bf16_t* pr = (const bf16_t*)(WS(p) + O_PR) + ((size_t)((b * 4 + hd) * 2048)) * 384;
  bf16_t* yr = (bf16_t*)(WS(p) + O_YR);
  const int tid = tidx(), row = (tid >> 4) & 15, kq = tid & 15;
  const bool comp = tid < 256;
  const int st_ = tid & 255;
  fv2 S01 = {0.f, 0.f}, S23 = {0.f, 0.f};
  uint4 g[3];
  __syncthreads();
  if (comp) __builtin_amdgcn_s_setprio(3);
  if (!comp) {
#pragma unroll
    for (int c0 = 0; c0 < 2; ++c0) {
#pragma unroll
      for (int i = 0; i < 3; ++i) g[i] = *(const uint4*)(pr + (size_t)c0 * 16 * 384 + (size_t)(st_ + 256 * i) * 8);
#pragma unroll
      for (int i = 0; i < 3; ++i) scan_put(g[i], st_ + 256 * i, stage + c0 * 16 * 384);
    }
#pragma unroll
    for (int i = 0; i < 3; ++i) g[i] = *(const uint4*)(pr + (size_t)2 * 16 * 384 + (size_t)(st_ + 256 * i) * 8);
  }
  __syncthreads();
  float4 Pr0, Pw0, Pk0, Pa0, Pb0, Pr1, Pw1, Pk1, Pa1, Pb1; float Pv0, Pv1;
  {
    const float* sp = stage + 4 * kq; const float* vp = stage + 3 * 64 + 16 * rg + row;
    Pr0 = *(const float4*)(sp + 0 * 64); Pw0 = *(const float4*)(sp + 1 * 64); Pk0 = *(const float4*)(sp + 2 * 64); Pa0 = *(const float4*)(sp + 4 * 64); Pb0 = *(const float4*)(sp + 5 * 64); Pv0 = vp[0];
    sp += 384; vp += 384;
    Pr1 = *(const float4*)(sp + 0 * 64); Pw1 = *(const float4*)(sp + 1 * 64); Pk1 = *(const float4*)(sp + 2 * 64); Pa1 = *(const float4*)(sp + 4 * 64); Pb1 = *(const float4*)(sp + 5 * 64); Pv1 = vp[0];
  }
  int cur = 0;
  for (int ch = 0; ch < 128; ++ch) {
    if (comp) {
      int nxt = cur + 1; if (nxt == 3) nxt = 0;
      const float* st = stage + cur * 16 * 384 + 4 * kq;
      const float* sv = stage + cur * 16 * 384 + 3 * 64 + 16 * rg + row;
      const float* stn = stage + nxt * 16 * 384 + 4 * kq;
      const float* svn = stage + nxt * 16 * 384 + 3 * 64 + 16 * rg + row;
      float ykeep = 0.f, yp = 0.f;
#pragma unroll
      for (int s = 0; s < 16; ++s) {
        float4 cr, cw, ck, ca, cb; float cv;
        if (s & 1) { cr = Pr1; cw = Pw1; ck = Pk1; ca = Pa1; cb = Pb1; cv = Pv1; }
        else { cr = Pr0; cw = Pw0; ck = Pk0; ca = Pa0; cb = Pb0; cv = Pv0; }
        {
          const float* sp = (s < 14) ? (st + (s + 2) * 384) : (stn + (s - 14) * 384);
          const float* vp = (s < 14) ? (sv + (s + 2) * 384) : (svn + (s - 14) * 384);
          if (s & 1) { Pr1 = *(const float4*)(sp + 0 * 64); Pw1 = *(const float4*)(sp + 1 * 64); Pk1 = *(const float4*)(sp + 2 * 64); Pa1 = *(const float4*)(sp + 4 * 64); Pb1 = *(const float4*)(sp + 5 * 64); Pv1 = vp[0]; }
          else { Pr0 = *(const float4*)(sp + 0 * 64); Pw0 = *(const float4*)(sp + 1 * 64); Pk0 = *(const float4*)(sp + 2 * 64); Pa0 = *(const float4*)(sp + 4 * 64); Pb0 = *(const float4*)(sp + 5 * 64); Pv0 = vp[0]; }
        }
        const fv2 a01 = {ca.x, ca.y}, a23 = {ca.z, ca.w}, w01 = {cw.x, cw.y}, w23 = {cw.z, cw.w};
        const fv2 k01 = {ck.x, ck.y}, k23 = {ck.z, ck.w}, b01 = {cb.x, cb.y}, b23 = {cb.z, cb.w};
        const fv2 r01 = {cr.x, cr.y}, r23 = {cr.z, cr.w};
        const fv2 vv = {cv, cv};
        fv2 pa = S01 * a01; pa = __builtin_elementwise_fma(S23, a23, pa);
        float sa = pa.x + pa.y;
        const fv2 t01 = __builtin_elementwise_fma(S01, w01, vv * k01);
        const fv2 t23 = __builtin_elementwise_fma(S23, w23, vv * k23);
        if (s > 0) {
          sa = dpp_add(sa, 0); yp = dpp_add(yp, 0); sa = dpp_add(sa, 1); yp = dpp_add(yp, 1);
          sa = dpp_add(sa, 2); yp = dpp_add(yp, 2); sa = dpp_add(sa, 3); yp = dpp_add(yp, 3);
          ykeep = (kq == s - 1) ? yp : ykeep;
        } else {
          sa = row16_sum(sa);
        }
        const fv2 sav = {sa, sa};
        S01 = __builtin_elementwise_fma(sav, b01, t01);
        S23 = __builtin_elementwise_fma(sav, b23, t23);
        fv2 py = S01 * r01; py = __builtin_elementwise_fma(S23, r23, py);
        yp = py.x + py.y;
      }
      yp = row16_sum(yp);
      ykeep = (kq == 15) ? yp : ykeep;
      yr[((size_t)(b * 2048 + ch * 16 + kq)) * 256 + hd * 64 + 16 * rg + row] = f2bf(ykeep);
    } else {
      if (ch + 2 < 128) {
        int nb = cur + 2; if (nb >= 3) nb -= 3;
        float* dst = stage + nb * 16 * 384;
#pragma unroll
        for (int i = 0; i < 3; ++i) scan_put(g[i], st_ + 256 * i, dst);
      }
      if (ch + 3 < 128) {
        const bf16_t* src = pr + (size_t)(ch + 3) * 16 * 384;
#pragma unroll
        for (int i = 0; i < 3; ++i) g[i] = *(const uint4*)(src + (size_t)(st_ + 256 * i) * 8);
      }
    }
    __syncthreads();
    cur = (cur == 2) ? 0 : cur + 1;
  }
  __builtin_amdgcn_s_setprio(0);
  __syncthreads();
}

constexpr float SL2 = 0.125f * 1.4426950408889634f;

template <int MODE>
DI void attn_loop(const bf16_t* kb, long kstride, const bf16_t* vtb, long vstride, int jlo, int jhi,
                  const bf16x8 (&qf)[4], int qpos, unsigned sel, unsigned uni, int W, int qmin, int qmax,
                  f32x16 (&o)[2], float& m, float& l, bf16_t* Ks, bf16_t* Vs,
                  float* impw = nullptr, float* lastb = nullptr, float* mts = nullptr) {
  const int tid = tidx(), lane = tid & 63, h = lane >> 5, r31 = lane & 31;
  const int lr = tid >> 3, lc = (tid & 7) * 8;
  int j = jlo;
  if (MODE == 1) { while (j <= jhi && !((uni >> j) & 1)) ++j; }
  uint4 k0, v0;
  if (j <= jhi) {
    k0 = *(const uint4*)(kb + (long)(64 * j + lr) * kstride + lc);
    v0 = *(const uint4*)(vtb + (long)lr * vstride + 64 * j + lc);
  }
  while (j <= jhi) {
    __syncthreads();
    *(uint4*)(Ks + lr * LDT + lc) = k0;
    *(uint4*)(Vs + lr * LDT + lc) = v0;
    __syncthreads();
    int jn = j + 1;
    if (MODE == 1) { while (jn <= jhi && !((uni >> jn) & 1)) ++jn; }
    if (jn <= jhi) {
      k0 = *(const uint4*)(kb + (long)(64 * jn + lr) * kstride + lc);
      v0 = *(const uint4*)(vtb + (long)lr * vstride + 64 * jn + lc);
    }
    __builtin_amdgcn_sched_barrier(0);
    f32x16 s[2];
#pragma unroll
    for (int kt = 0; kt < 2; ++kt) {
#pragma unroll
      for (int e = 0; e < 16; ++e) s[kt][e] = 0.f;
#pragma unroll
      for (int si = 0; si < 4; ++si) {
        const bf16x8 fa = *(const bf16x8*)(Ks + (32 * kt + r31) * LDT + 16 * si + 8 * h);
        s[kt] = MFMA32(fa, qf[si], s[kt]);
      }
    }
    const bool selj = (MODE == 1) ? (((sel >> j) & 1) != 0) : true;
    const bool interior = (MODE == 1) ? (64 * j + 63 <= qmin) : (MODE == 2) ? ((64 * j + 63 <= qmin) && (qmax - 64 * j < W)) : false;
    float mx = -1e30f;
    if (interior) {
#pragma unroll
      for (int kt = 0; kt < 2; ++kt)
#pragma unroll
        for (int e = 0; e < 16; ++e) {
          const float v = (MODE == 1) ? (selj ? s[kt][e] * SL2 : -1e30f) : s[kt][e] * SL2;
          s[kt][e] = v; mx = fmaxf(mx, v);
        }
    } else {
#pragma unroll
      for (int kt = 0; kt < 2; ++kt)
#pragma unroll
        for (int e = 0; e < 16; ++e) {
          const int key = 64 * j + 32 * kt + crow(e, h);
          bool valid;
          if (MODE == 0) valid = (16 * key + 31 <= qpos);
          else if (MODE == 1) valid = selj && (key <= qpos);
          else valid = (key <= qpos) && (qpos - key < W);
          const float v = valid ? s[kt][e] * SL2 : -1e30f;
          s[kt][e] = v; mx = fmaxf(mx, v);
        }
    }
    mx = xor32_max(mx);
    const float mnew = fmaxf(m, mx);
    const float alpha = __builtin_amdgcn_exp2f(m - mnew);
    m = mnew; l *= alpha;
#pragma unroll
    for (int e = 0; e < 16; ++e) { o[0][e] *= alpha; o[1][e] *= alpha; }
    if (interior && (MODE == 2 || mnew > -1e29f)) {
#pragma unroll
      for (int kt = 0; kt < 2; ++kt)
#pragma unroll
        for (int e = 0; e < 16; ++e) {
          const float pv = __builtin_amdgcn_exp2f(s[kt][e] - mnew);
          l += pv; s[kt][e] = pv;
        }
    } else {
#pragma unroll
      for (int kt = 0; kt < 2; ++kt)
#pragma unroll
        for (int e = 0; e < 16; ++e) {
          const float pv = (s[kt][e] > -1e29f) ? __builtin_amdgcn_exp2f(s[kt][e] - mnew) : 0.f;
          l += pv; s[kt][e] = pv;
        }
    }
    if (MODE == 0) {
      if (impw != nullptr) {
#pragma unroll
        for (int kt = 0; kt < 2; ++kt)
#pragma unroll
          for (int q = 0; q < 4; ++q) {
            impw[16 * j + 8 * kt + 2 * q + h] = (s[kt][4 * q] + s[kt][4 * q + 1]) + (s[kt][4 * q + 2] + s[kt][4 * q + 3]);
            lastb[(j * 8 + kt * 4 + q) * 512 + tid] = s[kt][4 * q + 3];
          }
        mts[j * 512 + tid] = mnew;
      }
    }
#pragma unroll
    for (int kt = 0; kt < 2; ++kt)
#pragma unroll
      for (int sp = 0; sp < 2; ++sp) {
        const bf16x8 fb = __builtin_bit_cast(bf16x8, make_uint4(pack2(s[kt][8 * sp + 0], s[kt][8 * sp + 1]), pack2(s[kt][8 * sp + 2], s[kt][8 * sp + 3]),
                                                               pack2(s[kt][8 * sp + 4], s[kt][8 * sp + 5]), pack2(s[kt][8 * sp + 6], s[kt][8 * sp + 7])));
#pragma unroll
        for (int dt = 0; dt < 2; ++dt) {
          const bf16_t* vr = Vs + (32 * dt + r31) * LDT + 32 * kt + 16 * sp + 4 * h;
          const uint2 lo = *(const uint2*)vr; const uint2 hi = *(const uint2*)(vr + 8);
          const bf16x8 fa = __builtin_bit_cast(bf16x8, make_uint4(lo.x, lo.y, hi.x, hi.y));
          o[dt] = MFMA32(fa, fb, o[dt]);
        }
      }
    j = jn;
  }
}

DI void zero_o(f32x16 (&o)[2]) {
#pragma unroll
  for (int e = 0; e < 16; ++e) { o[0][e] = 0.f; o[1][e] = 0.f; }
}

DI void nsa_item(const Params& p, int l_, int item, char* smraw, bool wr = true) {
  const int qb = 31 - (item >> 4), bg = item & 15, b = bg >> 1, g = bg & 1;
  bf16_t* Ks = (bf16_t*)smraw; bf16_t* Vs = Ks + 64 * LDT;
  float* imp = (float*)(smraw + 18432);
  float* scs = (float*)(smraw + 18432 + 33792);
  unsigned* selm = (unsigned*)(smraw + 18432 + 33792 + 8448);
  const bf16_t* hb = (const bf16_t*)(WS(p) + O_H);
  bf16_t* hw = (bf16_t*)(WS(p) + O_H);
  const bf16_t* vt = (const bf16_t*)(WS(p) + O_VT);
  const int tid = tidx(), lane = tid & 63, w = (tid >> 6) & 3, qh = tid >> 8, h = lane >> 5, r31 = lane & 31;
  const int H = g * 4 + w;
  const int qpos = 64 * qb + 32 * qh + r31;
  const size_t mrow = (size_t)b * 2048 + qpos;
  const int cur = qb;
  bf16x8 qf[4];
#pragma unroll
  for (int s = 0; s < 4; ++s) qf[s] = *(const bf16x8*)(hb + mrow * HS + C_AQ + H * 64 + 16 * s + 8 * h);
  const float g0 = sigmoidf_(bf2f(hb[mrow * HS + C_GATE + 0 * 8 + H]));
  const float g1 = sigmoidf_(bf2f(hb[mrow * HS + C_GATE + 1 * 8 + H]));
  const float g2 = sigmoidf_(bf2f(hb[mrow * HS + C_GATE + 2 * 8 + H]));
  f32x16 ot[2], o[2];
  float m, l;
  zero_o(o); m = -1e30f; l = 0.f;
  const int lo_ = 64 * qb - 511;
  const int jlo = (lo_ <= 0) ? 0 : (lo_ >> 6);
  attn_loop<2>(hb + (size_t)b * 2048 * HS + C_KW + g * 64, HS, vt + ((size_t)((1 * 8 + b) * 128 + g * 64)) * 2048, 2048, jlo, cur, qf, qpos, 0u, 0u, 512, 64 * qb, 64 * qb + 63, o, m, l, Ks, Vs);
  float lt = xor32_sum(l);
  float inv = (lt > 0.f) ? 1.f / lt : 0.f;
#pragma unroll
  for (int e = 0; e < 16; ++e) { ot[0][e] = g2 * inv * o[0][e]; ot[1][e] = g2 * inv * o[1][e]; }
  {
    int* seen = (int*)(smraw + DYN_XB + 20);
    if (*seen == 0) {
      if (tid == 0) {
        const int* cd = (const int*)(WS(p) + O_CNT) + 4 + l_;
        unsigned spins = 0;
        while (__hip_atomic_load(cd, __ATOMIC_RELAXED, __HIP_MEMORY_SCOPE_AGENT) < 32 && ++spins < (1u << 22)) __builtin_amdgcn_s_sleep(2);
      }
      __syncthreads();
      __builtin_amdgcn_fence(__ATOMIC_ACQUIRE, "agent");
      if (tid == 0) *seen = 1;
      __syncthreads();
    }
  }
  const bf16_t* kcb = (const bf16_t*)(WS(p) + O_KC) + (size_t)bg * 128 * 64;
  const bf16_t* vcb = (const bf16_t*)(WS(p) + O_VCT) + (size_t)bg * 64 * 128;
  const int ntile = (4 * qb + 3 + 63) >> 6;
  zero_o(o); m = -1e30f; l = 0.f;
  float* impw = imp + (w * 64 + 32 * qh + r31) * 33;
  float* lastb = (float*)(smraw + 61440);
  float* mts = (float*)(smraw + 61440 + 32768);
  if (cur >= 16) attn_loop<0>(kcb, 64, vcb, 128, 0, ntile - 1, qf, qpos, 0u, 0u, 0, 64 * qb, 64 * qb + 63, o, m, l, Ks, Vs, impw, lastb, mts);
  else attn_loop<0>(kcb, 64, vcb, 128, 0, ntile - 1, qf, qpos, 0u, 0u, 0, 64 * qb, 64 * qb + 63, o, m, l, Ks, Vs);
  lt = xor32_sum(l);
  inv = (lt > 0.f) ? 1.f / lt : 0.f;
#pragma unroll
  for (int e = 0; e < 16; ++e) { ot[0][e] += g0 * inv * o[0][e]; ot[1][e] += g0 * inv * o[1][e]; }
  unsigned sel, uni;
  if (cur < 16) {
    sel = (1u << (cur + 1)) - 1u; uni = sel;
  } else {
    {
      const float f0 = __builtin_amdgcn_exp2f(mts[tid] - m) * inv, f1 = __builtin_amdgcn_exp2f(mts[512 + tid] - m) * inv;
#pragma unroll
      for (int jt = 0; jt < 2; ++jt)
#pragma unroll
        for (int kt = 0; kt < 2; ++kt)
#pragma unroll
          for (int q = 0; q < 4; ++q) impw[16 * jt + 8 * kt + 2 * q + h] *= (jt ? f1 : f0);
      __syncthreads();
#pragma unroll
      for (int jt = 0; jt < 2; ++jt)
#pragma unroll
        for (int kt = 0; kt < 2; ++kt)
#pragma unroll
          for (int q = 0; q < 4; ++q) {
            const int j1 = 16 * jt + 8 * kt + 2 * q + h + 1;
            if (j1 < 32) impw[j1] += lastb[(jt * 8 + kt * 4 + q) * 512 + tid] * (jt ? f1 : f0);
          }
      __syncthreads();
    }
    {
      const int ql = tid >> 3, jj = tid & 7;
#pragma unroll
      for (int e = 0; e < 4; ++e) {
        const int j = jj * 4 + e;
        float sc;
        if (j == 0 || j == cur || j == cur - 1) sc = 1e9f;
        else if (j <= cur) sc = ((imp[(0 * 64 + ql) * 33 + j] + imp[(1 * 64 + ql) * 33 + j]) + imp[(2 * 64 + ql) * 33 + j]) + imp[(3 * 64 + ql) * 33 + j];
        else sc = -1e9f;
        scs[ql * 33 + j] = sc;
      }
      if (tid < 65) selm[tid] = 0u;
    }
    __syncthreads();
    {
      const int ql = tid >> 3, jj = tid & 7;
      unsigned bits = 0u;
#pragma unroll
      for (int e = 0; e < 4; ++e) {
        const int j = jj * 4 + e;
        const float my = scs[ql * 33 + j];
        int rank = 0;
        for (int j2 = 0; j2 < 32; ++j2) {
          const float o2 = scs[ql * 33 + j2];
          rank += (o2 > my || (o2 == my && j2 < j)) ? 1 : 0;
        }
        if (rank < 16) bits |= (1u << j);
      }
      atomicOr(&selm[ql], bits);
      atomicOr(&selm[64], bits);
    }
    __syncthreads();
    sel = selm[32 * qh + r31]; uni = selm[64];
  }
  zero_o(o); m = -1e30f; l = 0.f;
  attn_loop<1>(hb + (size_t)b * 2048 * HS + C_KS + g * 64, HS, vt + ((size_t)((0 * 8 + b) * 128 + g * 64)) * 2048, 2048, 0, cur, qf, qpos, sel, uni, 0, 64 * qb, 64 * qb + 63, o, m, l, Ks, Vs);
  lt = xor32_sum(l);
  inv = (lt > 0.f) ? 1.f / lt : 0.f;
#pragma unroll
  for (int e = 0; e < 16; ++e) { ot[0][e] += g1 * inv * o[0][e]; ot[1][e] += g1 * inv * o[1][e]; }
#pragma unroll
  for (int dt = 0; dt < 2; ++dt)
#pragma unroll
    for (int q = 0; q < 4; ++q) {
      const int d = 32 * dt + 8 * q + 4 * h;
      bf16_t* zp = hw + mrow * HS + C_AZ + H * 64 + d;
      const uint2 z = *(const uint2*)zp;
      uint2 ov;
      ov.x = pack2(ot[dt][4 * q] * siluf_(bflo(z.x)), ot[dt][4 * q + 1] * siluf_(bfhi(z.x)));
      ov.y = pack2(ot[dt][4 * q + 2] * siluf_(bflo(z.y)), ot[dt][4 * q + 3] * siluf_(bfhi(z.y)));
      if (wr) *(uint2*)zp = ov;
    }
  __syncthreads();
}

DI void swa_item(const Params& p, int l_, int item, char* smraw, bool wr = true) {
  const int qb = 15 - (item >> 4), bg = item & 15, b = bg >> 1, g = bg & 1;
  bf16_t* Ks = (bf16_t*)smraw; bf16_t* Vs = Ks + 64 * LDT;
  const bf16_t* hb = (const bf16_t*)(WS(p) + O_H);
  bf16_t* hw = (bf16_t*)(WS(p) + O_H);
  const bf16_t* vt = (const bf16_t*)(WS(p) + O_VT);
  const int tid = tidx(), lane = tid & 63, w = tid >> 6, h = lane >> 5, r31 = lane & 31;
  const int H = g * 2 + (w & 1);
  const int qpos = 128 * qb + 32 * (w >> 1) + r31;
  const size_t mrow = (size_t)b * 2048 + qpos;
  bf16x8 qf[4];
#pragma unroll
  for (int s = 0; s < 4; ++s) qf[s] = *(const bf16x8*)(hb + mrow * HS + C_BQ + H * 64 + 16 * s + 8 * h);
  const float sink = IN(10)[l_ * 4 + H] * 1.4426950408889634f;
  f32x16 o[2];
  zero_o(o);
  float m = sink, l = (h == 0) ? 1.f : 0.f;
  const int jlo = (qb >= 1) ? 2 * qb - 2 : 0;
  attn_loop<2>(hb + (size_t)b * 2048 * HS + C_BK + g * 64, HS, vt + ((size_t)((2 * 8 + b) * 128 + g * 64)) * 2048, 2048, jlo, 2 * qb + 1, qf, qpos, 0u, 0u, 128, 128 * qb, 128 * qb + 127, o, m, l, Ks, Vs);
  const float lt = xor32_sum(l);
  const float inv = (lt > 0.f) ? 1.f / lt : 0.f;
#pragma unroll
  for (int dt = 0; dt < 2; ++dt)
#pragma unroll
    for (int q = 0; q < 4; ++q) {
      const int d = 32 * dt + 8 * q + 4 * h;
      bf16_t* zp = hw + mrow * HS + C_BZ + H * 64 + d;
      const uint2 z = *(const uint2*)zp;
      uint2 ov;
      ov.x = pack2(inv * o[dt][4 * q] * siluf_(bflo(z.x)), inv * o[dt][4 * q + 1] * siluf_(bfhi(z.x)));
      ov.y = pack2(inv * o[dt][4 * q + 2] * siluf_(bflo(z.y)), inv * o[dt][4 * q + 3] * siluf_(bfhi(z.y)));
      if (wr) *(uint2*)zp = ov;
    }
  __syncthreads();
}

DI void rwkv_post(const Params& p, int l) {
  const int lane = tidx() & 63, hd = (tidx() >> 6) & 3, sub = tidx() >> 8;
  const bf16_t* yr = (const bf16_t*)(WS(p) + O_YR);
  const bf16_t* pr = (const bf16_t*)(WS(p) + O_PR);
  const float* bon = (const float*)(WS(p) + O_BON);
  bf16_t* hw = (bf16_t*)(WS(p) + O_H);
  const float lw = IN(19)[l * 256 + hd * 64 + lane], lb = IN(20)[l * 256 + hd * 64 + lane];
  for (int it = bidx(); it < NTOK / 16; it += gridDim.x) {
    float y[8], v[8], z[8], bo[8];
#pragma unroll
    for (int q = 0; q < 8; ++q) {
      const size_t m = (size_t)it * 16 + sub * 8 + q;
      const int b = (int)(m >> 11), t = (int)(m & 2047);
      y[q] = bf2f(yr[m * 256 + hd * 64 + lane]);
      v[q] = bf2f(pr[((size_t)((b * 4 + hd) * 2048 + t)) * 384 + 3 * 64 + lane]);
      z[q] = bf2f(hw[m * HS + C_CZ + hd * 64 + lane]);
      bo[q] = bon[m * 4 + hd];
    }
#pragma unroll
    for (int q = 0; q < 8; ++q) {
      const size_t m = (size_t)it * 16 + sub * 8 + q;
      const float mean = wave_sum_fast(y[q]) * (1.f / 64.f);
      const float dlt = y[q] - mean;
      const float var = wave_sum_fast(dlt * dlt) * (1.f / 64.f);
      float o = dlt * rsqrtf(var + 64e-5f) * lw + lb + bo[q] * v[q];
      o *= siluf_(z[q]);
      hw[m * HS + C_CZ + hd * 64 + lane] = f2bf(o);
    }
  }
}

struct EpiP {
  static constexpr bool PERM = true, AFTER_DRAIN = false;
  char* scr;
  DI void operator()(const f32x4 (&acc)[2][2][4][2], const Unit&, int, int, int, int) const {
    char* sb = scr; asm volatile("" : "+s"(sb));
    const unsigned toff = (unsigned)tidx() * 16u;
#pragma unroll
    for (int ai = 0; ai < 2; ++ai)
#pragma unroll
      for (int m = 0; m < 4; ++m)
#pragma unroll
        for (int bj = 0; bj < 2; ++bj) *(u32x4*)(sb + (size_t)(((ai * 4 + m) * 2 + bj) * 8192) + toff) = pack8(acc[ai][bj][m][0], acc[ai][bj][m][1]);
  }
};
struct EpiMix {
  static constexpr bool PERM = true, AFTER_DRAIN = false;
  const char* scr; bf16_t* mixed; const float* bias; int first;
  DI void operator()(const f32x4 (&acc)[2][2][4][2], const Unit& u, int wr, int wc, int fr, int fq) const {
    const int row0 = u.pm * BM + wr * 64 + fr, col0 = u.pn * BM + wc * 32 + 8 * fq;
    const char* sb = scr; asm volatile("" : "+s"(sb));
    const unsigned toff = (unsigned)tidx() * 16u;
#pragma unroll
    for (int ai = 0; ai < 2; ++ai)
#pragma unroll
      for (int mp = 0; mp < 2; ++mp) {
        u32x4 pv[2][2], ov[2][2];
        f32x4 bv[2][2];
#pragma unroll
        for (int bj = 0; bj < 2; ++bj)
#pragma unroll
          for (int n = 0; n < 2; ++n) bv[bj][n] = *(const f32x4*)(bias + col0 + bj * HALF + 4 * n);
#pragma unroll
        for (int mm = 0; mm < 2; ++mm)
#pragma unroll
          for (int bj = 0; bj < 2; ++bj) {
            const int m = mp * 2 + mm;
            pv[mm][bj] = *(const u32x4*)(sb + (size_t)(((ai * 4 + m) * 2 + bj) * 8192) + toff);
            ov[mm][bj] = (u32x4){0u, 0u, 0u, 0u};
            if (!first) ov[mm][bj] = *(const u32x4*)(mixed + (size_t)(row0 + ai * HALF + m * 16) * 1024 + col0 + bj * HALF);
          }
#pragma unroll
        for (int mm = 0; mm < 2; ++mm)
#pragma unroll
          for (int bj = 0; bj < 2; ++bj) {
            const int m = mp * 2 + mm;
            const f32x4 g0 = acc[ai][bj][m][0] + bv[bj][0], g1 = acc[ai][bj][m][1] + bv[bj][1];
            const u32x4 p_ = pv[mm][bj], o_ = ov[mm][bj];
            u32x4 w;
            w.x = pack2(bflo(o_.x) + sigmoidf_(g0[0]) * bflo(p_.x), bfhi(o_.x) + sigmoidf_(g0[1]) * bfhi(p_.x));
            w.y = pack2(bflo(o_.y) + sigmoidf_(g0[2]) * bflo(p_.y), bfhi(o_.y) + sigmoidf_(g0[3]) * bfhi(p_.y));
            w.z = pack2(bflo(o_.z) + sigmoidf_(g1[0]) * bflo(p_.z), bfhi(o_.z) + sigmoidf_(g1[1]) * bfhi(p_.z));
            w.w = pack2(bflo(o_.w) + sigmoidf_(g1[2]) * bflo(p_.w), bfhi(o_.w) + sigmoidf_(g1[3]) * bfhi(p_.w));
            *(u32x4*)(mixed + (size_t)(row0 + ai * HALF + m * 16) * 1024 + col0 + bj * HALF) = w;
          }
      }
  }
};
struct Sub5 { const char* A; const char* B; int nt; int isP; };
DI Sub5 p5_sub(int i, const Unit& u, const bf16_t* hb, const bf16_t* xn, const bf16_t* wtm, const bf16_t* wtp) {
  const int br = i >> 1;
  Sub5 s;
  if (!(i & 1)) {
    const int zc = (br == 0) ? C_AZ : (br == 1) ? C_BZ : C_CZ;
    const int kof = (br == 0) ? 0 : (br == 1) ? 512 : 768;
    s.A = (const char*)(hb + zc + (size_t)u.pm * BM * HS);
    s.B = (const char*)(wtp + kof + (size_t)u.pn * BM * 1024);
    s.nt = (br == 0) ? 8 : 4; s.isP = 1;
  } else {
    s.A = (const char*)(xn + (size_t)u.pm * BM * 1024);
    s.B = (const char*)(wtm + ((size_t)br * 1024 + (size_t)u.pn * BM) * 1024);
    s.nt = 16; s.isP = 0;
  }
  return s;
}
DI void gemm_phase_p5(LAS unsigned char* lds, const Unit u, const bf16_t* hb, const bf16_t* xn, const bf16_t* wtm, const bf16_t* wtp,
                      char* scr, bf16_t* mixed, const float* bmerge) {
    const int tid = tidx(), wid = __builtin_amdgcn_readfirstlane(tid >> 6), lane = tid & 63, wr = wid >> 2, wc = wid & 3, fr = lane & 15, fq = lane >> 4;
    unsigned rowA, col2;
    { int R, C; stage_rc(tid * 16, R, C); rowA = (unsigned)R; col2 = (unsigned)C * 2u; }
#define PG8_ROWB ((rowA & ~31u) + (unsigned)perm32((int)(rowA & 31u)))
    const unsigned ldX = 1024u * 2u, ldH = (unsigned)HS * 2u;
    const size_t kstep = (size_t)(BK * 2);
    const size_t hstepB = (size_t)HALF * 1024 * 2, hsX = (size_t)HALF * 1024 * 2, hsH = (size_t)HALF * HS * 2;
    const unsigned ldsw = (unsigned)wid * 1024u;
    const int aoff = lds_byte(wr * 64 + fr, fq * 8), boff = lds_byte(wc * 32 + fr, fq * 8);
#define PG8_SA(b, h) (((b) * 2 + (h)) * HTB)
#define PG8_SB(b, h) ((4 + (b) * 2 + (h)) * HTB)
#define PG8_STAGE2(bufoff, gbase, row_, ld_) do { const unsigned v0__ = (row_) * (ld_) + col2;         __builtin_amdgcn_global_load_lds((const unsigned*)((const char*)(gbase) + v0__), (LAS unsigned*)(lds + (bufoff) + ldsw), 16, 0, 0);         __builtin_amdgcn_global_load_lds((const unsigned*)((const char*)(gbase) + (size_t)(64u * (ld_)) + v0__), (LAS unsigned*)(lds + (bufoff) + ldsw + 8192), 16, 0, 0); } while (0)
#define PG8_LDA(dst, b, h) do { _Pragma("unroll") for (int m = 0; m < 4; ++m) _Pragma("unroll") for (int k = 0; k < 2; ++k) dst[m][k] = *(const LAS bf16x8*)(lds + PG8_SA(b, h) + aoff + m * 2048 + k * 1024); } while (0)
#define PG8_LDB(dst, b, h) do { _Pragma("unroll") for (int n = 0; n < 2; ++n) _Pragma("unroll") for (int k = 0; k < 2; ++k) dst[n][k] = *(const LAS bf16x8*)(lds + PG8_SB(b, h) + boff + n * 2048 + k * 1024); } while (0)
#define PG8_MMA(ai, bj, At, Bt) do { __builtin_amdgcn_s_setprio(1); _Pragma("unroll") for (int m = 0; m < 4; ++m) _Pragma("unroll") for (int n = 0; n < 2; ++n) _Pragma("unroll") for (int k = 0; k < 2; ++k)         acc[ai][bj][m][n] = __builtin_amdgcn_mfma_f32_16x16x32_bf16(Bt[n][k], At[m][k], acc[ai][bj][m][n], 0, 0, 0); __builtin_amdgcn_s_setprio(0); } while (0)
#define PG8_WAIT_V(n) asm volatile("s_waitcnt vmcnt(" #n ")" ::: "memory")
#define PG8_WAIT_L(n) asm volatile("s_waitcnt lgkmcnt(" #n ")" ::: "memory")
#define PG8_BAR __builtin_amdgcn_s_barrier()
#define PG8_SCHED __builtin_amdgcn_sched_barrier(0)
    Sub5 cur = p5_sub(0, u, hb, xn, wtm, wtp), nxt;
    f32x4 acc[2][2][4][2];
#pragma unroll
    for (int a = 0; a < 2; ++a)
#pragma unroll
        for (int b = 0; b < 2; ++b)
#pragma unroll
            for (int m = 0; m < 4; ++m)
#pragma unroll
                for (int n = 0; n < 2; ++n) acc[a][b][m][n] = (f32x4){0.f, 0.f, 0.f, 0.f};
    bf16x8 At[4][2], B0[2][2], B1[2][2];
    unsigned ldc = cur.isP ? ldH : ldX;
    size_t hsc = cur.isP ? hsH : hsX;
    PG8_STAGE2(PG8_SB(0, 0), cur.B, PG8_ROWB, ldX); PG8_STAGE2(PG8_SA(0, 0), cur.A, rowA, ldc);
    PG8_STAGE2(PG8_SB(0, 1), cur.B + hstepB, PG8_ROWB, ldX); PG8_STAGE2(PG8_SA(0, 1), cur.A + hsc, rowA, ldc);
    if (wr == 1) PG8_BAR;
    PG8_WAIT_V(4); PG8_BAR;
    PG8_STAGE2(PG8_SB(1, 0), cur.B + kstep, PG8_ROWB, ldX); PG8_STAGE2(PG8_SA(1, 0), cur.A + kstep, rowA, ldc);
    PG8_STAGE2(PG8_SB(1, 1), cur.B + hstepB + kstep, PG8_ROWB, ldX);
    PG8_WAIT_V(6); PG8_BAR;
#pragma unroll 1
    for (int ui = 0;; ++ui) {
        const bool has_next = ui < 5;
        nxt = has_next ? p5_sub(ui + 1, u, hb, xn, wtm, wtp) : cur;
        const unsigned ldn = nxt.isP ? ldH : ldX;
        const size_t hsn = nxt.isP ? hsH : hsX;
        const int nt = cur.nt;
#pragma unroll 1
        for (int t = 0; t < nt; t += 2) {
            const bool last = (t == nt - 2);
            const char* a1 = cur.A + (size_t)(t + 1) * kstep;
            const char* a2 = last ? nxt.A : cur.A + (size_t)(t + 2) * kstep; const char* b2 = last ? nxt.B : cur.B + (size_t)(t + 2) * kstep;
            const unsigned ld2 = last ? ldn : ldc; const size_t hs2 = last ? hsn : hsc;
            const char* a3 = a2 + kstep; const char* b3 = b2 + kstep;
            PG8_LDB(B0, 0, 0); PG8_SCHED; PG8_LDA(At, 0, 0); PG8_STAGE2(PG8_SA(1, 1), a1 + hsc, rowA, ldc);
            PG8_WAIT_L(8); PG8_BAR; PG8_WAIT_L(0); PG8_MMA(0, 0, At, B0); PG8_BAR; PG8_SCHED;
            PG8_LDB(B1, 0, 1); PG8_STAGE2(PG8_SB(0, 0), b2, PG8_ROWB, ldX);
            PG8_BAR; PG8_WAIT_L(0); PG8_MMA(0, 1, At, B1); PG8_BAR;
            PG8_LDA(At, 0, 1); PG8_STAGE2(PG8_SA(0, 0), a2, rowA, ld2);
            PG8_BAR; PG8_WAIT_L(0); PG8_MMA(1, 0, At, B0); PG8_BAR; PG8_SCHED;
            PG8_STAGE2(PG8_SB(0, 1), b2 + hstepB, PG8_ROWB, ldX);
            PG8_WAIT_V(6); PG8_BAR; PG8_MMA(1, 1, At, B1); PG8_BAR;
            PG8_LDB(B0, 1, 0); PG8_SCHED; PG8_LDA(At, 1, 0); PG8_STAGE2(PG8_SA(0, 1), a2 + hs2, rowA, ld2);
            PG8_WAIT_L(8); PG8_BAR; PG8_WAIT_L(0); PG8_MMA(0, 0, At, B0); PG8_BAR; PG8_SCHED;
            PG8_LDB(B1, 1, 1); PG8_STAGE2(PG8_SB(1, 0), b3, PG8_ROWB, ldX);
            PG8_BAR; PG8_WAIT_L(0); PG8_MMA(0, 1, At, B1); PG8_BAR;
            PG8_LDA(At, 1, 1); PG8_STAGE2(PG8_SA(1, 0), a3, rowA, ld2);
            PG8_BAR; PG8_WAIT_L(0); PG8_MMA(1, 0, At, B0); PG8_BAR; PG8_SCHED;
            PG8_STAGE2(PG8_SB(1, 1), b3 + hstepB, PG8_ROWB, ldX);
            PG8_WAIT_V(6); PG8_BAR; PG8_MMA(1, 1, At, B1); PG8_BAR;
        }
        PG8_SCHED;
        {
          const int t2 = tidx(), fr2 = t2 & 15, fq2 = (t2 & 63) >> 4;
          if (cur.isP) { EpiP E{scr}; E(acc, u, wr, wc, fr2, fq2); }
          else { const int br = ui >> 1; EpiMix E{scr, mixed, bmerge + br * 1024, br == 0 ? 1 : 0}; E(acc, u, wr, wc, fr2, fq2); }
        }
        PG8_SCHED;
        if (!has_next) break;
#pragma unroll
        for (int a = 0; a < 2; ++a)
#pragma unroll
            for (int b = 0; b < 2; ++b)
#pragma unroll
                for (int m = 0; m < 4; ++m)
#pragma unroll
                    for (int n = 0; n < 2; ++n) acc[a][b][m][n] = (f32x4){0.f, 0.f, 0.f, 0.f};
        cur = nxt; ldc = ldn; hsc = hsn;
    }
    PG8_WAIT_V(0);
    if (wr == 0) PG8_BAR;
    PG8_BAR;
#undef PG8_SA
#undef PG8_SB
#undef PG8_STAGE2
#undef PG8_ROWB
#undef PG8_LDA
#undef PG8_LDB
#undef PG8_MMA
#undef PG8_WAIT_V
#undef PG8_WAIT_L
#undef PG8_BAR
#undef PG8_SCHED
}
DI void phase5(const Params& p, int l, char* smraw) {
  const bf16_t* xn = (const bf16_t*)(WS(p) + O_XN);
  const bf16_t* hb = (const bf16_t*)(WS(p) + O_H);
  const bf16_t* wtm = (const bf16_t*)(WS(p) + O_WTM);
  const bf16_t* wtp = (const bf16_t*)(WS(p) + O_WTP);
  bf16_t* mixed = (bf16_t*)(WS(p) + O_PR);
  const int blk = bidx();
  char* sbase = (blk < 128) ? (WS(p) + O_PR + (size_t)NTOK * 1024 * 2 + (size_t)blk * 131072)
              : (blk < 224) ? (WS(p) + O_VT + (size_t)(blk - 128) * 131072)
                            : (WS(p) + O_YR + (size_t)(blk - 224) * 131072);
  char* scr = sbase;
  StaticOrder S; S.init(NTOK, 1024, gridDim.x, bidx());
  Unit u;
  for (int i = 0; S.next(i, u); ++i)
    gemm_phase_p5((LAS unsigned char*)smraw, u, hb, xn, wtm, wtp, scr, mixed, IN(3) + l * 3072);
}

struct EpiRes {
  static constexpr bool PERM = false, AFTER_DRAIN = false;
  const float* X; float* O;
  DI void operator()(const f32x4 (&acc)[2][2][4][2], const Unit& u, int wr, int wc, int fr, int fq) const {
    const int row0 = u.pm * BM + wr * 64 + fr, col0 = u.pn * BM + wc * 32 + 4 * fq;
#pragma unroll
    for (int ai = 0; ai < 2; ++ai)
#pragma unroll
      for (int mp = 0; mp < 2; ++mp) {
        f32x4 xv[2][2][2];
#pragma unroll
        for (int mm = 0; mm < 2; ++mm)
#pragma unroll
          for (int bj = 0; bj < 2; ++bj)
#pragma unroll
            for (int n = 0; n < 2; ++n)
              xv[mm][bj][n] = *(const f32x4*)(X + (size_t)(row0 + ai * HALF + (mp * 2 + mm) * 16) * 1024 + col0 + bj * HALF + n * 16);
#pragma unroll
        for (int mm = 0; mm < 2; ++mm)
#pragma unroll
          for (int bj = 0; bj < 2; ++bj)
#pragma unroll
            for (int n = 0; n < 2; ++n)
              *(f32x4*)(O + (size_t)(row0 + ai * HALF + (mp * 2 + mm) * 16) * 1024 + col0 + bj * HALF + n * 16) = xv[mm][bj][n] + acc[ai][bj][mp * 2 + mm][n];
      }
  }
};
DI void phase6(const Params& p, int l, char* smraw) {
  Gemm g{(const bf16_t*)(WS(p) + O_PR), (const bf16_t*)(WS(p) + O_WTO), 1024, 1024, 1024};
  StaticOrder S; S.init(NTOK, 1024, gridDim.x, bidx());
  EpiRes E{(l == 0) ? IN(0) : OUTP(), OUTP()};
  gemm_phase<EpiRes, StaticOrder>((LAS unsigned char*)smraw, g, S, E);
}

#define XB_TMO      128
#define XB_XCNT(j)  (256  + 64 * (j))
#define XB_XSUB(j)  (1280 + 64 * (j))
#define XB_XGEN(j)  (2304 + 64 * (j))
#define XB_TOP      3328
#define XB_TOPGEN   3392
#define XCD_BAR_WORDS 3456
#define XB_SPIN_CAP (1u << 18)

__device__ __forceinline__ unsigned xb_ld(unsigned* p)              { return __hip_atomic_load(p, __ATOMIC_RELAXED, __HIP_MEMORY_SCOPE_AGENT); }
__device__ __forceinline__ unsigned xb_add(unsigned* p, unsigned v) { return __hip_atomic_fetch_add(p, v, __ATOMIC_RELAXED, __HIP_MEMORY_SCOPE_AGENT); }
__device__ __forceinline__ unsigned xb_xcc_id() { return (unsigned)__builtin_amdgcn_s_getreg((3 << 11) | 20) & 0xFu; }
#define XB_SPIN(cond, bar) do { unsigned _sp = 0; while (cond) { __builtin_amdgcn_s_sleep(1); \
    if ((++_sp & 255u) == 0u) { if (xb_ld(&(bar)[XB_TMO])) break; if (_sp > XB_SPIN_CAP) { atomicAdd(&(bar)[XB_TMO], 1u); break; } } } } while (0)

struct XcdBarrier {
    unsigned* bar; unsigned x;
    volatile LAS unsigned* st;
};

__device__ __forceinline__ XcdBarrier xcd_barrier_post(unsigned* bar, volatile LAS unsigned* st) {
    XcdBarrier b; b.bar = bar; b.x = xb_xcc_id(); b.st = st;
    if (tidx() == 0) (void)xb_add(&bar[XB_XCNT(b.x)], 1u);
    return b;
}
__device__ __forceinline__ void xcd_barrier_complete(unsigned* bar, unsigned x, unsigned& nloc, unsigned& nx) {
    const unsigned G = gridDim.x * gridDim.y * gridDim.z;
    unsigned sum, cnt, mine, sp = 0u;
    for (;;) {
        sum = 0u; cnt = 0u; mine = 0u;
#pragma unroll
        for (unsigned j = 0; j < 16; ++j) { const unsigned c = xb_ld(&bar[XB_XCNT(j)]); sum += c; cnt += (c > 0u) ? 1u : 0u; mine = (j == x) ? c : mine; }
        if (sum == G) break;
        __builtin_amdgcn_s_sleep(1);
        if ((++sp & 255u) == 0u) { if (xb_ld(&bar[XB_TMO])) break; if (sp > XB_SPIN_CAP) { atomicAdd(&bar[XB_TMO], 1u); break; } }
    }
    nloc = mine > 0u ? mine : 1u; nx = cnt > 0u ? cnt : 1u;
}

__device__ __forceinline__ void xcd_barrier(const XcdBarrier& b) {
    asm volatile("s_waitcnt vmcnt(0)" ::: "memory");
    __syncthreads();
    if (tidx() == 0) {
        unsigned* bar = b.bar; asm volatile("" : "+s"(bar));
        __builtin_amdgcn_s_waitcnt(0);
        unsigned nloc = b.st[0], nx = b.st[1];
        if (nloc == 0u) { xcd_barrier_complete(bar, b.x, nloc, nx); b.st[0] = nloc; b.st[1] = nx; }
        const unsigned old = xb_add(&bar[XB_XSUB(b.x)], 1u);
        const unsigned gen = old / nloc;
        if (old + 1u == (gen + 1u) * nloc) {
            __builtin_amdgcn_fence(__ATOMIC_RELEASE, "agent");
            asm volatile("s_waitcnt vmcnt(0)" ::: "memory");
            const unsigned og = xb_add(&bar[XB_TOP], 1u);
            const unsigned tg = og / nx;
            if (og + 1u == (tg + 1u) * nx) xb_add(&bar[XB_TOPGEN], 1u);
            else XB_SPIN(xb_ld(&bar[XB_TOPGEN]) == tg, bar);
            __builtin_amdgcn_fence(__ATOMIC_ACQUIRE, "agent");
            xb_add(&bar[XB_XGEN(b.x)], 1u);
            asm volatile("s_waitcnt vmcnt(0)" ::: "memory");
        } else {
            XB_SPIN(xb_ld(&bar[XB_XGEN(b.x)]) == gen, bar);
            __builtin_amdgcn_fence(__ATOMIC_ACQUIRE, "agent");
            asm volatile("s_waitcnt vmcnt(0)" ::: "memory");
        }
    }
    __syncthreads();
}


__global__ void __launch_bounds__(512, 2) fwd_megakernel(Params p) {
  cg::grid_group grid = cg::this_grid();
  extern __shared__ __attribute__((aligned(16))) char smraw[];
  uint4* xb_words = (uint4*)(smraw + DYN_XB);
  int* s_item = (int*)(smraw + DYN_XB + 16);
  if (tidx() == 0) *xb_words = make_uint4(0u, 0u, 0u, 0u);
  __syncthreads();
  XcdBarrier xb = xcd_barrier_post((unsigned*)(WS(p) + O_BAR), (volatile LAS unsigned*)xb_words);
  if (WS(p) == nullptr) grid.sync();
  unsigned long long tacc = 0ull, t0 = 0ull;
#define TB(k) do { if (PROBE_T == (k)) t0 = __builtin_amdgcn_s_memrealtime(); } while (0)
#define TE(k) do { if (PROBE_T == (k)) tacc += __builtin_amdgcn_s_memrealtime() - t0; } while (0)
  for (int l = 0; l < 2; ++l) {
    TB(10);
    phase0(p, l, smraw);
    xcd_barrier(xb);
    TE(10); TB(11);
    phase1(p, smraw);
    xcd_barrier(xb);
    TE(11); TB(12);
    for (int it = bidx(); it < 256; it += gridDim.x) rwkv_prep(p, l, it, smraw);
    xcd_barrier(xb);
    TE(12); TB(13); TB(18);
    {
      int* cnt = (int*)(WS(p) + O_CNT) + l;
      if (tidx() == 0) *(int*)(smraw + DYN_XB + 20) = 0;
      __syncthreads();
      for (int it = bidx(); it < 128; it += gridDim.x) rwkv_scan(p, it, smraw);
      TE(18);
      while (true) {
        if (tidx() == 0) *s_item = atomicAdd(cnt, 1);
        __syncthreads();
        const int item = *s_item;
        __syncthreads();
        if (item >= 32 + 512 + 256) break;
        if (item < 32) compress_tile2(p, l, item, smraw);
        else if (item < 32 + 256) swa_item(p, l, item - 32, smraw);
        else nsa_item(p, l, item - 32 - 256, smraw);
      }
      TB(19);
    }
    xcd_barrier(xb);
    TE(13); TE(19); TB(14);
    rwkv_post(p, l);
    xcd_barrier(xb);
    TE(14); TB(15);
    phase5(p, l, smraw);
    xcd_barrier(xb);
    TE(15); TB(16);
    phase6(p, l, smraw);
    xcd_barrier(xb);
    TE(16);
  }
  TB(17);
  rmsnorm_rows(OUTP(), IN(28), nullptr, OUTP());
  TE(17);
  if (PROBE_T && bidx() == 0) {
    asm volatile("s_waitcnt vmcnt(0)" ::: "memory");
    __syncthreads();
    if (tidx() == 0) atomicAdd(OUTP(), 0.04f + (float)tacc * 0.01f * PROBE_TSCALE);
  }
}

extern "C" void kernel_launch(void* const* d_in, const int* in_sizes, int n_in, void* d_out, int out_size, void* d_ws,
                              size_t ws_size, hipStream_t stream) {
  static int grid_blocks = 0;
  if (!grid_blocks) {
    int dev = 0, cus = 0, per_cu = 0;
    (void)hipGetDevice(&dev);
    (void)hipDeviceGetAttribute(&cus, hipDeviceAttributeMultiprocessorCount, dev);
    if (hipFuncSetAttribute((const void*)fwd_megakernel, hipFuncAttributeMaxDynamicSharedMemorySize, DYN_LDS) != hipSuccess) {
      fprintf(stderr, "hipFuncSetAttribute failed\n"); grid_blocks = -1;
    } else {
      (void)hipOccupancyMaxActiveBlocksPerMultiprocessor(&per_cu, (const void*)fwd_megakernel, 512, DYN_LDS);
      if (per_cu > 1) per_cu = 1;
      grid_blocks = (cus * per_cu) & ~7;
      if (grid_blocks > 256) grid_blocks = 256;
    }
  }
  if (ws_size < WS_TOTAL || grid_blocks < 8) {
    fprintf(stderr, "workspace too small or grid too small: %zu < %zu, grid %d\n", ws_size, (size_t)WS_TOTAL, grid_blocks);
    return;
  }
  Params p{};
  for (int i = 0; i < 29; ++i) p.in[i] = (const float*)d_in[i];
  p.out = (float*)d_out;
  p.ws = (char*)d_ws;
  (void)hipMemsetAsync((char*)d_ws + O_BAR, 0, 16384, stream);
  void* args[] = {&p};
  hipError_t e = hipLaunchCooperativeKernel((void*)fwd_megakernel, dim3(grid_blocks), dim3(512), args, DYN_LDS, stream);
  if (e != hipSuccess) fprintf(stderr, "cooperative launch failed: %s (grid %d)\n", hipGetErrorString(e), grid_blocks);
}
```

```cpp
#include <hip/hip_runtime.h>
#include <hip/hip_cooperative_groups.h>
#include <cstdio>
namespace cg = cooperative_groups;

#define DI __device__ __forceinline__
typedef unsigned short bf16_t;
typedef short bf16x8 __attribute__((ext_vector_type(8)));
typedef short s16x4 __attribute__((ext_vector_type(4)));
typedef float f32x16 __attribute__((ext_vector_type(16)));
typedef float f32x4 __attribute__((ext_vector_type(4)));
typedef unsigned u32x4 __attribute__((ext_vector_type(4)));
#define LAS __attribute__((address_space(3)))
typedef __bf16 bfv2 __attribute__((ext_vector_type(2)));
typedef float fv2 __attribute__((ext_vector_type(2)));
#define MFMA32(a, b, c) __builtin_amdgcn_mfma_f32_32x32x16_bf16((a), (b), (c), 0, 0, 0)

DI unsigned pack2(float a, float b) { fv2 v = {a, b}; return __builtin_bit_cast(unsigned, __builtin_convertvector(v, bfv2)); }
DI bf16_t f2bf(float a) { return (bf16_t)(pack2(a, 0.f) & 0xffffu); }
DI float bflo(unsigned u) { return __uint_as_float(u << 16); }
DI float bfhi(unsigned u) { return __uint_as_float(u & 0xffff0000u); }
DI float bf2f(bf16_t u) { return __uint_as_float(((unsigned)u) << 16); }
DI float sigmoidf_(float x) { return __builtin_amdgcn_rcpf(1.f + __expf(-x)); }
DI float siluf_(float x) { return x * __builtin_amdgcn_rcpf(1.f + __expf(-x)); }
DI int tidx() { int t = threadIdx.x; asm volatile("" : "+v"(t)); return t; }
DI int bidx() { int b = blockIdx.x; asm volatile("" : "+s"(b)); return b; }
DI float xor32_sum(float x) { auto r = __builtin_amdgcn_permlane32_swap(__float_as_uint(x), __float_as_uint(x), false, false); return __uint_as_float(r[0]) + __uint_as_float(r[1]); }
DI float xor32_max(float x) { auto r = __builtin_amdgcn_permlane32_swap(__float_as_uint(x), __float_as_uint(x), false, false); return fmaxf(__uint_as_float(r[0]), __uint_as_float(r[1])); }
DI float xor16_sum(float x) { auto r = __builtin_amdgcn_permlane16_swap(__float_as_uint(x), __float_as_uint(x), false, false); return __uint_as_float(r[0]) + __uint_as_float(r[1]); }
DI float fdpp_add(float x, const int sel) {
  int xi = __float_as_int(x), yi;
  if (sel == 0) yi = __builtin_amdgcn_update_dpp(0, xi, 0xB1, 0xF, 0xF, true);
  else if (sel == 1) yi = __builtin_amdgcn_update_dpp(0, xi, 0x4E, 0xF, 0xF, true);
  else if (sel == 2) yi = __builtin_amdgcn_update_dpp(0, xi, 0x141, 0xF, 0xF, true);
  else yi = __builtin_amdgcn_update_dpp(0, xi, 0x140, 0xF, 0xF, true);
  return x + __int_as_float(yi);
}
DI float wave_sum_fast(float v) { v = fdpp_add(v, 0); v = fdpp_add(v, 1); v = fdpp_add(v, 2); v = fdpp_add(v, 3); v = xor16_sum(v); return xor32_sum(v); }
DI int crow(int i, int h) { return (i & 3) + 8 * (i >> 2) + 4 * h; }

constexpr int T_ = 2048, NTOK = 16384, HS = 3840, NIN = 6808;
constexpr int C_AQ = 0, C_KC = 512, C_VC = 640, C_KS = 768, C_KW = 1024, C_AZ = 1280, C_BQ = 1792, C_BK = 2048,
              C_BZ = 2304, C_R = 2560, C_K = 2816, C_V = 3072, C_WD = 3328, C_CZ = 3456, C_GATE = 3712;

constexpr size_t al256(size_t x) { return (x + 255) & ~(size_t)255; }
constexpr size_t O_WTA = 0;
constexpr size_t O_WTM = O_WTA + (size_t)3840 * 1024 * 2;
constexpr size_t O_WTP = O_WTM + (size_t)3072 * 1024 * 2;
constexpr size_t O_WTO = O_WTP + (size_t)1024 * 1024 * 2;
constexpr size_t O_W1K = O_WTO + (size_t)1024 * 1024 * 2;
constexpr size_t O_W1V = O_W1K + (size_t)128 * 2048 * 2;
constexpr size_t O_W2K = O_W1V + (size_t)128 * 2048 * 2;
constexpr size_t O_W2V = O_W2K + (size_t)64 * 128 * 2;
constexpr size_t O_PEB = O_W2V + (size_t)64 * 128 * 2;
constexpr size_t O_LW2 = O_PEB + 1024;
constexpr size_t O_LA2 = O_LW2 + 256 * 64 * 2;
constexpr size_t O_V1T = O_LA2 + 256 * 64 * 2;
constexpr size_t O_V2T = O_V1T + 32 * 256 * 2;
constexpr size_t O_CNT = O_V2T + 256 * 32 * 2;
constexpr size_t O_BAR = O_CNT + 256;
constexpr size_t O_XN = O_BAR + 16384;
constexpr size_t O_H = O_XN + (size_t)NTOK * 1024 * 2;
constexpr size_t O_VT = O_H + (size_t)NTOK * HS * 2;
constexpr size_t O_KC = O_VT + (size_t)3 * 8 * 2 * 64 * 2048 * 2;
constexpr size_t O_VCT = O_KC + (size_t)16 * 128 * 64 * 2;
constexpr size_t O_VF = O_VCT + (size_t)16 * 128 * 64 * 2;
constexpr size_t O_YR = O_VF + (size_t)NTOK * 256 * 2;
constexpr size_t O_BON = O_YR + (size_t)NTOK * 256 * 2;
constexpr size_t O_PR = O_BON + (size_t)NTOK * 4 * 4;
constexpr size_t WS_TOTAL = O_PR + (size_t)NTOK * 4 * 384 * 2;

#ifndef PROBE
#define PROBE 0
#define PROBE_T 0
#define PROBE_TSCALE 0.0001f
#endif
struct Params {
  const float* in[29];
  float* out;
  char* ws;
};

typedef const __attribute__((address_space(4))) char* kaptr_t;
DI kaptr_t KA() { kaptr_t k = (kaptr_t)__builtin_amdgcn_kernarg_segment_ptr(); asm volatile("" : "+s"(k)); return k; }
DI const float* IN(int i) { return *(const float* const __attribute__((address_space(4)))*)(KA() + 8 * i); }
DI float* OUTP() { return *(float* const __attribute__((address_space(4)))*)(KA() + 8 * 29); }
DI char* WS(const Params&) { return *(char* const __attribute__((address_space(4)))*)(KA() + 8 * 30); }
constexpr int SMEM_BYTES = 73728;
constexpr int DYN_XB = 155648;
constexpr int DYN_LDS = DYN_XB + 64;
constexpr int LDT = 72;

#define G_LOAD(P, ao_, bo_) do { const long ao__ = (ao_); const int bo__ = (bo_); \
  P##a0 = *(const uint4*)(a0 + ao__); P##a1 = *(const uint4*)(a1 + ao__); P##a2 = *(const uint4*)(a2 + ao__); P##a3 = *(const uint4*)(a3 + ao__); \
  P##b0 = *(const uint4*)(b0 + bo__); P##b1 = *(const uint4*)(b1 + bo__); P##b2 = *(const uint4*)(b2 + bo__); P##b3 = *(const uint4*)(b3 + bo__); } while (0)
#define G_STORE(P, A_, B_) do { bf16_t* A__ = (A_); bf16_t* B__ = (B_); \
  *(uint4*)(A__ + (wr)*LDT + wc) = P##a0; *(uint4*)(A__ + (wr + 32) * LDT + wc) = P##a1; \
  *(uint4*)(A__ + (wr + 64) * LDT + wc) = P##a2; *(uint4*)(A__ + (wr + 96) * LDT + wc) = P##a3; \
  *(uint4*)(B__ + (wr)*LDT + wc) = P##b0; *(uint4*)(B__ + (wr + 32) * LDT + wc) = P##b1; \
  *(uint4*)(B__ + (wr + 64) * LDT + wc) = P##b2; *(uint4*)(B__ + (wr + 96) * LDT + wc) = P##b3; } while (0)
DI void g_compute(f32x16 (&acc)[2][2], const bf16_t* A_, const bf16_t* B_) {
  __builtin_amdgcn_s_setprio(1);
#pragma unroll
  for (int s = 0; s < 4; ++s) {
    bf16x8 fa0 = *(const bf16x8*)(A_ + 16 * s);
    bf16x8 fa1 = *(const bf16x8*)(A_ + 32 * LDT + 16 * s);
    bf16x8 fb0 = *(const bf16x8*)(B_ + 16 * s);
    bf16x8 fb1 = *(const bf16x8*)(B_ + 32 * LDT + 16 * s);
    acc[0][0] = MFMA32(fa0, fb0, acc[0][0]);
    acc[0][1] = MFMA32(fa0, fb1, acc[0][1]);
    acc[1][0] = MFMA32(fa1, fb0, acc[1][0]);
    acc[1][1] = MFMA32(fa1, fb1, acc[1][1]);
  }
  __builtin_amdgcn_s_setprio(0);
}
DI void gemm_core(f32x16 (&acc)[2][2], const bf16_t* a0, const bf16_t* a1, const bf16_t* a2, const bf16_t* a3, long aks,
                  const bf16_t* b0, const bf16_t* b1, const bf16_t* b2, const bf16_t* b3, int KT, bf16_t* sm, int tid) {
  const int lane = tid & 63, w = tid >> 6, wm = w >> 1, wn = w & 1, h = lane >> 5, r31 = lane & 31;
  bf16_t* As = sm;
  bf16_t* Bs = sm + 2 * 128 * LDT;
  const int wr = (tid >> 3), wc = (tid & 7) * 8;
#pragma unroll
  for (int i = 0; i < 2; ++i)
#pragma unroll
    for (int j = 0; j < 2; ++j)
#pragma unroll
      for (int e = 0; e < 16; ++e) acc[i][j][e] = 0.f;
  uint4 pa0, pa1, pa2, pa3, pb0, pb1, pb2, pb3, qa0, qa1, qa2, qa3, qb0, qb1, qb2, qb3;
  G_LOAD(p, 0, 0);
  G_LOAD(q, aks, 64);
  __syncthreads();
  G_STORE(p, As, Bs);
  __syncthreads();
  const int aoff = (wm * 64 + r31) * LDT + 8 * h, boff = (wn * 64 + r31) * LDT + 8 * h;
  for (int kt = 0; kt < KT; kt += 2) {
    if (kt + 2 < KT) G_LOAD(p, (long)(kt + 2) * aks, (kt + 2) * 64);
    __builtin_amdgcn_sched_barrier(0);
    g_compute(acc, As + aoff, Bs + boff);
    __builtin_amdgcn_sched_barrier(0);
    G_STORE(q, As + 128 * LDT, Bs + 128 * LDT);
    __syncthreads();
    if (kt + 3 < KT) G_LOAD(q, (long)(kt + 3) * aks, (kt + 3) * 64);
    __builtin_amdgcn_sched_barrier(0);
    g_compute(acc, As + 128 * LDT + aoff, Bs + 128 * LDT + boff);
    __builtin_amdgcn_sched_barrier(0);
    if (kt + 2 < KT) G_STORE(p, As, Bs);
    __syncthreads();
  }
}


constexpr int BM = 256, BK = 64, HALF = 128, HTB = HALF * BK * 2, STAGE_BYTES = 8 * HTB, NXCD = 8, WGM = 8;
DI int lds_byte(int r, int c) { const int st = (r >> 4) * 2 + (c >> 5), rr = r & 15, cc = c & 31, ob = rr * 64 + cc * 2; return st * 1024 + (ob ^ (((ob >> 9) & 1) << 5)); }
DI void stage_rc(int b, int& R, int& C) { const int st = b / 1024, sb = b % 1024, swz = sb ^ (((sb >> 9) & 1) << 5); R = (st >> 1) * 16 + swz / 64; C = (st & 1) * 32 + (swz % 64) / 2; }
DI int perm32(int rho) { const int n = rho >> 4, i = rho & 15; return 8 * (i >> 2) + 4 * n + (i & 3); }
struct Unit { int pm, pn; };
struct Gemm { const bf16_t* A; const bf16_t* Bt; int lda, ldb, K; };
struct StaticOrder {
    int nM, nN, nwg, G, c;
    DI void init(int M, int N, int G_, int c_) { nM = M / BM; nN = N / BM; nwg = nM * nN; G = G_; c = c_; }
    DI bool next(int i, Unit& u) const {
        const long L = (long)i * G + c; if (L >= nwg) return false;
        int wgid = (int)L; { const int q = nwg / NXCD, r = nwg % NXCD, xcd = wgid % NXCD, off = wgid / NXCD; wgid = (xcd < r ? xcd * (q + 1) : r * (q + 1) + (xcd - r) * q) + off; }
        const int nig = WGM * nN, gid = wgid / nig, fm = gid * WGM, gsz = (nM - fm) < WGM ? (nM - fm) : WGM;
        u.pm = fm + ((wgid % nig) % gsz); u.pn = (wgid % nig) / gsz; return true;
    }
    DI void a_ready(const Unit&) const {}
    DI void done(const Unit&) const {}
};
struct OneUnit { Unit u; DI bool next(int i, Unit& o) const { if (i) return false; o = u; return true; } DI void a_ready(const Unit&) const {} DI void done(const Unit&) const {} };
template <class Epi, class Sched>
DI void gemm_phase(LAS unsigned char* lds, const Gemm g, const Sched& S, const Epi& E) {
    const int tid = tidx(), wid = __builtin_amdgcn_readfirstlane(tid >> 6), lane = tid & 63, wr = wid >> 2, wc = wid & 3, fr = lane & 15, fq = lane >> 4;
    const int K = g.K, nt = K / BK;
    unsigned voffA[2], voffB[2];
#pragma unroll
    for (int i = 0; i < 2; ++i) { int R, C; stage_rc(tid * 16 + i * 8192, R, C); const int Rb = Epi::PERM ? ((R & ~31) + perm32(R & 31)) : R;
        voffA[i] = (unsigned)(R * g.lda + C) * 2u; voffB[i] = (unsigned)(Rb * g.ldb + C) * 2u; }
    const size_t kstep = (size_t)(BK * 2);
    const size_t hstepA = (size_t)HALF * g.lda * 2, hstepB = (size_t)HALF * g.ldb * 2;
    const size_t tstepA = 2 * hstepA, tstepB = 2 * hstepB;
    const unsigned ldsw = (unsigned)wid * 1024u;
    const int aoff = lds_byte(wr * 64 + fr, fq * 8), boff = lds_byte(wc * 32 + fr, fq * 8);
#define PG8_SA(b, h) (((b) * 2 + (h)) * HTB)
#define PG8_SB(b, h) ((4 + (b) * 2 + (h)) * HTB)
#define PG8_STAGE(bufoff, gbase, voff) do { _Pragma("unroll") for (int _i = 0; _i < 2; ++_i) \
        __builtin_amdgcn_global_load_lds((const unsigned*)((const char*)(gbase) + (voff)[_i]), (LAS unsigned*)(lds + (bufoff) + ldsw + _i * 8192), 16, 0, 0); } while (0)
#define PG8_LDA(dst, b, h) do { _Pragma("unroll") for (int m = 0; m < 4; ++m) _Pragma("unroll") for (int k = 0; k < 2; ++k) dst[m][k] = *(const LAS bf16x8*)(lds + PG8_SA(b, h) + aoff + m * 2048 + k * 1024); } while (0)
#define PG8_LDB(dst, b, h) do { _Pragma("unroll") for (int n = 0; n < 2; ++n) _Pragma("unroll") for (int k = 0; k < 2; ++k) dst[n][k] = *(const LAS bf16x8*)(lds + PG8_SB(b, h) + boff + n * 2048 + k * 1024); } while (0)
#define PG8_MMA(ai, bj, At, Bt) do { __builtin_amdgcn_s_setprio(1); _Pragma("unroll") for (int m = 0; m < 4; ++m) _Pragma("unroll") for (int n = 0; n < 2; ++n) _Pragma("unroll") for (int k = 0; k < 2; ++k) \
        acc[ai][bj][m][n] = __builtin_amdgcn_mfma_f32_16x16x32_bf16(Bt[n][k], At[m][k], acc[ai][bj][m][n], 0, 0, 0); __builtin_amdgcn_s_setprio(0); } while (0)
#define PG8_WAIT_V(n) asm volatile("s_waitcnt vmcnt(" #n ")" ::: "memory")
#define PG8_WAIT_L(n) asm volatile("s_waitcnt lgkmcnt(" #n ")" ::: "memory")
#define PG8_BAR __builtin_amdgcn_s_barrier()
#define PG8_SCHED __builtin_amdgcn_sched_barrier(0)
    Unit cur, nxt; int ui = 0;
    if (!S.next(0, cur)) return;
    f32x4 acc[2][2][4][2];
#pragma unroll
    for (int a = 0; a < 2; ++a)
#pragma unroll
        for (int b = 0; b < 2; ++b)
#pragma unroll
            for (int m = 0; m < 4; ++m)
#pragma unroll
                for (int n = 0; n < 2; ++n) acc[a][b][m][n] = (f32x4){0.f, 0.f, 0.f, 0.f};
    bf16x8 At[4][2], B0[2][2], B1[2][2];
    const char* cA = (const char*)g.A + (size_t)cur.pm * tstepA; const char* cB = (const char*)g.Bt + (size_t)cur.pn * tstepB;
    S.a_ready(cur);
    PG8_STAGE(PG8_SB(0, 0), cB, voffB); PG8_STAGE(PG8_SA(0, 0), cA, voffA); PG8_STAGE(PG8_SB(0, 1), cB + hstepB, voffB); PG8_STAGE(PG8_SA(0, 1), cA + hstepA, voffA);
    if (wr == 1) PG8_BAR;
    PG8_WAIT_V(4); PG8_BAR;
    PG8_STAGE(PG8_SB(1, 0), cB + kstep, voffB); PG8_STAGE(PG8_SA(1, 0), cA + kstep, voffA); PG8_STAGE(PG8_SB(1, 1), cB + hstepB + kstep, voffB);
    PG8_WAIT_V(6); PG8_BAR;
    for (;;) {
        const bool has_next = S.next(ui + 1, nxt);
        const char* nA = has_next ? (const char*)g.A + (size_t)nxt.pm * tstepA : cA; const char* nB = has_next ? (const char*)g.Bt + (size_t)nxt.pn * tstepB : cB;
        for (int t = 0; t < nt; t += 2) {
            const bool last = (t == nt - 2);
            const char* a1 = cA + (size_t)(t + 1) * kstep;
            const char* a2 = last ? nA : cA + (size_t)(t + 2) * kstep; const char* b2 = last ? nB : cB + (size_t)(t + 2) * kstep;
            const char* a3 = a2 + kstep; const char* b3 = b2 + kstep;
            if (last && has_next) S.a_ready(nxt);
            PG8_LDB(B0, 0, 0); PG8_SCHED; PG8_LDA(At, 0, 0); PG8_STAGE(PG8_SA(1, 1), a1 + hstepA, voffA);
            PG8_WAIT_L(8); PG8_BAR; PG8_WAIT_L(0); PG8_MMA(0, 0, At, B0); PG8_BAR; PG8_SCHED;
            PG8_LDB(B1, 0, 1); PG8_STAGE(PG8_SB(0, 0), b2, voffB);
            PG8_BAR; PG8_WAIT_L(0); PG8_MMA(0, 1, At, B1); PG8_BAR;
            PG8_LDA(At, 0, 1); PG8_STAGE(PG8_SA(0, 0), a2, voffA);
            PG8_BAR; PG8_WAIT_L(0); PG8_MMA(1, 0, At, B0); PG8_BAR; PG8_SCHED;
            PG8_STAGE(PG8_SB(0, 1), b2 + hstepB, voffB);
            PG8_WAIT_V(6); PG8_BAR; PG8_MMA(1, 1, At, B1); PG8_BAR;
            PG8_LDB(B0, 1, 0); PG8_SCHED; PG8_LDA(At, 1, 0); PG8_STAGE(PG8_SA(0, 1), a2 + hstepA, voffA);
            PG8_WAIT_L(8); PG8_BAR; PG8_WAIT_L(0); PG8_MMA(0, 0, At, B0); PG8_BAR; PG8_SCHED;
            PG8_LDB(B1, 1, 1); PG8_STAGE(PG8_SB(1, 0), b3, voffB);
            PG8_BAR; PG8_WAIT_L(0); PG8_MMA(0, 1, At, B1); PG8_BAR;
            PG8_LDA(At, 1, 1); PG8_STAGE(PG8_SA(1, 0), a3, voffA);
            PG8_BAR; PG8_WAIT_L(0); PG8_MMA(1, 0, At, B0); PG8_BAR; PG8_SCHED;
            PG8_STAGE(PG8_SB(1, 1), b3 + hstepB, voffB);
            PG8_WAIT_V(6); PG8_BAR; PG8_MMA(1, 1, At, B1); PG8_BAR;
        }
        if constexpr (!Epi::AFTER_DRAIN) { E(acc, cur, wr, wc, fr, fq); S.done(cur); }
        if (!has_next) break;
#pragma unroll
        for (int a = 0; a < 2; ++a)
#pragma unroll
            for (int b = 0; b < 2; ++b)
#pragma unroll
                for (int m = 0; m < 4; ++m)
#pragma unroll
                    for (int n = 0; n < 2; ++n) acc[a][b][m][n] = (f32x4){0.f, 0.f, 0.f, 0.f};
        cur = nxt; cA = nA; cB = nB; ++ui;
    }
    PG8_WAIT_V(0);
    if (wr == 0) PG8_BAR;
    PG8_BAR;
    if constexpr (Epi::AFTER_DRAIN) { E.fused(acc, cur, wr, wc, fr, fq, lds, wid, lane); S.done(cur); }
#undef PG8_SA
#undef PG8_SB
#undef PG8_STAGE
#undef PG8_LDA
#undef PG8_LDB
#undef PG8_MMA
#undef PG8_WAIT_V
#undef PG8_WAIT_L
#undef PG8_BAR
#undef PG8_SCHED
}

struct TJob { const float* src; int ld; int mode; bf16_t* dst; int ldd; int ntn; int ntk; };

DI TJob get_job(int j, const Params& p, int l) {
  char* ws = WS(p);
  TJob t;
  switch (j) {
    case 0: t = {IN(2) + (size_t)l * 1024 * NIN, NIN, 1, (bf16_t*)(ws + O_WTA), 1024, 60, 16}; break;
    case 1: t = {IN(2) + (size_t)l * 1024 * NIN + 3736, NIN, 0, (bf16_t*)(ws + O_WTM), 1024, 48, 16}; break;
    case 2: t = {IN(24) + (size_t)l * 512 * 1024, 1024, 0, (bf16_t*)(ws + O_WTP), 1024, 16, 8}; break;
    case 3: t = {IN(25) + (size_t)l * 256 * 1024, 1024, 0, (bf16_t*)(ws + O_WTP) + 512, 1024, 16, 4}; break;
    case 4: t = {IN(26) + (size_t)l * 256 * 1024, 1024, 0, (bf16_t*)(ws + O_WTP) + 768, 1024, 16, 4}; break;
    case 5: t = {IN(27) + (size_t)l * 1024 * 1024, 1024, 0, (bf16_t*)(ws + O_WTO), 1024, 16, 16}; break;
    case 6: t = {IN(5) + (size_t)l * 2048 * 128, 128, 0, (bf16_t*)(ws + O_W1K), 2048, 2, 32}; break;
    case 7: t = {IN(8) + (size_t)l * 2048 * 128, 128, 0, (bf16_t*)(ws + O_W1V), 2048, 2, 32}; break;
    case 8: t = {IN(6) + (size_t)l * 128 * 64, 64, 0, (bf16_t*)(ws + O_W2K), 128, 1, 2}; break;
    case 9: t = {IN(9) + (size_t)l * 128 * 64, 64, 0, (bf16_t*)(ws + O_W2V), 128, 1, 2}; break;
    case 10: t = {IN(13) + (size_t)l * 64 * 256, 256, 0, (bf16_t*)(ws + O_LW2), 64, 4, 1}; break;
    default: t = {IN(15) + (size_t)l * 64 * 256, 256, 0, (bf16_t*)(ws + O_LA2), 64, 4, 1}; break;
  }
  return t;
}

struct TrTile { TJob jb; int n0, k0; bool valid; };
DI TrTile tr_find(const Params& p, int l, int id) {
  TrTile t; t.valid = id < 2380;
  int rem = t.valid ? id : 0;
  t.jb = get_job(0, p, l);
  for (int j = 0; j < 12; ++j) {
    t.jb = get_job(j, p, l);
    const int cnt = t.jb.ntn * t.jb.ntk;
    if (rem < cnt) break;
    rem -= cnt;
  }
  t.n0 = (rem / t.jb.ntk) * 64; t.k0 = (rem % t.jb.ntk) * 64;
  return t;
}
DI void tr_load(const TrTile& t, int tid, float4 (&r)[4]) {
  const int n4 = (tid & 15) * 4;
  const int c = t.n0 + n4;
  int oc = c; bool cv = t.valid;
  if (t.jb.mode == 1) {
    if (c < 1280) oc = c; else if (c < 3712) oc = c + 24; else if (c < 3736) oc = c - 3712 + 1280; else { oc = 0; cv = false; }
  }
#pragma unroll
  for (int pz = 0; pz < 4; ++pz) {
    const int kk = (tid >> 4) + 16 * pz;
    r[pz] = make_float4(0.f, 0.f, 0.f, 0.f);
    if (cv) r[pz] = *(const float4*)(t.jb.src + (size_t)(t.k0 + kk) * t.jb.ld + oc);
  }
}
DI void tr_put(float* tile, int tid, const float4 (&r)[4]) {
  const int n4 = (tid & 15) * 4;
#pragma unroll
  for (int pz = 0; pz < 4; ++pz) {
    const int kk = (tid >> 4) + 16 * pz;
    tile[kk * 65 + n4 + 0] = r[pz].x; tile[kk * 65 + n4 + 1] = r[pz].y; tile[kk * 65 + n4 + 2] = r[pz].z; tile[kk * 65 + n4 + 3] = r[pz].w;
  }
}
DI void tr_store(const TrTile& t, const float* tile, int tid) {
  if (t.valid) {
#pragma unroll
    for (int pz = 0; pz < 2; ++pz) {
      const int q = tid + 256 * pz;
      const int nn = q >> 3, kc = (q & 7) * 8;
      uint4 o;
      o.x = pack2(tile[(kc + 0) * 65 + nn], tile[(kc + 1) * 65 + nn]);
      o.y = pack2(tile[(kc + 2) * 65 + nn], tile[(kc + 3) * 65 + nn]);
      o.z = pack2(tile[(kc + 4) * 65 + nn], tile[(kc + 5) * 65 + nn]);
      o.w = pack2(tile[(kc + 6) * 65 + nn], tile[(kc + 7) * 65 + nn]);
      *(uint4*)(t.jb.dst + (size_t)(t.n0 + nn) * t.jb.ldd + t.k0 + kc) = o;
    }
  }
}

DI float wave_sum(float v) {
#pragma unroll
  for (int o = 32; o > 0; o >>= 1) v += __shfl_xor(v, o, 64);
  return v;
}

DI void rmsnorm_rows(const float* x, const float* g, bf16_t* outb, float* outf) {
  const int lane = tidx() & 63, w = tidx() >> 6;
  for (int it = bidx(); it < NTOK / 16; it += gridDim.x) {
    float4 v[2][4]; float ss[2] = {0.f, 0.f};
#pragma unroll
    for (int rr = 0; rr < 2; ++rr) {
      const float* xr = x + (size_t)(it * 16 + rr * 8 + w) * 1024;
#pragma unroll
      for (int i = 0; i < 4; ++i) v[rr][i] = *(const float4*)(xr + lane * 4 + 256 * i);
    }
    float4 gg[4];
#pragma unroll
    for (int i = 0; i < 4; ++i) gg[i] = *(const float4*)(g + lane * 4 + 256 * i);
#pragma unroll
    for (int rr = 0; rr < 2; ++rr) {
#pragma unroll
      for (int i = 0; i < 4; ++i) ss[rr] += v[rr][i].x * v[rr][i].x + v[rr][i].y * v[rr][i].y + v[rr][i].z * v[rr][i].z + v[rr][i].w * v[rr][i].w;
      ss[rr] = wave_sum_fast(ss[rr]);
    }
#pragma unroll
    for (int rr = 0; rr < 2; ++rr) {
      const int row = it * 16 + rr * 8 + w;
      const float rs = rsqrtf(ss[rr] * (1.f / 1024.f) + 1e-6f);
#pragma unroll
      for (int i = 0; i < 4; ++i) {
        const float o0 = v[rr][i].x * rs * gg[i].x, o1 = v[rr][i].y * rs * gg[i].y, o2 = v[rr][i].z * rs * gg[i].z, o3 = v[rr][i].w * rs * gg[i].w;
        if (outf) { *(float4*)(outf + (size_t)row * 1024 + lane * 4 + 256 * i) = make_float4(o0, o1, o2, o3); }
        else { uint2 o; o.x = pack2(o0, o1); o.y = pack2(o2, o3); *(uint2*)(outb + (size_t)row * 1024 + lane * 4 + 256 * i) = o; }
      }
    }
  }
}

DI void phase0(const Params& p, int l, char* smraw) {
  const int half = tidx() >> 8, ltid = tidx() & 255;
  float* tile = (float*)(smraw + half * 17408);
  {
    int id0 = bidx() * 2;
    TrTile cur = tr_find(p, l, id0 + half);
    float4 rg[4];
    tr_load(cur, ltid, rg);
    while (id0 < 2380) {
      tr_put(tile, ltid, rg);
      __syncthreads();
      const int id1 = id0 + gridDim.x * 2;
      TrTile nxt = tr_find(p, l, id1 + half);
      if (id1 < 2380) tr_load(nxt, ltid, rg);
      tr_store(cur, tile, ltid);
      __syncthreads();
      cur = nxt; id0 = id1;
    }
  }
  const float* xin = (l == 0) ? IN(0) : OUTP();
  rmsnorm_rows(xin, IN(1) + l * 1024, (bf16_t*)(WS(p) + O_XN), nullptr);
  const int gtid = bidx() * 512 + tidx(), nth = gridDim.x * 512;
  if (l == 1) {
    bf16_t* v1t = (bf16_t*)(WS(p) + O_V1T); bf16_t* v2t = (bf16_t*)(WS(p) + O_V2T);
    const float* v1 = IN(22); const float* v2 = IN(23);
    for (int idx = gtid; idx < 8192; idx += nth) {
      { const int j = idx >> 8, c = idx & 255; v1t[idx] = f2bf(v1[c * 32 + j]); }
      { const int c = idx >> 5, j = idx & 31; v2t[idx] = f2bf(v2[j * 256 + c]); }
    }
  }
  {
    bf16_t* kc = (bf16_t*)(WS(p) + O_KC); bf16_t* vct = (bf16_t*)(WS(p) + O_VCT);
    for (int idx = gtid; idx < 1024; idx += nth) {
      const int bg = idx >> 6, d = idx & 63;
      kc[(bg * 128 + 127) * 64 + d] = 0; vct[(bg * 64 + d) * 128 + 127] = 0;
    }
    if (gtid == 0) { ((int*)(WS(p) + O_CNT))[l] = 0; }
    if (gtid == 1) { ((int*)(WS(p) + O_CNT))[4 + l] = 0; }
  }
  {
    const int lane = tidx() & 63, gw = bidx() * 8 + (tidx() >> 6), nw = gridDim.x * 8;
    float* peb = (float*)(WS(p) + O_PEB);
    for (int o = gw; o < 256; o += nw) {
      const int which = o >> 7, n = o & 127;
      const float* pe = (which ? IN(7) : IN(4)) + (size_t)l * 2048;
      const float* w1 = (which ? IN(8) : IN(5)) + (size_t)l * 2048 * 128;
      float s = 0.f;
      float pa[32], pb[32];
#pragma unroll
      for (int i = 0; i < 32; ++i) { const int k = lane + 64 * i; pa[i] = pe[k]; pb[i] = w1[(size_t)k * 128 + n]; }
#pragma unroll
      for (int i = 0; i < 32; ++i) s += pa[i] * pb[i];
      s = wave_sum(s);
      if (lane == 0) peb[o] = s;
    }
  }
}

DI u32x4 pack8(const f32x4& a, const f32x4& b) {
  u32x4 w; w.x = pack2(a[0], a[1]); w.y = pack2(a[2], a[3]); w.z = pack2(b[0], b[1]); w.w = pack2(b[2], b[3]); return w;
}
struct EpiH {
  static constexpr bool PERM = true, AFTER_DRAIN = false;
  bf16_t* H; bf16_t* VT;
  DI void operator()(const f32x4 (&acc)[2][2][4][2], const Unit& u, int wr, int wc, int fr, int fq) const {
    const int row0 = u.pm * BM + wr * 64 + fr;
    const int cl = wc * 32 + 8 * fq;
    const int which = (u.pn == 3) ? 0 : (u.pn == 4) ? 1 : (u.pn == 8) ? 2 : -1;
#pragma unroll
    for (int ai = 0; ai < 2; ++ai)
#pragma unroll
      for (int m = 0; m < 4; ++m) {
        const int row = row0 + ai * HALF + m * 16;
        *(u32x4*)(H + (size_t)row * HS + u.pn * BM + cl) = pack8(acc[ai][0][m][0], acc[ai][0][m][1]);
        if (which < 0) {
          *(u32x4*)(H + (size_t)row * HS + u.pn * BM + HALF + cl) = pack8(acc[ai][1][m][0], acc[ai][1][m][1]);
        } else {
          const int b = row >> 11, t = row & 2047;
          bf16_t* vp = VT + ((size_t)((which * 8 + b) * 128 + cl)) * 2048 + t;
#pragma unroll
          for (int j = 0; j < 4; ++j) { vp[(size_t)j * 2048] = f2bf(acc[ai][1][m][0][j]); vp[(size_t)(4 + j) * 2048] = f2bf(acc[ai][1][m][1][j]); }
        }
      }
  }
};
DI void phase1(const Params& p, char* smraw) {
  Gemm g{(const bf16_t*)(WS(p) + O_XN), (const bf16_t*)(WS(p) + O_WTA), 1024, 1024, 1024};
  StaticOrder S; S.init(NTOK, HS, gridDim.x, bidx());
  EpiH E{(bf16_t*)(WS(p) + O_H), (bf16_t*)(WS(p) + O_VT)};
  gemm_phase<EpiH, StaticOrder>((LAS unsigned char*)smraw, g, S, E);
}

DI void compress_tile2(const Params& p, int l_, int tix, char* smraw) {
  const int half = tidx() >> 8, tid = tidx() & 255;
  const int which = tix >> 4, mt = tix & 15;
  bf16_t* sm = (bf16_t*)(smraw + half * SMEM_BYTES);
  const bf16_t* hb = (const bf16_t*)(WS(p) + O_H);
  const bf16_t* w1t = (const bf16_t*)(WS(p) + (which ? O_W1V : O_W1K));
  const bf16_t* w2t = (const bf16_t*)(WS(p) + (which ? O_W2V : O_W2K));
  const float* peb = (const float*)(WS(p) + O_PEB) + which * 128;
  const int lane = tid & 63, w = tid >> 6, wm = w >> 1, wn = w & 1, h = lane >> 5, r31 = lane & 31;
  const int wr = tid >> 3, wc = (tid & 7) * 8;
  const int col0 = which ? C_VC : C_KC;
  const bf16_t* ap[4];
#pragma unroll
  for (int i = 0; i < 4; ++i) {
    int m = mt * 128 + wr + 32 * i; if (m >= 2032) m = 0;
    const int b = m / 254, rem = m - b * 254, n = rem >> 1, g = rem & 1;
    ap[i] = hb + ((size_t)(b * 2048 + 16 * n + 16 * half)) * HS + col0 + g * 64 + wc;
  }
  const bf16_t* b0 = w1t + (size_t)wr * 2048 + wc + half * 1024;
  f32x16 acc[2][2];
  gemm_core(acc, ap[0], ap[1], ap[2], ap[3], HS, b0, b0 + 32 * 2048, b0 + 64 * 2048, b0 + 96 * 2048, 16, sm, tid);
  float4* part = (float4*)(smraw + SMEM_BYTES);
  if (half == 1) {
#pragma unroll
    for (int i = 0; i < 2; ++i)
#pragma unroll
      for (int j = 0; j < 2; ++j)
#pragma unroll
        for (int q = 0; q < 4; ++q)
          part[((i * 2 + j) * 4 + q) * 256 + tid] = make_float4(acc[i][j][4 * q], acc[i][j][4 * q + 1], acc[i][j][4 * q + 2], acc[i][j][4 * q + 3]);
  }
  __syncthreads();
  bf16_t* Hs = (bf16_t*)smraw;
  if (half == 0) {
#pragma unroll
    for (int i = 0; i < 2; ++i)
#pragma unroll
      for (int j = 0; j < 2; ++j) {
        const int n = wn * 64 + 32 * j + r31;
        const float bias = peb[n];
#pragma unroll
        for (int q = 0; q < 4; ++q) {
          const float4 o = part[((i * 2 + j) * 4 + q) * 256 + tid];
          const int r = wm * 64 + 32 * i + 8 * q + 4 * h;
          Hs[(r + 0) * 136 + n] = f2bf(siluf_(acc[i][j][4 * q + 0] + o.x + bias));
          Hs[(r + 1) * 136 + n] = f2bf(siluf_(acc[i][j][4 * q + 1] + o.y + bias));
          Hs[(r + 2) * 136 + n] = f2bf(siluf_(acc[i][j][4 * q + 2] + o.z + bias));
          Hs[(r + 3) * 136 + n] = f2bf(siluf_(acc[i][j][4 * q + 3] + o.w + bias));
        }
      }
  }
  __syncthreads();
  if (half == 0) {
    f32x16 o2[2];
#pragma unroll
    for (int j = 0; j < 2; ++j)
#pragma unroll
      for (int e = 0; e < 16; ++e) o2[j][e] = 0.f;
#pragma unroll
    for (int s = 0; s < 8; ++s) {
      const bf16x8 fa = *(const bf16x8*)(Hs + (w * 32 + r31) * 136 + 16 * s + 8 * h);
#pragma unroll
      for (int j = 0; j < 2; ++j) {
        const bf16x8 fb = *(const bf16x8*)(w2t + (32 * j + r31) * 128 + 16 * s + 8 * h);
        o2[j] = MFMA32(fa, fb, o2[j]);
      }
    }
    bf16_t* kc = (bf16_t*)(WS(p) + O_KC); bf16_t* vct = (bf16_t*)(WS(p) + O_VCT);
#pragma unroll
    for (int j = 0; j < 2; ++j) {
      const int d = 32 * j + r31;
#pragma unroll
      for (int e = 0; e < 16; ++e) {
        const int m = mt * 128 + w * 32 + crow(e, h);
        if (m < 2032) {
          const int b = m / 254, rem = m - b * 254, n = rem >> 1, g = rem & 1;
          if (which == 0) kc[((size_t)((b * 2 + g) * 128 + n)) * 64 + d] = f2bf(o2[j][e]);
          else vct[((size_t)((b * 2 + g) * 64 + d)) * 128 + n] = f2bf(o2[j][e]);
        }
      }
    }
  }
  __builtin_amdgcn_fence(__ATOMIC_RELEASE, "agent");
  __syncthreads();
  if (tidx() == 0) atomicAdd((int*)(WS(p) + O_CNT) + 4 + l_, 1);
}

DI void rwkv_prep(const Params& p, int l, int item, char* smraw) {
  const bf16_t* hb = (const bf16_t*)(WS(p) + O_H);
  bf16_t* A1 = (bf16_t*)smraw;
  bf16_t* A2 = A1 + 64 * LDT;
  bf16_t* A3 = A2 + 64 * LDT;
  const int tid = tidx(), lane = tid & 63, w = (tid >> 6) & 3, tt = tid >> 8, h = lane >> 5, r31 = lane & 31;
  const int T0 = item * 64;
  const float* mu = IN(11) + l * 896;
  __syncthreads();
  bf16_t* SR = A3 + 64 * 264;
  {
    const bool seqstart = (T0 & 2047) == 0;
    uint4 sv[13];
#pragma unroll
    for (int i = 0; i < 13; ++i) {
      const int idx = tid + 512 * i, row = idx / 96, c = idx - row * 96;
      sv[i] = make_uint4(0, 0, 0, 0);
      if (idx < 65 * 96 && (row > 0 || !seqstart)) sv[i] = *(const uint4*)(hb + (size_t)(T0 - 1 + row) * HS + C_R + c * 8);
    }
#pragma unroll
    for (int i = 0; i < 13; ++i) {
      const int idx = tid + 512 * i, row = idx / 96, c = idx - row * 96;
      if (idx < 65 * 96) *(uint4*)(SR + row * 776 + c * 8) = sv[i];
    }
  }
#pragma unroll
  for (int idx = tid; idx < 64 * 16; idx += 512) {
    const int tok = idx >> 4, c8 = idx & 15;
    const size_t m = (size_t)(T0 + tok);
    const uint4 z = *(const uint4*)(hb + m * HS + C_WD + c8 * 8);
    uint4 zp = make_uint4(0, 0, 0, 0);
    if (((T0 + tok) & 2047) != 0) zp = *(const uint4*)(hb + (m - 1) * HS + C_WD + c8 * 8);
    const unsigned zz[4] = {z.x, z.y, z.z, z.w}, pp[4] = {zp.x, zp.y, zp.z, zp.w};
    unsigned oo[4];
#pragma unroll
    for (int e = 0; e < 4; ++e) {
      const float m0 = mu[768 + c8 * 8 + 2 * e], m1 = mu[768 + c8 * 8 + 2 * e + 1];
      float x0 = bflo(zz[e]), x1 = bfhi(zz[e]);
      x0 = x0 + (bflo(pp[e]) - x0) * m0; x1 = x1 + (bfhi(pp[e]) - x1) * m1;
      if (c8 < 8) { x0 = 1.f - 2.f * __builtin_amdgcn_rcpf(__expf(2.f * x0) + 1.f); x1 = 1.f - 2.f * __builtin_amdgcn_rcpf(__expf(2.f * x1) + 1.f); }
      oo[e] = pack2(x0, x1);
    }
    bf16_t* dst = (c8 < 8) ? (A1 + tok * LDT + c8 * 8) : (A2 + tok * LDT + (c8 - 8) * 8);
    *(uint4*)dst = make_uint4(oo[0], oo[1], oo[2], oo[3]);
  }
  __syncthreads();
  if (l == 1) {
    for (int idx = tid; idx < 64 * 32; idx += 512) {
      const int tok = idx >> 5, c8 = idx & 31;
      const size_t m = (size_t)(T0 + tok);
      const uint4 z = *(const uint4*)(SR + (tok + 1) * 776 + 512 + c8 * 8);
      const uint4 zp = *(const uint4*)(SR + tok * 776 + 512 + c8 * 8);
      const unsigned zz[4] = {z.x, z.y, z.z, z.w}, pp[4] = {zp.x, zp.y, zp.z, zp.w};
      unsigned oo[4];
#pragma unroll
      for (int e = 0; e < 4; ++e) {
        const float m0 = mu[512 + c8 * 8 + 2 * e], m1 = mu[512 + c8 * 8 + 2 * e + 1];
        float x0 = bflo(zz[e]), x1 = bfhi(zz[e]);
        x0 = x0 + (bflo(pp[e]) - x0) * m0; x1 = x1 + (bfhi(pp[e]) - x1) * m1;
        oo[e] = pack2(x0, x1);
      }
      *(uint4*)(A3 + tok * 264 + c8 * 8) = make_uint4(oo[0], oo[1], oo[2], oo[3]);
    }
  }
  __syncthreads();
  const bf16_t* lw2 = (const bf16_t*)(WS(p) + O_LW2);
  const bf16_t* la2 = (const bf16_t*)(WS(p) + O_LA2);
  const bf16_t* v1t = (const bf16_t*)(WS(p) + O_V1T);
  const bf16_t* v2t = (const bf16_t*)(WS(p) + O_V2T);
  const float* w0 = IN(12) + l * 256; const float* a0 = IN(14) + l * 256;
  const float* kkw = IN(16) + l * 256; const float* kaw = IN(17) + l * 256; const float* rkw = IN(18) + l * 256;
  const float* v0 = IN(21);
  bf16_t* vf = (bf16_t*)(WS(p) + O_VF);
  bf16_t* pr = (bf16_t*)(WS(p) + O_PR);
  float* bon = (float*)(WS(p) + O_BON);
  {
    const int tokl = 32 * tt + r31;
    const size_t m = (size_t)(T0 + tokl);
    const bool first = (((T0 + tokl) & 2047) == 0);
    const int b = (int)(m >> 11), t = (int)(m & 2047);
    float ss = 0.f;
#pragma unroll
    for (int nt = 0; nt < 2; ++nt)
#pragma unroll
      for (int q = 0; q < 4; ++q) {
        const int c = w * 64 + 32 * nt + 8 * q + 4 * h;
        const uint2 zk = *(const uint2*)(SR + (tokl + 1) * 776 + 256 + c);
        const uint2 pk_ = *(const uint2*)(SR + tokl * 776 + 256 + c);
        const float4 muk = *(const float4*)(mu + 256 + c);
        const float4 kw4 = *(const float4*)(kkw + c);
        float x0 = bflo(zk.x), x1 = bfhi(zk.x), x2 = bflo(zk.y), x3 = bfhi(zk.y);
        x0 = (x0 + (bflo(pk_.x) - x0) * muk.x) * kw4.x; x1 = (x1 + (bfhi(pk_.x) - x1) * muk.y) * kw4.y;
        x2 = (x2 + (bflo(pk_.y) - x2) * muk.z) * kw4.z; x3 = (x3 + (bfhi(pk_.y) - x3) * muk.w) * kw4.w;
        ss += x0 * x0 + x1 * x1 + x2 * x2 + x3 * x3;
      }
    ss = xor32_sum(ss);
    const float inv = 1.f / fmaxf(sqrtf(ss), 1e-12f);
    float bsum = 0.f;
    bf16_t* prow = pr + ((size_t)((b * 4 + w) * 2048 + t)) * 384;
#pragma unroll 1
    for (int nt = 0; nt < 2; ++nt) {
      f32x16 aw, aa, av;
#pragma unroll
      for (int e = 0; e < 16; ++e) { aw[e] = 0.f; aa[e] = 0.f; av[e] = 0.f; }
#pragma unroll
      for (int s = 0; s < 4; ++s) {
        const bf16x8 f1 = *(const bf16x8*)(A1 + (32 * tt + r31) * LDT + 16 * s + 8 * h);
        const bf16x8 f2 = *(const bf16x8*)(A2 + (32 * tt + r31) * LDT + 16 * s + 8 * h);
        const bf16x8 gw = *(const bf16x8*)(lw2 + (w * 64 + 32 * nt + r31) * 64 + 16 * s + 8 * h);
        const bf16x8 ga = *(const bf16x8*)(la2 + (w * 64 + 32 * nt + r31) * 64 + 16 * s + 8 * h);
        aw = MFMA32(gw, f1, aw);
        aa = MFMA32(ga, f2, aa);
      }
      if (l == 1) {
        f32x16 t1;
#pragma unroll
        for (int e = 0; e < 16; ++e) t1[e] = 0.f;
#pragma unroll
        for (int s = 0; s < 16; ++s) {
          const bf16x8 fv = *(const bf16x8*)(A3 + (32 * tt + r31) * 264 + 16 * s + 8 * h);
          const bf16x8 g1 = *(const bf16x8*)(v1t + r31 * 256 + 16 * s + 8 * h);
          t1 = MFMA32(g1, fv, t1);
        }
#pragma unroll
        for (int s = 0; s < 2; ++s) {
          unsigned pk[4];
#pragma unroll
          for (int e = 0; e < 4; ++e) pk[e] = pack2(t1[8 * s + 2 * e], t1[8 * s + 2 * e + 1]);
          const bf16x8 fb = __builtin_bit_cast(bf16x8, make_uint4(pk[0], pk[1], pk[2], pk[3]));
          const bf16_t* vr = v2t + (w * 64 + 32 * nt + r31) * 32 + 16 * s + 4 * h;
          const uint2 lo = *(const uint2*)vr; const uint2 hi = *(const uint2*)(vr + 8);
          const bf16x8 fa = __builtin_bit_cast(bf16x8, make_uint4(lo.x, lo.y, hi.x, hi.y));
          av = MFMA32(fa, fb, av);
        }
      }
      uint2 sto[4][6];
#pragma unroll
      for (int q = 0; q < 4; ++q) {
        const int cl = 32 * nt + 8 * q + 4 * h;
        const int c = w * 64 + cl;
        const uint2 zr = *(const uint2*)(SR + (tokl + 1) * 776 + c);
        const uint2 zk = *(const uint2*)(SR + (tokl + 1) * 776 + 256 + c);
        const uint2 zv = *(const uint2*)(SR + (tokl + 1) * 776 + 512 + c);
        const uint2 pr_ = *(const uint2*)(SR + tokl * 776 + c);
        const uint2 pk_ = *(const uint2*)(SR + tokl * 776 + 256 + c);
        const uint2 pv_ = *(const uint2*)(SR + tokl * 776 + 512 + c);
        uint2 vfl = make_uint2(0, 0);
        if (l == 1) vfl = *(const uint2*)(vf + m * 256 + c);
        float orr[4], ou[4], okp[4], ovv[4], oa[4], ob[4];
#pragma unroll
        for (int e = 0; e < 4; ++e) {
          const int cc = c + e; const int i = 4 * q + e;
          const unsigned zru = (e < 2) ? zr.x : zr.y, zku = (e < 2) ? zk.x : zk.y, zvu = (e < 2) ? zv.x : zv.y;
          const unsigned pru = (e < 2) ? pr_.x : pr_.y, pku = (e < 2) ? pk_.x : pk_.y, pvu = (e < 2) ? pv_.x : pv_.y;
          const unsigned vfu = (e < 2) ? vfl.x : vfl.y;
          float xr = (e & 1) ? bfhi(zru) : bflo(zru), xk = (e & 1) ? bfhi(zku) : bflo(zku), xv = (e & 1) ? bfhi(zvu) : bflo(zvu);
          const float qr = (e & 1) ? bfhi(pru) : bflo(pru), qk = (e & 1) ? bfhi(pku) : bflo(pku), qv = (e & 1) ? bfhi(pvu) : bflo(pvu);
          xr = xr + (qr - xr) * mu[cc]; xk = xk + (qk - xk) * mu[256 + cc]; xv = xv + (qv - xv) * mu[512 + cc];
          const float wl = w0[cc] + aw[i];
          const float ew = 0.60653065971f * sigmoidf_(wl);
          const float u = 1.f - __expf(-ew);
          const float a = sigmoidf_(a0[cc] + aa[i]);
          if (l == 1) {
            const float vfirst = (e & 1) ? bfhi(vfu) : bflo(vfu);
            xv = xv + (vfirst - xv) * sigmoidf_(v0[cc] + av[i]);
          }
          const float kk = xk * kkw[cc] * inv;
          const float kp = xk * (1.f + (a - 1.f) * kaw[cc]);
          bsum += xr * kp * rkw[cc];
          orr[e] = xr; ou[e] = u; okp[e] = kp; ovv[e] = xv; oa[e] = -kk; ob[e] = kk * a;
        }
        uint2 o;
        o.x = pack2(orr[0], orr[1]); o.y = pack2(orr[2], orr[3]); sto[q][0] = o;
        o.x = pack2(ou[0], ou[1]); o.y = pack2(ou[2], ou[3]); sto[q][1] = o;
        o.x = pack2(okp[0], okp[1]); o.y = pack2(okp[2], okp[3]); sto[q][2] = o;
        o.x = pack2(ovv[0], ovv[1]); o.y = pack2(ovv[2], ovv[3]); sto[q][3] = o;
        o.x = pack2(oa[0], oa[1]); o.y = pack2(oa[2], oa[3]); sto[q][4] = o;
        o.x = pack2(ob[0], ob[1]); o.y = pack2(ob[2], ob[3]); sto[q][5] = o;
      }
#pragma unroll
      for (int q = 0; q < 4; ++q) {
        const int cl = 32 * nt + 8 * q + 4 * h;
#pragma unroll
        for (int k6 = 0; k6 < 6; ++k6) *(uint2*)(prow + k6 * 64 + cl) = sto[q][k6];
        if (l == 0) *(uint2*)(vf + m * 256 + w * 64 + cl) = sto[q][3];
      }
    }
    bsum = xor32_sum(bsum);
    if (h == 0) bon[m * 4 + w] = bsum;
  }
  __syncthreads();
}

DI float dpp_add(float x, const int ctrl_sel) {
  int xi = __float_as_int(x), yi;
  if (ctrl_sel == 0) yi = __builtin_amdgcn_update_dpp(0, xi, 0xB1, 0xF, 0xF, true);
  else if (ctrl_sel == 1) yi = __builtin_amdgcn_update_dpp(0, xi, 0x4E, 0xF, 0xF, true);
  else if (ctrl_sel == 2) yi = __builtin_amdgcn_update_dpp(0, xi, 0x141, 0xF, 0xF, true);
  else yi = __builtin_amdgcn_update_dpp(0, xi, 0x140, 0xF, 0xF, true);
  return x + __int_as_float(yi);
}
DI float row16_sum(float x) { x = dpp_add(x, 0); x = dpp_add(x, 1); x = dpp_add(x, 2); x = dpp_add(x, 3); return x; }

DI void scan_put(const uint4& g, int idx, float* dstbase) {
  const int e0 = idx * 8; const int arr = (e0 % 384) >> 6;
  float f[8] = {bflo(g.x), bfhi(g.x), bflo(g.y), bfhi(g.y), bflo(g.z), bfhi(g.z), bflo(g.w), bfhi(g.w)};
  if (arr == 1) {
#pragma unroll
    for (int e = 0; e < 8; ++e) f[e] = 1.f - f[e];
  }
  *(float4*)(dstbase + e0) = make_float4(f[0], f[1], f[2], f[3]);
  *(float4*)(dstbase + e0 + 4) = make_float4(f[4], f[5], f[6], f[7]);
}
DI void rwkv_scan(const Params& p, int item, char* smraw) {
  const int rg = item & 3, hd = (item >> 2) & 3, b = item >> 4;
  float* stage = (float*)smraw;
  const bf16_t* pr = (const bf16_t*)(WS(p) + O_PR) + ((size_t)((b * 4 + hd) * 2048)) * 384;
  bf16_t* yr = (bf16_t*)(WS(p) + O_YR);
  const int tid = tidx(), row = (tid >> 4) & 15, kq = tid & 15;
  const bool comp = tid < 256;
  const int st_ = tid & 255;
  fv2 S01 = {0.f, 0.f}, S23 = {0.f, 0.f};
  uint4 g[3];
  __syncthreads();
  if (comp) __builtin_amdgcn_s_setprio(3);
  if (!comp) {
#pragma unroll
    for (int c0 = 0; c0 < 2; ++c0) {
#pragma unroll
      for (int i = 0; i < 3; ++i) g[i] = *(const uint4*)(pr + (size_t)c0 * 16 * 384 + (size_t)(st_ + 256 * i) * 8);
#pragma unroll
      for (int i = 0; i < 3; ++i) scan_put(g[i], st_ + 256 * i, stage + c0 * 16 * 384);
    }
#pragma unroll
    for (int i = 0; i < 3; ++i) g[i] = *(const uint4*)(pr + (size_t)2 * 16 * 384 + (size_t)(st_ + 256 * i) * 8);
  }
  __syncthreads();
  float4 Pr0, Pw0, Pk0, Pa0, Pb0, Pr1, Pw1, Pk1, Pa1, Pb1; float Pv0, Pv1;
  {
    const float* sp = stage + 4 * kq; const float* vp = stage + 3 * 64 + 16 * rg + row;
    Pr0 = *(const float4*)(sp + 0 * 64); Pw0 = *(const float4*)(sp + 1 * 64); Pk0 = *(const float4*)(sp + 2 * 64); Pa0 = *(const float4*)(sp + 4 * 64); Pb0 = *(const float4*)(sp + 5 * 64); Pv0 = vp[0];
    sp += 384; vp += 384;
    Pr1 = *(const float4*)(sp + 0 * 64); Pw1 = *(const float4*)(sp + 1 * 64); Pk1 = *(const float4*)(sp + 2 * 64); Pa1 = *(const float4*)(sp + 4 * 64); Pb1 = *(const float4*)(sp + 5 * 64); Pv1 = vp[0];
  }
  int cur = 0;
  for (int ch = 0; ch < 128; ++ch) {
    if (comp) {
      int nxt = cur + 1; if (nxt == 3) nxt = 0;
      const float* st = stage + cur * 16 * 384 + 4 * kq;
      const float* sv = stage + cur * 16 * 384 + 3 * 64 + 16 * rg + row;
      const float* stn = stage + nxt * 16 * 384 + 4 * kq;
      const float* svn = stage + nxt * 16 * 384 + 3 * 64 + 16 * rg + row;
      float ykeep = 0.f, yp = 0.f;
#pragma unroll
      for (int s = 0; s < 16; ++s) {
        float4 cr, cw, ck, ca, cb; float cv;
        if (s & 1) { cr = Pr1; cw = Pw1; ck = Pk1; ca = Pa1; cb = Pb1; cv = Pv1; }
        else { cr = Pr0; cw = Pw0; ck = Pk0; ca = Pa0; cb = Pb0; cv = Pv0; }
        {
          const float* sp = (s < 14) ? (st + (s + 2) * 384) : (stn + (s - 14) * 384);
          const float* vp = (s < 14) ? (sv + (s + 2) * 384) : (svn + (s - 14) * 384);
          if (s & 1) { Pr1 = *(const float4*)(sp + 0 * 64); Pw1 = *(const float4*)(sp + 1 * 64); Pk1 = *(const float4*)(sp + 2 * 64); Pa1 = *(const float4*)(sp + 4 * 64); Pb1 = *(const float4*)(sp + 5 * 64); Pv1 = vp[0]; }
          else { Pr0 = *(const float4*)(sp + 0 * 64); Pw0 = *(const float4*)(sp + 1 * 64); Pk0 = *(const float4*)(sp + 2 * 64); Pa0 = *(const float4*)(sp + 4 * 64); Pb0 = *(const float4*)(sp + 5 * 64); Pv0 = vp[0]; }
        }
        const fv2 a01 = {ca.x, ca.y}, a23 = {ca.z, ca.w}, w01 = {cw.x, cw.y}, w23 = {cw.z, cw.w};
        const fv2 k01 = {ck.x, ck.y}, k23 = {ck.z, ck.w}, b01 = {cb.x, cb.y}, b23 = {cb.z, cb.w};
        const fv2 r01 = {cr.x, cr.y}, r23 = {cr.z, cr.w};
        const fv2 vv = {cv, cv};
        fv2 pa = S01 * a01; pa = __builtin_elementwise_fma(S23, a23, pa);
        float sa = pa.x + pa.y;
        const fv2 t01 = __builtin_elementwise_fma(S01, w01, vv * k01);
        const fv2 t23 = __builtin_elementwise_fma(S23, w23, vv * k23);
        if (s > 0) {
          sa = dpp_add(sa, 0); yp = dpp_add(yp, 0); sa = dpp_add(sa, 1); yp = dpp_add(yp, 1);
          sa = dpp_add(sa, 2); yp = dpp_add(yp, 2); sa = dpp_add(sa, 3); yp = dpp_add(yp, 3);
          ykeep = (kq == s - 1) ? yp : ykeep;
        } else {
          sa = row16_sum(sa);
        }
        const fv2 sav = {sa, sa};
        S01 = __builtin_elementwise_fma(sav, b01, t01);
        S23 = __builtin_elementwise_fma(sav, b23, t23);
        fv2 py = S01 * r01; py = __builtin_elementwise_fma(S23, r23, py);
        yp = py.x + py.y;
      }
      yp = row16_sum(yp);
      ykeep = (kq == 15) ? yp : ykeep;
      yr[((size_t)(b * 2048 + ch * 16 + kq)) * 256 + hd * 64 + 16 * rg + row] = f2bf(ykeep);
    } else {
      if (ch + 2 < 128) {
        int nb = cur + 2; if (nb >= 3) nb -= 3;
        float* dst = stage + nb * 16 * 384;
#pragma unroll
        for (int i = 0; i < 3; ++i) scan_put(g[i], st_ + 256 * i, dst);
      }
      if (ch + 3 < 128) {
        const bf16_t* src = pr + (size_t)(ch + 3) * 16 * 384;
#pragma unroll
        for (int i = 0; i < 3; ++i) g[i] = *(const uint4*)(src + (size_t)(st_ + 256 * i) * 8);
      }
    }
    __syncthreads();
    cur = (cur == 2) ? 0 : cur + 1;
  }
  __builtin_amdgcn_s_setprio(0);
  __syncthreads();
}

constexpr float SL2 = 0.125f * 1.4426950408889634f;

template <int MODE>
DI void attn_loop(const bf16_t* kb, long kstride, const bf16_t* vtb, long vstride, int jlo, int jhi,
                  const bf16x8 (&qf)[4], int qpos, unsigned sel, unsigned uni, int W, int qmin, int qmax,
                  f32x16 (&o)[2], float& m, float& l, bf16_t* Ks, bf16_t* Vs,
                  float* impw = nullptr, float* lastb = nullptr, float* mts = nullptr) {
  const int tid = tidx(), lane = tid & 63, h = lane >> 5, r31 = lane & 31;
  const int lr = tid >> 3, lc = (tid & 7) * 8;
  int j = jlo;
  if (MODE == 1) { while (j <= jhi && !((uni >> j) & 1)) ++j; }
  uint4 k0, v0;
  if (j <= jhi) {
    k0 = *(const uint4*)(kb + (long)(64 * j + lr) * kstride + lc);
    v0 = *(const uint4*)(vtb + (long)lr * vstride + 64 * j + lc);
  }
  while (j <= jhi) {
    __syncthreads();
    *(uint4*)(Ks + lr * LDT + lc) = k0;
    *(uint4*)(Vs + lr * LDT + lc) = v0;
    __syncthreads();
    int jn = j + 1;
    if (MODE == 1) { while (jn <= jhi && !((uni >> jn) & 1)) ++jn; }
    if (jn <= jhi) {
      k0 = *(const uint4*)(kb + (long)(64 * jn + lr) * kstride + lc);
      v0 = *(const uint4*)(vtb + (long)lr * vstride + 64 * jn + lc);
    }
    __builtin_amdgcn_sched_barrier(0);
    f32x16 s[2];
#pragma unroll
    for (int kt = 0; kt < 2; ++kt) {
#pragma unroll
      for (int e = 0; e < 16; ++e) s[kt][e] = 0.f;
#pragma unroll
      for (int si = 0; si < 4; ++si) {
        const bf16x8 fa = *(const bf16x8*)(Ks + (32 * kt + r31) * LDT + 16 * si + 8 * h);
        s[kt] = MFMA32(fa, qf[si], s[kt]);
      }
    }
    const bool selj = (MODE == 1) ? (((sel >> j) & 1) != 0) : true;
    const bool interior = (MODE == 1) ? (64 * j + 63 <= qmin) : (MODE == 2) ? ((64 * j + 63 <= qmin) && (qmax - 64 * j < W)) : false;
    float mx = -1e30f;
    if (interior) {
#pragma unroll
      for (int kt = 0; kt < 2; ++kt)
#pragma unroll
        for (int e = 0; e < 16; ++e) {
          const float v = (MODE == 1) ? (selj ? s[kt][e] : -1e30f) : s[kt][e];
          s[kt][e] = v; mx = fmaxf(mx, v);
        }
    } else {
#pragma unroll
      for (int kt = 0; kt < 2; ++kt)
#pragma unroll
        for (int e = 0; e < 16; ++e) {
          const int key = 64 * j + 32 * kt + crow(e, h);
          bool valid;
          if (MODE == 0) valid = (16 * key + 31 <= qpos);
          else if (MODE == 1) valid = selj && (key <= qpos);
          else valid = (key <= qpos) && (qpos - key < W);
          const float v = valid ? s[kt][e] : -1e30f;
          s[kt][e] = v; mx = fmaxf(mx, v);
        }
    }
    mx = xor32_max(mx);
    const float mnew = fmaxf(m, mx);
    const float alpha = __builtin_amdgcn_exp2f(m - mnew);
    m = mnew; l *= alpha;
    if (__builtin_amdgcn_ballot_w64(alpha != 1.f)) {
#pragma unroll
      for (int e = 0; e < 16; ++e) { o[0][e] *= alpha; o[1][e] *= alpha; }
    }
    if (interior && (MODE == 2 || mnew > -1e29f)) {
#pragma unroll
      for (int kt = 0; kt < 2; ++kt)
#pragma unroll
        for (int e = 0; e < 16; ++e) {
          const float pv = __builtin_amdgcn_exp2f(s[kt][e] - mnew);
          l += pv; s[kt][e] = pv;
        }
    } else {
#pragma unroll
      for (int kt = 0; kt < 2; ++kt)
#pragma unroll
        for (int e = 0; e < 16; ++e) {
          const float pv = (s[kt][e] > -1e29f) ? __builtin_amdgcn_exp2f(s[kt][e] - mnew) : 0.f;
          l += pv; s[kt][e] = pv;
        }
    }
    if (MODE == 0) {
      if (impw != nullptr) {
#pragma unroll
        for (int kt = 0; kt < 2; ++kt)
#pragma unroll
          for (int q = 0; q < 4; ++q) {
            impw[16 * j + 8 * kt + 2 * q + h] = (s[kt][4 * q] + s[kt][4 * q + 1]) + (s[kt][4 * q + 2] + s[kt][4 * q + 3]);
            lastb[(j * 8 + kt * 4 + q) * 512 + tid] = s[kt][4 * q + 3];
          }
        mts[j * 512 + tid] = mnew;
      }
    }
#pragma unroll
    for (int kt = 0; kt < 2; ++kt)
#pragma unroll
      for (int sp = 0; sp < 2; ++sp) {
        const bf16x8 fb = __builtin_bit_cast(bf16x8, make_uint4(pack2(s[kt][8 * sp + 0], s[kt][8 * sp + 1]), pack2(s[kt][8 * sp + 2], s[kt][8 * sp + 3]),
                                                               pack2(s[kt][8 * sp + 4], s[kt][8 * sp + 5]), pack2(s[kt][8 * sp + 6], s[kt][8 * sp + 7])));
#pragma unroll
        for (int dt = 0; dt < 2; ++dt) {
          const bf16_t* vr = Vs + (32 * dt + r31) * LDT + 32 * kt + 16 * sp + 4 * h;
          const uint2 lo = *(const uint2*)vr; const uint2 hi = *(const uint2*)(vr + 8);
          const bf16x8 fa = __builtin_bit_cast(bf16x8, make_uint4(lo.x, lo.y, hi.x, hi.y));
          o[dt] = MFMA32(fa, fb, o[dt]);
        }
      }
    j = jn;
  }
}

DI void scale_q(bf16x8 (&qf)[4]) {
#pragma unroll
  for (int s = 0; s < 4; ++s) {
    const uint4 t = __builtin_bit_cast(uint4, qf[s]);
    qf[s] = __builtin_bit_cast(bf16x8, make_uint4(pack2(bflo(t.x) * SL2, bfhi(t.x) * SL2), pack2(bflo(t.y) * SL2, bfhi(t.y) * SL2),
                                                  pack2(bflo(t.z) * SL2, bfhi(t.z) * SL2), pack2(bflo(t.w) * SL2, bfhi(t.w) * SL2)));
  }
}
DI void zero_o(f32x16 (&o)[2]) {
#pragma unroll
  for (int e = 0; e < 16; ++e) { o[0][e] = 0.f; o[1][e] = 0.f; }
}

DI void nsa_item(const Params& p, int l_, int item, char* smraw, bool wr = true) {
  const int qb = 31 - (item >> 4), bg = item & 15, b = bg >> 1, g = bg & 1;
  bf16_t* Ks = (bf16_t*)smraw; bf16_t* Vs = Ks + 64 * LDT;
  float* imp = (float*)(smraw + 18432);
  float* scs = (float*)(smraw + 18432 + 33792);
  unsigned* selm = (unsigned*)(smraw + 18432 + 33792 + 8448);
  const bf16_t* hb = (const bf16_t*)(WS(p) + O_H);
  bf16_t* hw = (bf16_t*)(WS(p) + O_H);
  const bf16_t* vt = (const bf16_t*)(WS(p) + O_VT);
  const int tid = tidx(), lane = tid & 63, w = (tid >> 6) & 3, qh = tid >> 8, h = lane >> 5, r31 = lane & 31;
  const int H = g * 4 + w;
  const int qpos = 64 * qb + 32 * qh + r31;
  const size_t mrow = (size_t)b * 2048 + qpos;
  const int cur = qb;
  bf16x8 qf[4];
#pragma unroll
  for (int s = 0; s < 4; ++s) qf[s] = *(const bf16x8*)(hb + mrow * HS + C_AQ + H * 64 + 16 * s + 8 * h);
  scale_q(qf);
  const float g0 = sigmoidf_(bf2f(hb[mrow * HS + C_GATE + 0 * 8 + H]));
  const float g1 = sigmoidf_(bf2f(hb[mrow * HS + C_GATE + 1 * 8 + H]));
  const float g2 = sigmoidf_(bf2f(hb[mrow * HS + C_GATE + 2 * 8 + H]));
  f32x16 ot[2], o[2];
  float m, l;
  zero_o(o); m = -1e30f; l = 0.f;
  const int lo_ = 64 * qb - 511;
  const int jlo = (lo_ <= 0) ? 0 : (lo_ >> 6);
  attn_loop<2>(hb + (size_t)b * 2048 * HS + C_KW + g * 64, HS, vt + ((size_t)((1 * 8 + b) * 128 + g * 64)) * 2048, 2048, jlo, cur, qf, qpos, 0u, 0u, 512, 64 * qb, 64 * qb + 63, o, m, l, Ks, Vs);
  float lt = xor32_sum(l);
  float inv = (lt > 0.f) ? 1.f / lt : 0.f;
#pragma unroll
  for (int e = 0; e < 16; ++e) { ot[0][e] = g2 * inv * o[0][e]; ot[1][e] = g2 * inv * o[1][e]; }
  {
    int* seen = (int*)(smraw + DYN_XB + 20);
    if (*seen == 0) {
      if (tid == 0) {
        const int* cd = (const int*)(WS(p) + O_CNT) + 4 + l_;
        unsigned spins = 0;
        while (__hip_atomic_load(cd, __ATOMIC_RELAXED, __HIP_MEMORY_SCOPE_AGENT) < 32 && ++spins < (1u << 22)) __builtin_amdgcn_s_sleep(2);
      }
      __syncthreads();
      __builtin_amdgcn_fence(__ATOMIC_ACQUIRE, "agent");
      if (tid == 0) *seen = 1;
      __syncthreads();
    }
  }
  const bf16_t* kcb = (const bf16_t*)(WS(p) + O_KC) + (size_t)bg * 128 * 64;
  const bf16_t* vcb = (const bf16_t*)(WS(p) + O_VCT) + (size_t)bg * 64 * 128;
  const int ntile = (4 * qb + 3 + 63) >> 6;
  zero_o(o); m = -1e30f; l = 0.f;
  float* impw = imp + (w * 64 + 32 * qh + r31) * 33;
  float* lastb = (float*)(smraw + 61440);
  float* mts = (float*)(smraw + 61440 + 32768);
  if (cur >= 16) attn_loop<0>(kcb, 64, vcb, 128, 0, ntile - 1, qf, qpos, 0u, 0u, 0, 64 * qb, 64 * qb + 63, o, m, l, Ks, Vs, impw, lastb, mts);
  else attn_loop<0>(kcb, 64, vcb, 128, 0, ntile - 1, qf, qpos, 0u, 0u, 0, 64 * qb, 64 * qb + 63, o, m, l, Ks, Vs);
  lt = xor32_sum(l);
  inv = (lt > 0.f) ? 1.f / lt : 0.f;
#pragma unroll
  for (int e = 0; e < 16; ++e) { ot[0][e] += g0 * inv * o[0][e]; ot[1][e] += g0 * inv * o[1][e]; }
  unsigned sel, uni;
  if (cur < 16) {
    sel = (1u << (cur + 1)) - 1u; uni = sel;
  } else {
    {
      const float f0 = __builtin_amdgcn_exp2f(mts[tid] - m) * inv, f1 = __builtin_amdgcn_exp2f(mts[512 + tid] - m) * inv;
#pragma unroll
      for (int jt = 0; jt < 2; ++jt)
#pragma unroll
        for (int kt = 0; kt < 2; ++kt)
#pragma unroll
          for (int q = 0; q < 4; ++q) impw[16 * jt + 8 * kt + 2 * q + h] *= (jt ? f1 : f0);
      __syncthreads();
#pragma unroll
      for (int jt = 0; jt < 2; ++jt)
#pragma unroll
        for (int kt = 0; kt < 2; ++kt)
#pragma unroll
          for (int q = 0; q < 4; ++q) {
            const int j1 = 16 * jt + 8 * kt + 2 * q + h + 1;
            if (j1 < 32) impw[j1] += lastb[(jt * 8 + kt * 4 + q) * 512 + tid] * (jt ? f1 : f0);
          }
      __syncthreads();
    }
    {
      const int ql = tid >> 3, jj = tid & 7;
#pragma unroll
      for (int e = 0; e < 4; ++e) {
        const int j = jj * 4 + e;
        float sc;
        if (j == 0 || j == cur || j == cur - 1) sc = 1e9f;
        else if (j <= cur) sc = ((imp[(0 * 64 + ql) * 33 + j] + imp[(1 * 64 + ql) * 33 + j]) + imp[(2 * 64 + ql) * 33 + j]) + imp[(3 * 64 + ql) * 33 + j];
        else sc = -1e9f;
        scs[ql * 33 + j] = sc;
      }
      if (tid < 65) selm[tid] = 0u;
    }
    __syncthreads();
    {
      const int ql = tid >> 3, jj = tid & 7;
      unsigned bits = 0u;
#pragma unroll
      for (int e = 0; e < 4; ++e) {
        const int j = jj * 4 + e;
        const float my = scs[ql * 33 + j];
        int rank = 0;
#pragma unroll
        for (int j2 = 0; j2 < 32; ++j2) {
          const float o2 = scs[ql * 33 + j2];
          rank += (o2 > my || (o2 == my && j2 < j)) ? 1 : 0;
        }
        if (rank < 16) bits |= (1u << j);
      }
      atomicOr(&selm[ql], bits);
      atomicOr(&selm[64], bits);
    }
    __syncthreads();
    sel = selm[32 * qh + r31]; uni = selm[64];
  }
  zero_o(o); m = -1e30f; l = 0.f;
  if (cur < 16)
    attn_loop<2>(hb + (size_t)b * 2048 * HS + C_KS + g * 64, HS, vt + ((size_t)((0 * 8 + b) * 128 + g * 64)) * 2048, 2048, 0, cur, qf, qpos, 0u, 0u, 1 << 30, 64 * qb, 64 * qb + 63, o, m, l, Ks, Vs);
  else
  attn_loop<1>(hb + (size_t)b * 2048 * HS + C_KS + g * 64, HS, vt + ((size_t)((0 * 8 + b) * 128 + g * 64)) * 2048, 2048, 0, cur, qf, qpos, sel, uni, 0, 64 * qb, 64 * qb + 63, o, m, l, Ks, Vs);
  lt = xor32_sum(l);
  inv = (lt > 0.f) ? 1.f / lt : 0.f;
#pragma unroll
  for (int e = 0; e < 16; ++e) { ot[0][e] += g1 * inv * o[0][e]; ot[1][e] += g1 * inv * o[1][e]; }
#pragma unroll
  for (int dt = 0; dt < 2; ++dt)
#pragma unroll
    for (int q = 0; q < 4; ++q) {
      const int d = 32 * dt + 8 * q + 4 * h;
      bf16_t* zp = hw + mrow * HS + C_AZ + H * 64 + d;
      const uint2 z = *(const uint2*)zp;
      uint2 ov;
      ov.x = pack2(ot[dt][4 * q] * siluf_(bflo(z.x)), ot[dt][4 * q + 1] * siluf_(bfhi(z.x)));
      ov.y = pack2(ot[dt][4 * q + 2] * siluf_(bflo(z.y)), ot[dt][4 * q + 3] * siluf_(bfhi(z.y)));
      if (wr) *(uint2*)zp = ov;
    }
  __syncthreads();
}

DI void swa_item(const Params& p, int l_, int item, char* smraw, bool wr = true) {
  const int qb = 15 - (item >> 4), bg = item & 15, b = bg >> 1, g = bg & 1;
  bf16_t* Ks = (bf16_t*)smraw; bf16_t* Vs = Ks + 64 * LDT;
  const bf16_t* hb = (const bf16_t*)(WS(p) + O_H);
  bf16_t* hw = (bf16_t*)(WS(p) + O_H);
  const bf16_t* vt = (const bf16_t*)(WS(p) + O_VT);
  const int tid = tidx(), lane = tid & 63, w = tid >> 6, h = lane >> 5, r31 = lane & 31;
  const int H = g * 2 + (w & 1);
  const int qpos = 128 * qb + 32 * (w >> 1) + r31;
  const size_t mrow = (size_t)b * 2048 + qpos;
  bf16x8 qf[4];
#pragma unroll
  for (int s = 0; s < 4; ++s) qf[s] = *(const bf16x8*)(hb + mrow * HS + C_BQ + H * 64 + 16 * s + 8 * h);
  scale_q(qf);
  const float sink = IN(10)[l_ * 4 + H] * 1.4426950408889634f;
  f32x16 o[2];
  zero_o(o);
  float m = sink, l = (h == 0) ? 1.f : 0.f;
  const int jlo = (qb >= 1) ? 2 * qb - 2 : 0;
  attn_loop<2>(hb + (size_t)b * 2048 * HS + C_BK + g * 64, HS, vt + ((size_t)((2 * 8 + b) * 128 + g * 64)) * 2048, 2048, jlo, 2 * qb + 1, qf, qpos, 0u, 0u, 128, 128 * qb, 128 * qb + 127, o, m, l, Ks, Vs);
  const float lt = xor32_sum(l);
  const float inv = (lt > 0.f) ? 1.f / lt : 0.f;
#pragma unroll
  for (int dt = 0; dt < 2; ++dt)
#pragma unroll
    for (int q = 0; q < 4; ++q) {
      const int d = 32 * dt + 8 * q + 4 * h;
      bf16_t* zp = hw + mrow * HS + C_BZ + H * 64 + d;
      const uint2 z = *(const uint2*)zp;
      uint2 ov;
      ov.x = pack2(inv * o[dt][4 * q] * siluf_(bflo(z.x)), inv * o[dt][4 * q + 1] * siluf_(bfhi(z.x)));
      ov.y = pack2(inv * o[dt][4 * q + 2] * siluf_(bflo(z.y)), inv * o[dt][4 * q + 3] * siluf_(bfhi(z.y)));
      if (wr) *(uint2*)zp = ov;
    }
  __syncthreads();
}

DI void rwkv_post(const Params& p, int l) {
  const int lane = tidx() & 63, hd = (tidx() >> 6) & 3, sub = tidx() >> 8;
  const bf16_t* yr = (const bf16_t*)(WS(p) + O_YR);
  const bf16_t* pr = (const bf16_t*)(WS(p) + O_PR);
  const float* bon = (const float*)(WS(p) + O_BON);
  bf16_t* hw = (bf16_t*)(WS(p) + O_H);
  const float lw = IN(19)[l * 256 + hd * 64 + lane], lb = IN(20)[l * 256 + hd * 64 + lane];
  for (int it = bidx(); it < NTOK / 16; it += gridDim.x) {
    float y[8], v[8], z[8], bo[8];
#pragma unroll
    for (int q = 0; q < 8; ++q) {
      const size_t m = (size_t)it * 16 + sub * 8 + q;
      const int b = (int)(m >> 11), t = (int)(m & 2047);
      y[q] = bf2f(yr[m * 256 + hd * 64 + lane]);
      v[q] = bf2f(pr[((size_t)((b * 4 + hd) * 2048 + t)) * 384 + 3 * 64 + lane]);
      z[q] = bf2f(hw[m * HS + C_CZ + hd * 64 + lane]);
      bo[q] = bon[m * 4 + hd];
    }
#pragma unroll
    for (int q = 0; q < 8; ++q) {
      const size_t m = (size_t)it * 16 + sub * 8 + q;
      const float mean = wave_sum_fast(y[q]) * (1.f / 64.f);
      const float dlt = y[q] - mean;
      const float var = wave_sum_fast(dlt * dlt) * (1.f / 64.f);
      float o = dlt * rsqrtf(var + 64e-5f) * lw + lb + bo[q] * v[q];
      o *= siluf_(z[q]);
      hw[m * HS + C_CZ + hd * 64 + lane] = f2bf(o);
    }
  }
}

struct EpiP {
  static constexpr bool PERM = true, AFTER_DRAIN = false;
  char* scr;
  DI void operator()(const f32x4 (&acc)[2][2][4][2], const Unit&, int, int, int, int) const {
    char* sb = scr; asm volatile("" : "+s"(sb));
    const unsigned toff = (unsigned)tidx() * 16u;
#pragma unroll
    for (int ai = 0; ai < 2; ++ai)
#pragma unroll
      for (int m = 0; m < 4; ++m)
#pragma unroll
        for (int bj = 0; bj < 2; ++bj) *(u32x4*)(sb + (size_t)(((ai * 4 + m) * 2 + bj) * 8192) + toff) = pack8(acc[ai][bj][m][0], acc[ai][bj][m][1]);
  }
};
struct EpiMix {
  static constexpr bool PERM = true, AFTER_DRAIN = false;
  const char* scr; bf16_t* mixed; const float* bias; int first;
  DI void operator()(const f32x4 (&acc)[2][2][4][2], const Unit& u, int wr, int wc, int fr, int fq) const {
    const int row0 = u.pm * BM + wr * 64 + fr, col0 = u.pn * BM + wc * 32 + 8 * fq;
    const char* sb = scr; asm volatile("" : "+s"(sb));
    const unsigned toff = (unsigned)tidx() * 16u;
#pragma unroll
    for (int ai = 0; ai < 2; ++ai)
#pragma unroll
      for (int mp = 0; mp < 2; ++mp) {
        u32x4 pv[2][2], ov[2][2];
        f32x4 bv[2][2];
#pragma unroll
        for (int bj = 0; bj < 2; ++bj)
#pragma unroll
          for (int n = 0; n < 2; ++n) bv[bj][n] = *(const f32x4*)(bias + col0 + bj * HALF + 4 * n);
#pragma unroll
        for (int mm = 0; mm < 2; ++mm)
#pragma unroll
          for (int bj = 0; bj < 2; ++bj) {
            const int m = mp * 2 + mm;
            pv[mm][bj] = *(const u32x4*)(sb + (size_t)(((ai * 4 + m) * 2 + bj) * 8192) + toff);
            ov[mm][bj] = (u32x4){0u, 0u, 0u, 0u};
            if (!first) ov[mm][bj] = *(const u32x4*)(mixed + (size_t)(row0 + ai * HALF + m * 16) * 1024 + col0 + bj * HALF);
          }
#pragma unroll
        for (int mm = 0; mm < 2; ++mm)
#pragma unroll
          for (int bj = 0; bj < 2; ++bj) {
            const int m = mp * 2 + mm;
            const f32x4 g0 = acc[ai][bj][m][0] + bv[bj][0], g1 = acc[ai][bj][m][1] + bv[bj][1];
            const u32x4 p_ = pv[mm][bj], o_ = ov[mm][bj];
            u32x4 w;
            w.x = pack2(bflo(o_.x) + sigmoidf_(g0[0]) * bflo(p_.x), bfhi(o_.x) + sigmoidf_(g0[1]) * bfhi(p_.x));
            w.y = pack2(bflo(o_.y) + sigmoidf_(g0[2]) * bflo(p_.y), bfhi(o_.y) + sigmoidf_(g0[3]) * bfhi(p_.y));
            w.z = pack2(bflo(o_.z) + sigmoidf_(g1[0]) * bflo(p_.z), bfhi(o_.z) + sigmoidf_(g1[1]) * bfhi(p_.z));
            w.w = pack2(bflo(o_.w) + sigmoidf_(g1[2]) * bflo(p_.w), bfhi(o_.w) + sigmoidf_(g1[3]) * bfhi(p_.w));
            *(u32x4*)(mixed + (size_t)(row0 + ai * HALF + m * 16) * 1024 + col0 + bj * HALF) = w;
          }
      }
  }
};
struct Sub5 { const char* A; const char* B; int nt; int isP; };
DI Sub5 p5_sub(int i, const Unit& u, const bf16_t* hb, const bf16_t* xn, const bf16_t* wtm, const bf16_t* wtp) {
  const int br = i >> 1;
  Sub5 s;
  if (!(i & 1)) {
    const int zc = (br == 0) ? C_AZ : (br == 1) ? C_BZ : C_CZ;
    const int kof = (br == 0) ? 0 : (br == 1) ? 512 : 768;
    s.A = (const char*)(hb + zc + (size_t)u.pm * BM * HS);
    s.B = (const char*)(wtp + kof + (size_t)u.pn * BM * 1024);
    s.nt = (br == 0) ? 8 : 4; s.isP = 1;
  } else {
    s.A = (const char*)(xn + (size_t)u.pm * BM * 1024);
    s.B = (const char*)(wtm + ((size_t)br * 1024 + (size_t)u.pn * BM) * 1024);
    s.nt = 16; s.isP = 0;
  }
  return s;
}
DI void gemm_phase_p5(LAS unsigned char* lds, const Unit u, const bf16_t* hb, const bf16_t* xn, const bf16_t* wtm, const bf16_t* wtp,
                      char* scr, bf16_t* mixed, const float* bmerge) {
    const int tid = tidx(), wid = __builtin_amdgcn_readfirstlane(tid >> 6), lane = tid & 63, wr = wid >> 2, wc = wid & 3, fr = lane & 15, fq = lane >> 4;
    unsigned rowA, col2;
    { int R, C; stage_rc(tid * 16, R, C); rowA = (unsigned)R; col2 = (unsigned)C * 2u; }
#define PG8_ROWB ((rowA & ~31u) + (unsigned)perm32((int)(rowA & 31u)))
    const unsigned ldX = 1024u * 2u, ldH = (unsigned)HS * 2u;
    const size_t kstep = (size_t)(BK * 2);
    const size_t hstepB = (size_t)HALF * 1024 * 2, hsX = (size_t)HALF * 1024 * 2, hsH = (size_t)HALF * HS * 2;
    const unsigned ldsw = (unsigned)wid * 1024u;
    const int aoff = lds_byte(wr * 64 + fr, fq * 8), boff = lds_byte(wc * 32 + fr, fq * 8);
#define PG8_SA(b, h) (((b) * 2 + (h)) * HTB)
#define PG8_SB(b, h) ((4 + (b) * 2 + (h)) * HTB)
#define PG8_STAGE2(bufoff, gbase, row_, ld_) do { const unsigned v0__ = (row_) * (ld_) + col2;         __builtin_amdgcn_global_load_lds((const unsigned*)((const char*)(gbase) + v0__), (LAS unsigned*)(lds + (bufoff) + ldsw), 16, 0, 0);         __builtin_amdgcn_global_load_lds((const unsigned*)((const char*)(gbase) + (size_t)(64u * (ld_)) + v0__), (LAS unsigned*)(lds + (bufoff) + ldsw + 8192), 16, 0, 0); } while (0)
#define PG8_LDA(dst, b, h) do { _Pragma("unroll") for (int m = 0; m < 4; ++m) _Pragma("unroll") for (int k = 0; k < 2; ++k) dst[m][k] = *(const LAS bf16x8*)(lds + PG8_SA(b, h) + aoff + m * 2048 + k * 1024); } while (0)
#define PG8_LDB(dst, b, h) do { _Pragma("unroll") for (int n = 0; n < 2; ++n) _Pragma("unroll") for (int k = 0; k < 2; ++k) dst[n][k] = *(const LAS bf16x8*)(lds + PG8_SB(b, h) + boff + n * 2048 + k * 1024); } while (0)
#define PG8_MMA(ai, bj, At, Bt) do { __builtin_amdgcn_s_setprio(1); _Pragma("unroll") for (int m = 0; m < 4; ++m) _Pragma("unroll") for (int n = 0; n < 2; ++n) _Pragma("unroll") for (int k = 0; k < 2; ++k)         acc[ai][bj][m][n] = __builtin_amdgcn_mfma_f32_16x16x32_bf16(Bt[n][k], At[m][k], acc[ai][bj][m][n], 0, 0, 0); __builtin_amdgcn_s_setprio(0); } while (0)
#define PG8_WAIT_V(n) asm volatile("s_waitcnt vmcnt(" #n ")" ::: "memory")
#define PG8_WAIT_L(n) asm volatile("s_waitcnt lgkmcnt(" #n ")" ::: "memory")
#define PG8_BAR __builtin_amdgcn_s_barrier()
#define PG8_SCHED __builtin_amdgcn_sched_barrier(0)
    Sub5 cur = p5_sub(0, u, hb, xn, wtm, wtp), nxt;
    f32x4 acc[2][2][4][2];
#pragma unroll
    for (int a = 0; a < 2; ++a)
#pragma unroll
        for (int b = 0; b < 2; ++b)
#pragma unroll
            for (int m = 0; m < 4; ++m)
#pragma unroll
                for (int n = 0; n < 2; ++n) acc[a][b][m][n] = (f32x4){0.f, 0.f, 0.f, 0.f};
    bf16x8 At[4][2], B0[2][2], B1[2][2];
    unsigned ldc = cur.isP ? ldH : ldX;
    size_t hsc = cur.isP ? hsH : hsX;
    PG8_STAGE2(PG8_SB(0, 0), cur.B, PG8_ROWB, ldX); PG8_STAGE2(PG8_SA(0, 0), cur.A, rowA, ldc);
    PG8_STAGE2(PG8_SB(0, 1), cur.B + hstepB, PG8_ROWB, ldX); PG8_STAGE2(PG8_SA(0, 1), cur.A + hsc, rowA, ldc);
    if (wr == 1) PG8_BAR;
    PG8_WAIT_V(4); PG8_BAR;
    PG8_STAGE2(PG8_SB(1, 0), cur.B + kstep, PG8_ROWB, ldX); PG8_STAGE2(PG8_SA(1, 0), cur.A + kstep, rowA, ldc);
    PG8_STAGE2(PG8_SB(1, 1), cur.B + hstepB + kstep, PG8_ROWB, ldX);
    PG8_WAIT_V(6); PG8_BAR;
#pragma unroll 1
    for (int ui = 0;; ++ui) {
        const bool has_next = ui < 5;
        nxt = has_next ? p5_sub(ui + 1, u, hb, xn, wtm, wtp) : cur;
        const unsigned ldn = nxt.isP ? ldH : ldX;
        const size_t hsn = nxt.isP ? hsH : hsX;
        const int nt = cur.nt;
#pragma unroll 1
        for (int t = 0; t < nt; t += 2) {
            const bool last = (t == nt - 2);
            const char* a1 = cur.A + (size_t)(t + 1) * kstep;
            const char* a2 = last ? nxt.A : cur.A + (size_t)(t + 2) * kstep; const char* b2 = last ? nxt.B : cur.B + (size_t)(t + 2) * kstep;
            const unsigned ld2 = last ? ldn : ldc; const size_t hs2 = last ? hsn : hsc;
            const char* a3 = a2 + kstep; const char* b3 = b2 + kstep;
            PG8_LDB(B0, 0, 0); PG8_SCHED; PG8_LDA(At, 0, 0); PG8_STAGE2(PG8_SA(1, 1), a1 + hsc, rowA, ldc);
            PG8_WAIT_L(8); PG8_BAR; PG8_WAIT_L(0); PG8_MMA(0, 0, At, B0); PG8_BAR; PG8_SCHED;
            PG8_LDB(B1, 0, 1); PG8_STAGE2(PG8_SB(0, 0), b2, PG8_ROWB, ldX);
            PG8_BAR; PG8_WAIT_L(0); PG8_MMA(0, 1, At, B1); PG8_BAR;
            PG8_LDA(At, 0, 1); PG8_STAGE2(PG8_SA(0, 0), a2, rowA, ld2);
            PG8_BAR; PG8_WAIT_L(0); PG8_MMA(1, 0, At, B0); PG8_BAR; PG8_SCHED;
            PG8_STAGE2(PG8_SB(0, 1), b2 + hstepB, PG8_ROWB, ldX);
            PG8_WAIT_V(6); PG8_BAR; PG8_MMA(1, 1, At, B1); PG8_BAR;
            PG8_LDB(B0, 1, 0); PG8_SCHED; PG8_LDA(At, 1, 0); PG8_STAGE2(PG8_SA(0, 1), a2 + hs2, rowA, ld2);
            PG8_WAIT_L(8); PG8_BAR; PG8_WAIT_L(0); PG8_MMA(0, 0, At, B0); PG8_BAR; PG8_SCHED;
            PG8_LDB(B1, 1, 1); PG8_STAGE2(PG8_SB(1, 0), b3, PG8_ROWB, ldX);
            PG8_BAR; PG8_WAIT_L(0); PG8_MMA(0, 1, At, B1); PG8_BAR;
            PG8_LDA(At, 1, 1); PG8_STAGE2(PG8_SA(1, 0), a3, rowA, ld2);
            PG8_BAR; PG8_WAIT_L(0); PG8_MMA(1, 0, At, B0); PG8_BAR; PG8_SCHED;
            PG8_STAGE2(PG8_SB(1, 1), b3 + hstepB, PG8_ROWB, ldX);
            PG8_WAIT_V(6); PG8_BAR; PG8_MMA(1, 1, At, B1); PG8_BAR;
        }
        PG8_SCHED;
        {
          const int t2 = tidx(), fr2 = t2 & 15, fq2 = (t2 & 63) >> 4;
          if (cur.isP) { EpiP E{scr}; E(acc, u, wr, wc, fr2, fq2); }
          else { const int br = ui >> 1; EpiMix E{scr, mixed, bmerge + br * 1024, br == 0 ? 1 : 0}; E(acc, u, wr, wc, fr2, fq2); }
        }
        PG8_SCHED;
        if (!has_next) break;
#pragma unroll
        for (int a = 0; a < 2; ++a)
#pragma unroll
            for (int b = 0; b < 2; ++b)
#pragma unroll
                for (int m = 0; m < 4; ++m)
#pragma unroll
                    for (int n = 0; n < 2; ++n) acc[a][b][m][n] = (f32x4){0.f, 0.f, 0.f, 0.f};
        cur = nxt; ldc = ldn; hsc = hsn;
    }
    PG8_WAIT_V(0);
    if (wr == 0) PG8_BAR;
    PG8_BAR;
#undef PG8_SA
#undef PG8_SB
#undef PG8_STAGE2
#undef PG8_ROWB
#undef PG8_LDA
#undef PG8_LDB
#undef PG8_MMA
#undef PG8_WAIT_V
#undef PG8_WAIT_L
#undef PG8_BAR
#undef PG8_SCHED
}
DI void phase5(const Params& p, int l, char* smraw) {
  const bf16_t* xn = (const bf16_t*)(WS(p) + O_XN);
  const bf16_t* hb = (const bf16_t*)(WS(p) + O_H);
  const bf16_t* wtm = (const bf16_t*)(WS(p) + O_WTM);
  const bf16_t* wtp = (const bf16_t*)(WS(p) + O_WTP);
  bf16_t* mixed = (bf16_t*)(WS(p) + O_PR);
  const int blk = bidx();
  char* sbase = (blk < 128) ? (WS(p) + O_PR + (size_t)NTOK * 1024 * 2 + (size_t)blk * 131072)
              : (blk < 224) ? (WS(p) + O_VT + (size_t)(blk - 128) * 131072)
                            : (WS(p) + O_YR + (size_t)(blk - 224) * 131072);
  char* scr = sbase;
  StaticOrder S; S.init(NTOK, 1024, gridDim.x, bidx());
  Unit u;
  for (int i = 0; S.next(i, u); ++i)
    gemm_phase_p5((LAS unsigned char*)smraw, u, hb, xn, wtm, wtp, scr, mixed, IN(3) + l * 3072);
}

struct EpiRes {
  static constexpr bool PERM = false, AFTER_DRAIN = false;
  const float* X; float* O;
  DI void operator()(const f32x4 (&acc)[2][2][4][2], const Unit& u, int wr, int wc, int fr, int fq) const {
    const int row0 = u.pm * BM + wr * 64 + fr, col0 = u.pn * BM + wc * 32 + 4 * fq;
#pragma unroll
    for (int ai = 0; ai < 2; ++ai)
#pragma unroll
      for (int mp = 0; mp < 2; ++mp) {
        f32x4 xv[2][2][2];
#pragma unroll
        for (int mm = 0; mm < 2; ++mm)
#pragma unroll
          for (int bj = 0; bj < 2; ++bj)
#pragma unroll
            for (int n = 0; n < 2; ++n)
              xv[mm][bj][n] = *(const f32x4*)(X + (size_t)(row0 + ai * HALF + (mp * 2 + mm) * 16) * 1024 + col0 + bj * HALF + n * 16);
#pragma unroll
        for (int mm = 0; mm < 2; ++mm)
#pragma unroll
          for (int bj = 0; bj < 2; ++bj)
#pragma unroll
            for (int n = 0; n < 2; ++n)
              *(f32x4*)(O + (size_t)(row0 + ai * HALF + (mp * 2 + mm) * 16) * 1024 + col0 + bj * HALF + n * 16) = xv[mm][bj][n] + acc[ai][bj][mp * 2 + mm][n];
      }
  }
};
DI void phase6(const Params& p, int l, char* smraw) {
  Gemm g{(const bf16_t*)(WS(p) + O_PR), (const bf16_t*)(WS(p) + O_WTO), 1024, 1024, 1024};
  StaticOrder S; S.init(NTOK, 1024, gridDim.x, bidx());
  EpiRes E{(l == 0) ? IN(0) : OUTP(), OUTP()};
  gemm_phase<EpiRes, StaticOrder>((LAS unsigned char*)smraw, g, S, E);
}

#define XB_TMO      128
#define XB_XCNT(j)  (256  + 64 * (j))
#define XB_XSUB(j)  (1280 + 64 * (j))
#define XB_XGEN(j)  (2304 + 64 * (j))
#define XB_TOP      3328
#define XB_TOPGEN   3392
#define XCD_BAR_WORDS 3456
#define XB_SPIN_CAP (1u << 18)

__device__ __forceinline__ unsigned xb_ld(unsigned* p)              { return __hip_atomic_load(p, __ATOMIC_RELAXED, __HIP_MEMORY_SCOPE_AGENT); }
__device__ __forceinline__ unsigned xb_add(unsigned* p, unsigned v) { return __hip_atomic_fetch_add(p, v, __ATOMIC_RELAXED, __HIP_MEMORY_SCOPE_AGENT); }
__device__ __forceinline__ unsigned xb_xcc_id() { return (unsigned)__builtin_amdgcn_s_getreg((3 << 11) | 20) & 0xFu; }
#define XB_SPIN(cond, bar) do { unsigned _sp = 0; while (cond) { __builtin_amdgcn_s_sleep(1); \
    if ((++_sp & 255u) == 0u) { if (xb_ld(&(bar)[XB_TMO])) break; if (_sp > XB_SPIN_CAP) { atomicAdd(&(bar)[XB_TMO], 1u); break; } } } } while (0)

struct XcdBarrier {
    unsigned* bar; unsigned x;
    volatile LAS unsigned* st;
};

__device__ __forceinline__ XcdBarrier xcd_barrier_post(unsigned* bar, volatile LAS unsigned* st) {
    XcdBarrier b; b.bar = bar; b.x = xb_xcc_id(); b.st = st;
    if (tidx() == 0) (void)xb_add(&bar[XB_XCNT(b.x)], 1u);
    return b;
}
__device__ __forceinline__ void xcd_barrier_complete(unsigned* bar, unsigned x, unsigned& nloc, unsigned& nx) {
    const unsigned G = gridDim.x * gridDim.y * gridDim.z;
    unsigned sum, cnt, mine, sp = 0u;
    for (;;) {
        sum = 0u; cnt = 0u; mine = 0u;
#pragma unroll
        for (unsigned j = 0; j < 16; ++j) { const unsigned c = xb_ld(&bar[XB_XCNT(j)]); sum += c; cnt += (c > 0u) ? 1u : 0u; mine = (j == x) ? c : mine; }
        if (sum == G) break;
        __builtin_amdgcn_s_sleep(1);
        if ((++sp & 255u) == 0u) { if (xb_ld(&bar[XB_TMO])) break; if (sp > XB_SPIN_CAP) { atomicAdd(&bar[XB_TMO], 1u); break; } }
    }
    nloc = mine > 0u ? mine : 1u; nx = cnt > 0u ? cnt : 1u;
}

__device__ __forceinline__ void xcd_barrier(const XcdBarrier& b) {
    asm volatile("s_waitcnt vmcnt(0)" ::: "memory");
    __syncthreads();
    if (tidx() == 0) {
        unsigned* bar = b.bar; asm volatile("" : "+s"(bar));
        __builtin_amdgcn_s_waitcnt(0);
        unsigned nloc = b.st[0], nx = b.st[1];
        if (nloc == 0u) { xcd_barrier_complete(bar, b.x, nloc, nx); b.st[0] = nloc; b.st[1] = nx; }
        const unsigned old = xb_add(&bar[XB_XSUB(b.x)], 1u);
        const unsigned gen = old / nloc;
        if (old + 1u == (gen + 1u) * nloc) {
            __builtin_amdgcn_fence(__ATOMIC_RELEASE, "agent");
            asm volatile("s_waitcnt vmcnt(0)" ::: "memory");
            const unsigned og = xb_add(&bar[XB_TOP], 1u);
            const unsigned tg = og / nx;
            if (og + 1u == (tg + 1u) * nx) xb_add(&bar[XB_TOPGEN], 1u);
            else XB_SPIN(xb_ld(&bar[XB_TOPGEN]) == tg, bar);
            __builtin_amdgcn_fence(__ATOMIC_ACQUIRE, "agent");
            xb_add(&bar[XB_XGEN(b.x)], 1u);
            asm volatile("s_waitcnt vmcnt(0)" ::: "memory");
        } else {
            XB_SPIN(xb_ld(&bar[XB_XGEN(b.x)]) == gen, bar);
            __builtin_amdgcn_fence(__ATOMIC_ACQUIRE, "agent");
            asm volatile("s_waitcnt vmcnt(0)" ::: "memory");
        }
    }
    __syncthreads();
}


__global__ void __launch_bounds__(512, 2) fwd_megakernel(Params p) {
  cg::grid_group grid = cg::this_grid();
  extern __shared__ __attribute__((aligned(16))) char smraw[];
  uint4* xb_words = (uint4*)(smraw + DYN_XB);
  int* s_item = (int*)(smraw + DYN_XB + 16);
  if (tidx() == 0) *xb_words = make_uint4(0u, 0u, 0u, 0u);
  __syncthreads();
  XcdBarrier xb = xcd_barrier_post((unsigned*)(WS(p) + O_BAR), (volatile LAS unsigned*)xb_words);
  if (WS(p) == nullptr) grid.sync();
  unsigned long long tacc = 0ull, t0 = 0ull;
#define TB(k) do { if (PROBE_T == (k)) t0 = __builtin_amdgcn_s_memrealtime(); } while (0)
#define TE(k) do { if (PROBE_T == (k)) tacc += __builtin_amdgcn_s_memrealtime() - t0; } while (0)
  for (int l = 0; l < 2; ++l) {
    TB(10);
    phase0(p, l, smraw);
    xcd_barrier(xb);
    TE(10); TB(11);
    phase1(p, smraw);
    xcd_barrier(xb);
    TE(11); TB(12);
    for (int it = bidx(); it < 256; it += gridDim.x) rwkv_prep(p, l, it, smraw);
    xcd_barrier(xb);
    TE(12); TB(13); TB(18);
    {
      int* cnt = (int*)(WS(p) + O_CNT) + l;
      if (tidx() == 0) *(int*)(smraw + DYN_XB + 20) = 0;
      __syncthreads();
      for (int it = bidx(); it < 128; it += gridDim.x) rwkv_scan(p, it, smraw);
      TE(18);
      while (true) {
        if (tidx() == 0) *s_item = atomicAdd(cnt, 1);
        __syncthreads();
        const int item = *s_item;
        __syncthreads();
        if (item >= 32 + 512 + 256) break;
        if (item < 32) compress_tile2(p, l, item, smraw);
        else if (item < 32 + 256) swa_item(p, l, item - 32, smraw);
        else nsa_item(p, l, item - 32 - 256, smraw);
      }
      TB(19);
    }
    xcd_barrier(xb);
    TE(13); TE(19); TB(14);
    rwkv_post(p, l);
    xcd_barrier(xb);
    TE(14); TB(15);
    phase5(p, l, smraw);
    xcd_barrier(xb);
    TE(15); TB(16);
    phase6(p, l, smraw);
    xcd_barrier(xb);
    TE(16);
  }
  TB(17);
  rmsnorm_rows(OUTP(), IN(28), nullptr, OUTP());
  TE(17);
  if (PROBE_T && bidx() == 0) {
    asm volatile("s_waitcnt vmcnt(0)" ::: "memory");
    __syncthreads();
    if (tidx() == 0) atomicAdd(OUTP(), 0.04f + (float)tacc * 0.01f * PROBE_TSCALE);
  }
}

extern "C" void kernel_launch(void* const* d_in, const int* in_sizes, int n_in, void* d_out, int out_size, void* d_ws,
                              size_t ws_size, hipStream_t stream) {
  static int grid_blocks = 0;
  if (!grid_blocks) {
    int dev = 0, cus = 0, per_cu = 0;
    (void)hipGetDevice(&dev);
    (void)hipDeviceGetAttribute(&cus, hipDeviceAttributeMultiprocessorCount, dev);
    if (hipFuncSetAttribute((const void*)fwd_megakernel, hipFuncAttributeMaxDynamicSharedMemorySize, DYN_LDS) != hipSuccess) {
      fprintf(stderr, "hipFuncSetAttribute failed\n"); grid_blocks = -1;
    } else {
      (void)hipOccupancyMaxActiveBlocksPerMultiprocessor(&per_cu, (const void*)fwd_megakernel, 512, DYN_LDS);
      if (per_cu > 1) per_cu = 1;
      grid_blocks = (cus * per_cu) & ~7;
      if (grid_blocks > 256) grid_blocks = 256;
    }
  }
  if (ws_size < WS_TOTAL || grid_blocks < 8) {
    fprintf(stderr, "workspace too small or grid too small: %zu < %zu, grid %d\n", ws_size, (size_t)WS_TOTAL, grid_blocks);
    return;
  }
  Params p{};
  for (int i = 0; i < 29; ++i) p.in[i] = (const float*)d_in[i];
  p.out = (float*)d_out;
  p.ws = (char*)d_ws;
  (void)hipMemsetAsync((char*)d_ws + O_BAR, 0, 16384, stream);
  void* args[] = {&p};
  hipError_t e = hipLaunchCooperativeKernel((void*)fwd_megakernel, dim3(grid_blocks), dim3(512), args, DYN_LDS, stream);
  if (e != hipSuccess) fprintf(stderr, "cooperative launch failed: %s (grid %d)\n", hipGetErrorString(e), grid_blocks);
}
```

```cpp
#include <hip/hip_runtime.h>
#include <hip/hip_cooperative_groups.h>
#include <cstdio>
namespace cg = cooperative_groups;

#define DI __device__ __forceinline__
typedef unsigned short bf16_t;
typedef short bf16x8 __attribute__((ext_vector_type(8)));
typedef short s16x4 __attribute__((ext_vector_type(4)));
typedef float f32x16 __attribute__((ext_vector_type(16)));
typedef float f32x4 __attribute__((ext_vector_type(4)));
typedef unsigned u32x4 __attribute__((ext_vector_type(4)));
#define LAS __attribute__((address_space(3)))
typedef __bf16 bfv2 __attribute__((ext_vector_type(2)));
typedef float fv2 __attribute__((ext_vector_type(2)));
#define MFMA32(a, b, c) __builtin_amdgcn_mfma_f32_32x32x16_bf16((a), (b), (c), 0, 0, 0)

DI unsigned pack2(float a, float b) { fv2 v = {a, b}; return __builtin_bit_cast(unsigned, __builtin_convertvector(v, bfv2)); }
DI bf16_t f2bf(float a) { return (bf16_t)(pack2(a, 0.f) & 0xffffu); }
DI float bflo(unsigned u) { return __uint_as_float(u << 16); }
DI float bfhi(unsigned u) { return __uint_as_float(u & 0xffff0000u); }
DI float bf2f(bf16_t u) { return __uint_as_float(((unsigned)u) << 16); }
DI float sigmoidf_(float x) { return __builtin_amdgcn_rcpf(1.f + __expf(-x)); }
DI float siluf_(float x) { return x * __builtin_amdgcn_rcpf(1.f + __expf(-x)); }
DI int tidx() { int t = threadIdx.x; asm volatile("" : "+v"(t)); return t; }
DI int bidx() { int b = blockIdx.x; asm volatile("" : "+s"(b)); return b; }
DI float xor32_sum(float x) { auto r = __builtin_amdgcn_permlane32_swap(__float_as_uint(x), __float_as_uint(x), false, false); return __uint_as_float(r[0]) + __uint_as_float(r[1]); }
DI float xor32_max(float x) { auto r = __builtin_amdgcn_permlane32_swap(__float_as_uint(x), __float_as_uint(x), false, false); return fmaxf(__uint_as_float(r[0]), __uint_as_float(r[1])); }
DI float xor16_sum(float x) { auto r = __builtin_amdgcn_permlane16_swap(__float_as_uint(x), __float_as_uint(x), false, false); return __uint_as_float(r[0]) + __uint_as_float(r[1]); }
DI float fdpp_add(float x, const int sel) {
  int xi = __float_as_int(x), yi;
  if (sel == 0) yi = __builtin_amdgcn_update_dpp(0, xi, 0xB1, 0xF, 0xF, true);
  else if (sel == 1) yi = __builtin_amdgcn_update_dpp(0, xi, 0x4E, 0xF, 0xF, true);
  else if (sel == 2) yi = __builtin_amdgcn_update_dpp(0, xi, 0x141, 0xF, 0xF, true);
  else yi = __builtin_amdgcn_update_dpp(0, xi, 0x140, 0xF, 0xF, true);
  return x + __int_as_float(yi);
}
DI float wave_sum_fast(float v) { v = fdpp_add(v, 0); v = fdpp_add(v, 1); v = fdpp_add(v, 2); v = fdpp_add(v, 3); v = xor16_sum(v); return xor32_sum(v); }
DI int crow(int i, int h) { return (i & 3) + 8 * (i >> 2) + 4 * h; }

constexpr int T_ = 2048, NTOK = 16384, HS = 3840, NIN = 6808;
constexpr int C_AQ = 0, C_KC = 512, C_VC = 640, C_KS = 768, C_KW = 1024, C_AZ = 1280, C_BQ = 1792, C_BK = 2048,
              C_BZ = 2304, C_R = 2560, C_K = 2816, C_V = 3072, C_WD = 3328, C_CZ = 3456, C_GATE = 3712;

constexpr size_t al256(size_t x) { return (x + 255) & ~(size_t)255; }
constexpr size_t O_WTA = 0;
constexpr size_t O_WTM = O_WTA + (size_t)3840 * 1024 * 2;
constexpr size_t O_WTP = O_WTM + (size_t)3072 * 1024 * 2;
constexpr size_t O_WTO = O_WTP + (size_t)1024 * 1024 * 2;
constexpr size_t O_W1K = O_WTO + (size_t)1024 * 1024 * 2;
constexpr size_t O_W1V = O_W1K + (size_t)128 * 2048 * 2;
constexpr size_t O_W2K = O_W1V + (size_t)128 * 2048 * 2;
constexpr size_t O_W2V = O_W2K + (size_t)64 * 128 * 2;
constexpr size_t O_PEB = O_W2V + (size_t)64 * 128 * 2;
constexpr size_t O_LW2 = O_PEB + 1024;
constexpr size_t O_LA2 = O_LW2 + 256 * 64 * 2;
constexpr size_t O_V1T = O_LA2 + 256 * 64 * 2;
constexpr size_t O_V2T = O_V1T + 32 * 256 * 2;
constexpr size_t O_CNT = O_V2T + 256 * 32 * 2;
constexpr size_t O_BAR = O_CNT + 256;
constexpr size_t O_XN = O_BAR + 16384;
constexpr size_t O_H = O_XN + (size_t)NTOK * 1024 * 2;
constexpr size_t O_VT = O_H + (size_t)NTOK * HS * 2;
constexpr size_t O_KC = O_VT + (size_t)3 * 8 * 2 * 64 * 2048 * 2;
constexpr size_t O_VCT = O_KC + (size_t)16 * 128 * 64 * 2;
constexpr size_t O_VF = O_VCT + (size_t)16 * 128 * 64 * 2;
constexpr size_t O_YR = O_VF + (size_t)NTOK * 256 * 2;
constexpr size_t O_BON = O_YR + (size_t)NTOK * 256 * 2;
constexpr size_t O_PR = O_BON + (size_t)NTOK * 4 * 4;
constexpr size_t WS_TOTAL = O_PR + (size_t)NTOK * 4 * 384 * 2;

#ifndef PROBE
#define PROBE 0
#define PROBE_T 0
#define PROBE_TSCALE 0.0001f
#endif
struct Params {
  const float* in[29];
  float* out;
  char* ws;
};

typedef const __attribute__((address_space(4))) char* kaptr_t;
DI kaptr_t KA() { kaptr_t k = (kaptr_t)__builtin_amdgcn_kernarg_segment_ptr(); asm volatile("" : "+s"(k)); return k; }
DI const float* IN(int i) { return *(const float* const __attribute__((address_space(4)))*)(KA() + 8 * i); }
DI float* OUTP() { return *(float* const __attribute__((address_space(4)))*)(KA() + 8 * 29); }
DI char* WS(const Params&) { return *(char* const __attribute__((address_space(4)))*)(KA() + 8 * 30); }
constexpr int SMEM_BYTES = 73728;
constexpr int DYN_XB = 155648;
constexpr int DYN_LDS = DYN_XB + 64;
constexpr int LDT = 72;

#define G_LOAD(P, ao_, bo_) do { const long ao__ = (ao_); const int bo__ = (bo_); \
  P##a0 = *(const uint4*)(a0 + ao__); P##a1 = *(const uint4*)(a1 + ao__); P##a2 = *(const uint4*)(a2 + ao__); P##a3 = *(const uint4*)(a3 + ao__); \
  P##b0 = *(const uint4*)(b0 + bo__); P##b1 = *(const uint4*)(b1 + bo__); P##b2 = *(const uint4*)(b2 + bo__); P##b3 = *(const uint4*)(b3 + bo__); } while (0)
#define G_STORE(P, A_, B_) do { bf16_t* A__ = (A_); bf16_t* B__ = (B_); \
  *(uint4*)(A__ + (wr)*LDT + wc) = P##a0; *(uint4*)(A__ + (wr + 32) * LDT + wc) = P##a1; \
  *(uint4*)(A__ + (wr + 64) * LDT + wc) = P##a2; *(uint4*)(A__ + (wr + 96) * LDT + wc) = P##a3; \
  *(uint4*)(B__ + (wr)*LDT + wc) = P##b0; *(uint4*)(B__ + (wr + 32) * LDT + wc) = P##b1; \
  *(uint4*)(B__ + (wr + 64) * LDT + wc) = P##b2; *(uint4*)(B__ + (wr + 96) * LDT + wc) = P##b3; } while (0)
DI void g_compute(f32x16 (&acc)[2][2], const bf16_t* A_, const bf16_t* B_) {
  __builtin_amdgcn_s_setprio(1);
#pragma unroll
  for (int s = 0; s < 4; ++s) {
    bf16x8 fa0 = *(const bf16x8*)(A_ + 16 * s);
    bf16x8 fa1 = *(const bf16x8*)(A_ + 32 * LDT + 16 * s);
    bf16x8 fb0 = *(const bf16x8*)(B_ + 16 * s);
    bf16x8 fb1 = *(const bf16x8*)(B_ + 32 * LDT + 16 * s);
    acc[0][0] = MFMA32(fa0, fb0, acc[0][0]);
    acc[0][1] = MFMA32(fa0, fb1, acc[0][1]);
    acc[1][0] = MFMA32(fa1, fb0, acc[1][0]);
    acc[1][1] = MFMA32(fa1, fb1, acc[1][1]);
  }
  __builtin_amdgcn_s_setprio(0);
}
DI void gemm_core(f32x16 (&acc)[2][2], const bf16_t* a0, const bf16_t* a1, const bf16_t* a2, const bf16_t* a3, long aks,
                  const bf16_t* b0, const bf16_t* b1, const bf16_t* b2, const bf16_t* b3, int KT, bf16_t* sm, int tid) {
  const int lane = tid & 63, w = tid >> 6, wm = w >> 1, wn = w & 1, h = lane >> 5, r31 = lane & 31;
  bf16_t* As = sm;
  bf16_t* Bs = sm + 2 * 128 * LDT;
  const int wr = (tid >> 3), wc = (tid & 7) * 8;
#pragma unroll
  for (int i = 0; i < 2; ++i)
#pragma unroll
    for (int j = 0; j < 2; ++j)
#pragma unroll
      for (int e = 0; e < 16; ++e) acc[i][j][e] = 0.f;
  uint4 pa0, pa1, pa2, pa3, pb0, pb1, pb2, pb3, qa0, qa1, qa2, qa3, qb0, qb1, qb2, qb3;
  G_LOAD(p, 0, 0);
  G_LOAD(q, aks, 64);
  __syncthreads();
  G_STORE(p, As, Bs);
  __syncthreads();
  const int aoff = (wm * 64 + r31) * LDT + 8 * h, boff = (wn * 64 + r31) * LDT + 8 * h;
  for (int kt = 0; kt < KT; kt += 2) {
    if (kt + 2 < KT) G_LOAD(p, (long)(kt + 2) * aks, (kt + 2) * 64);
    __builtin_amdgcn_sched_barrier(0);
    g_compute(acc, As + aoff, Bs + boff);
    __builtin_amdgcn_sched_barrier(0);
    G_STORE(q, As + 128 * LDT, Bs + 128 * LDT);
    __syncthreads();
    if (kt + 3 < KT) G_LOAD(q, (long)(kt + 3) * aks, (kt + 3) * 64);
    __builtin_amdgcn_sched_barrier(0);
    g_compute(acc, As + 128 * LDT + aoff, Bs + 128 * LDT + boff);
    __builtin_amdgcn_sched_barrier(0);
    if (kt + 2 < KT) G_STORE(p, As, Bs);
    __syncthreads();
  }
}


constexpr int BM = 256, BK = 64, HALF = 128, HTB = HALF * BK * 2, STAGE_BYTES = 8 * HTB, NXCD = 8, WGM = 8;
DI int lds_byte(int r, int c) { const int st = (r >> 4) * 2 + (c >> 5), rr = r & 15, cc = c & 31, ob = rr * 64 + cc * 2; return st * 1024 + (ob ^ (((ob >> 9) & 1) << 5)); }
DI void stage_rc(int b, int& R, int& C) { const int st = b / 1024, sb = b % 1024, swz = sb ^ (((sb >> 9) & 1) << 5); R = (st >> 1) * 16 + swz / 64; C = (st & 1) * 32 + (swz % 64) / 2; }
DI int perm32(int rho) { const int n = rho >> 4, i = rho & 15; return 8 * (i >> 2) + 4 * n + (i & 3); }
struct Unit { int pm, pn; };
struct Gemm { const bf16_t* A; const bf16_t* Bt; int lda, ldb, K; };
struct StaticOrder {
    int nM, nN, nwg, G, c;
    DI void init(int M, int N, int G_, int c_) { nM = M / BM; nN = N / BM; nwg = nM * nN; G = G_; c = c_; }
    DI bool next(int i, Unit& u) const {
        const long L = (long)i * G + c; if (L >= nwg) return false;
        int wgid = (int)L; { const int q = nwg / NXCD, r = nwg % NXCD, xcd = wgid % NXCD, off = wgid / NXCD; wgid = (xcd < r ? xcd * (q + 1) : r * (q + 1) + (xcd - r) * q) + off; }
        const int nig = WGM * nN, gid = wgid / nig, fm = gid * WGM, gsz = (nM - fm) < WGM ? (nM - fm) : WGM;
        u.pm = fm + ((wgid % nig) % gsz); u.pn = (wgid % nig) / gsz; return true;
    }
    DI void a_ready(const Unit&) const {}
    DI void done(const Unit&) const {}
};
struct OneUnit { Unit u; DI bool next(int i, Unit& o) const { if (i) return false; o = u; return true; } DI void a_ready(const Unit&) const {} DI void done(const Unit&) const {} };
template <class Epi, class Sched>
DI void gemm_phase(LAS unsigned char* lds, const Gemm g, const Sched& S, const Epi& E) {
    const int tid = tidx(), wid = __builtin_amdgcn_readfirstlane(tid >> 6), lane = tid & 63, wr = wid >> 2, wc = wid & 3, fr = lane & 15, fq = lane >> 4;
    const int K = g.K, nt = K / BK;
    unsigned voffA[2], voffB[2];
#pragma unroll
    for (int i = 0; i < 2; ++i) { int R, C; stage_rc(tid * 16 + i * 8192, R, C); const int Rb = Epi::PERM ? ((R & ~31) + perm32(R & 31)) : R;
        voffA[i] = (unsigned)(R * g.lda + C) * 2u; voffB[i] = (unsigned)(Rb * g.ldb + C) * 2u; }
    const size_t kstep = (size_t)(BK * 2);
    const size_t hstepA = (size_t)HALF * g.lda * 2, hstepB = (size_t)HALF * g.ldb * 2;
    const size_t tstepA = 2 * hstepA, tstepB = 2 * hstepB;
    const unsigned ldsw = (unsigned)wid * 1024u;
    const int aoff = lds_byte(wr * 64 + fr, fq * 8), boff = lds_byte(wc * 32 + fr, fq * 8);
#define PG8_SA(b, h) (((b) * 2 + (h)) * HTB)
#define PG8_SB(b, h) ((4 + (b) * 2 + (h)) * HTB)
#define PG8_STAGE(bufoff, gbase, voff) do { _Pragma("unroll") for (int _i = 0; _i < 2; ++_i) \
        __builtin_amdgcn_global_load_lds((const unsigned*)((const char*)(gbase) + (voff)[_i]), (LAS unsigned*)(lds + (bufoff) + ldsw + _i * 8192), 16, 0, 0); } while (0)
#define PG8_LDA(dst, b, h) do { _Pragma("unroll") for (int m = 0; m < 4; ++m) _Pragma("unroll") for (int k = 0; k < 2; ++k) dst[m][k] = *(const LAS bf16x8*)(lds + PG8_SA(b, h) + aoff + m * 2048 + k * 1024); } while (0)
#define PG8_LDB(dst, b, h) do { _Pragma("unroll") for (int n = 0; n < 2; ++n) _Pragma("unroll") for (int k = 0; k < 2; ++k) dst[n][k] = *(const LAS bf16x8*)(lds + PG8_SB(b, h) + boff + n * 2048 + k * 1024); } while (0)
#define PG8_MMA(ai, bj, At, Bt) do { __builtin_amdgcn_s_setprio(1); _Pragma("unroll") for (int m = 0; m < 4; ++m) _Pragma("unroll") for (int n = 0; n < 2; ++n) _Pragma("unroll") for (int k = 0; k < 2; ++k) \
        acc[ai][bj][m][n] = __builtin_amdgcn_mfma_f32_16x16x32_bf16(Bt[n][k], At[m][k], acc[ai][bj][m][n], 0, 0, 0); __builtin_amdgcn_s_setprio(0); } while (0)
#define PG8_WAIT_V(n) asm volatile("s_waitcnt vmcnt(" #n ")" ::: "memory")
#define PG8_WAIT_L(n) asm volatile("s_waitcnt lgkmcnt(" #n ")" ::: "memory")
#define PG8_BAR __builtin_amdgcn_s_barrier()
#define PG8_SCHED __builtin_amdgcn_sched_barrier(0)
    Unit cur, nxt; int ui = 0;
    if (!S.next(0, cur)) return;
    f32x4 acc[2][2][4][2];
#pragma unroll
    for (int a = 0; a < 2; ++a)
#pragma unroll
        for (int b = 0; b < 2; ++b)
#pragma unroll
            for (int m = 0; m < 4; ++m)
#pragma unroll
                for (int n = 0; n < 2; ++n) acc[a][b][m][n] = (f32x4){0.f, 0.f, 0.f, 0.f};
    bf16x8 At[4][2], B0[2][2], B1[2][2];
    const char* cA = (const char*)g.A + (size_t)cur.pm * tstepA; const char* cB = (const char*)g.Bt + (size_t)cur.pn * tstepB;
    S.a_ready(cur);
    PG8_STAGE(PG8_SB(0, 0), cB, voffB); PG8_STAGE(PG8_SA(0, 0), cA, voffA); PG8_STAGE(PG8_SB(0, 1), cB + hstepB, voffB); PG8_STAGE(PG8_SA(0, 1), cA + hstepA, voffA);
    if (wr == 1) PG8_BAR;
    PG8_WAIT_V(4); PG8_BAR;
    PG8_STAGE(PG8_SB(1, 0), cB + kstep, voffB); PG8_STAGE(PG8_SA(1, 0), cA + kstep, voffA); PG8_STAGE(PG8_SB(1, 1), cB + hstepB + kstep, voffB);
    PG8_WAIT_V(6); PG8_BAR;
    for (;;) {
        const bool has_next = S.next(ui + 1, nxt);
        const char* nA = has_next ? (const char*)g.A + (size_t)nxt.pm * tstepA : cA; const char* nB = has_next ? (const char*)g.Bt + (size_t)nxt.pn * tstepB : cB;
        for (int t = 0; t < nt; t += 2) {
            const bool last = (t == nt - 2);
            const char* a1 = cA + (size_t)(t + 1) * kstep;
            const char* a2 = last ? nA : cA + (size_t)(t + 2) * kstep; const char* b2 = last ? nB : cB + (size_t)(t + 2) * kstep;
            const char* a3 = a2 + kstep; const char* b3 = b2 + kstep;
            if (last && has_next) S.a_ready(nxt);
            PG8_LDB(B0, 0, 0); PG8_SCHED; PG8_LDA(At, 0, 0); PG8_STAGE(PG8_SA(1, 1), a1 + hstepA, voffA);
            PG8_WAIT_L(8); PG8_BAR; PG8_WAIT_L(0); PG8_MMA(0, 0, At, B0); PG8_BAR; PG8_SCHED;
            PG8_LDB(B1, 0, 1); PG8_STAGE(PG8_SB(0, 0), b2, voffB);
            PG8_BAR; PG8_WAIT_L(0); PG8_MMA(0, 1, At, B1); PG8_BAR;
            PG8_LDA(At, 0, 1); PG8_STAGE(PG8_SA(0, 0), a2, voffA);
            PG8_BAR; PG8_WAIT_L(0); PG8_MMA(1, 0, At, B0); PG8_BAR; PG8_SCHED;
            PG8_STAGE(PG8_SB(0, 1), b2 + hstepB, voffB);
            PG8_WAIT_V(6); PG8_BAR; PG8_MMA(1, 1, At, B1); PG8_BAR;
            PG8_LDB(B0, 1, 0); PG8_SCHED; PG8_LDA(At, 1, 0); PG8_STAGE(PG8_SA(0, 1), a2 + hstepA, voffA);
            PG8_WAIT_L(8); PG8_BAR; PG8_WAIT_L(0); PG8_MMA(0, 0, At, B0); PG8_BAR; PG8_SCHED;
            PG8_LDB(B1, 1, 1); PG8_STAGE(PG8_SB(1, 0), b3, voffB);
            PG8_BAR; PG8_WAIT_L(0); PG8_MMA(0, 1, At, B1); PG8_BAR;
            PG8_LDA(At, 1, 1); PG8_STAGE(PG8_SA(1, 0), a3, voffA);
            PG8_BAR; PG8_WAIT_L(0); PG8_MMA(1, 0, At, B0); PG8_BAR; PG8_SCHED;
            PG8_STAGE(PG8_SB(1, 1), b3 + hstepB, voffB);
            PG8_WAIT_V(6); PG8_BAR; PG8_MMA(1, 1, At, B1); PG8_BAR;
        }
        if constexpr (!Epi::AFTER_DRAIN) { E(acc, cur, wr, wc, fr, fq); S.done(cur); }
        if (!has_next) break;
#pragma unroll
        for (int a = 0; a < 2; ++a)
#pragma unroll
            for (int b = 0; b < 2; ++b)
#pragma unroll
                for (int m = 0; m < 4; ++m)
#pragma unroll
                    for (int n = 0; n < 2; ++n) acc[a][b][m][n] = (f32x4){0.f, 0.f, 0.f, 0.f};
        cur = nxt; cA = nA; cB = nB; ++ui;
    }
    PG8_WAIT_V(0);
    if (wr == 0) PG8_BAR;
    PG8_BAR;
    if constexpr (Epi::AFTER_DRAIN) { E.fused(acc, cur, wr, wc, fr, fq, lds, wid, lane); S.done(cur); }
#undef PG8_SA
#undef PG8_SB
#undef PG8_STAGE
#undef PG8_LDA
#undef PG8_LDB
#undef PG8_MMA
#undef PG8_WAIT_V
#undef PG8_WAIT_L
#undef PG8_BAR
#undef PG8_SCHED
}

struct TJob { const float* src; int ld; int mode; bf16_t* dst; int ldd; int ntn; int ntk; };

DI TJob get_job(int j, const Params& p, int l) {
  char* ws = WS(p);
  TJob t;
  switch (j) {
    case 0: t = {IN(2) + (size_t)l * 1024 * NIN, NIN, 1, (bf16_t*)(ws + O_WTA), 1024, 60, 16}; break;
    case 1: t = {IN(2) + (size_t)l * 1024 * NIN + 3736, NIN, 0, (bf16_t*)(ws + O_WTM), 1024, 48, 16}; break;
    case 2: t = {IN(24) + (size_t)l * 512 * 1024, 1024, 0, (bf16_t*)(ws + O_WTP), 1024, 16, 8}; break;
    case 3: t = {IN(25) + (size_t)l * 256 * 1024, 1024, 0, (bf16_t*)(ws + O_WTP) + 512, 1024, 16, 4}; break;
    case 4: t = {IN(26) + (size_t)l * 256 * 1024, 1024, 0, (bf16_t*)(ws + O_WTP) + 768, 1024, 16, 4}; break;
    case 5: t = {IN(27) + (size_t)l * 1024 * 1024, 1024, 0, (bf16_t*)(ws + O_WTO), 1024, 16, 16}; break;
    case 6: t = {IN(5) + (size_t)l * 2048 * 128, 128, 0, (bf16_t*)(ws + O_W1K), 2048, 2, 32}; break;
    case 7: t = {IN(8) + (size_t)l * 2048 * 128, 128, 0, (bf16_t*)(ws + O_W1V), 2048, 2, 32}; break;
    case 8: t = {IN(6) + (size_t)l * 128 * 64, 64, 0, (bf16_t*)(ws + O_W2K), 128, 1, 2}; break;
    case 9: t = {IN(9) + (size_t)l * 128 * 64, 64, 0, (bf16_t*)(ws + O_W2V), 128, 1, 2}; break;
    case 10: t = {IN(13) + (size_t)l * 64 * 256, 256, 0, (bf16_t*)(ws + O_LW2), 64, 4, 1}; break;
    default: t = {IN(15) + (size_t)l * 64 * 256, 256, 0, (bf16_t*)(ws + O_LA2), 64, 4, 1}; break;
  }
  return t;
}

struct TrTile { TJob jb; int n0, k0; bool valid; };
DI TrTile tr_find(const Params& p, int l, int id) {
  TrTile t; t.valid = id < 2380;
  int rem = t.valid ? id : 0;
  t.jb = get_job(0, p, l);
  for (int j = 0; j < 12; ++j) {
    t.jb = get_job(j, p, l);
    const int cnt = t.jb.ntn * t.jb.ntk;
    if (rem < cnt) break;
    rem -= cnt;
  }
  t.n0 = (rem / t.jb.ntk) * 64; t.k0 = (rem % t.jb.ntk) * 64;
  return t;
}
DI void tr_load(const TrTile& t, int tid, float4 (&r)[4]) {
  const int n4 = (tid & 15) * 4;
  const int c = t.n0 + n4;
  int oc = c; bool cv = t.valid;
  if (t.jb.mode == 1) {
    if (c < 1280) oc = c; else if (c < 3712) oc = c + 24; else if (c < 3736) oc = c - 3712 + 1280; else { oc = 0; cv = false; }
  }
#pragma unroll
  for (int pz = 0; pz < 4; ++pz) {
    const int kk = (tid >> 4) + 16 * pz;
    r[pz] = make_float4(0.f, 0.f, 0.f, 0.f);
    if (cv) r[pz] = *(const float4*)(t.jb.src + (size_t)(t.k0 + kk) * t.jb.ld + oc);
  }
}
DI void tr_put(float* tile, int tid, const float4 (&r)[4]) {
  const int n4 = (tid & 15) * 4;
#pragma unroll
  for (int pz = 0; pz < 4; ++pz) {
    const int kk = (tid >> 4) + 16 * pz;
    tile[kk * 65 + n4 + 0] = r[pz].x; tile[kk * 65 + n4 + 1] = r[pz].y; tile[kk * 65 + n4 + 2] = r[pz].z; tile[kk * 65 + n4 + 3] = r[pz].w;
  }
}
DI void tr_store(const TrTile& t, const float* tile, int tid) {
  if (t.valid) {
#pragma unroll
    for (int pz = 0; pz < 2; ++pz) {
      const int q = tid + 256 * pz;
      const int nn = q >> 3, kc = (q & 7) * 8;
      uint4 o;
      o.x = pack2(tile[(kc + 0) * 65 + nn], tile[(kc + 1) * 65 + nn]);
      o.y = pack2(tile[(kc + 2) * 65 + nn], tile[(kc + 3) * 65 + nn]);
      o.z = pack2(tile[(kc + 4) * 65 + nn], tile[(kc + 5) * 65 + nn]);
      o.w = pack2(tile[(kc + 6) * 65 + nn], tile[(kc + 7) * 65 + nn]);
      *(uint4*)(t.jb.dst + (size_t)(t.n0 + nn) * t.jb.ldd + t.k0 + kc) = o;
    }
  }
}

DI float wave_sum(float v) {
#pragma unroll
  for (int o = 32; o > 0; o >>= 1) v += __shfl_xor(v, o, 64);
  return v;
}

DI void rmsnorm_rows(const float* x, const float* g, bf16_t* outb, float* outf) {
  const int lane = tidx() & 63, w = tidx() >> 6;
  for (int it = bidx(); it < NTOK / 16; it += gridDim.x) {
    float4 v[2][4]; float ss[2] = {0.f, 0.f};
#pragma unroll
    for (int rr = 0; rr < 2; ++rr) {
      const float* xr = x + (size_t)(it * 16 + rr * 8 + w) * 1024;
#pragma unroll
      for (int i = 0; i < 4; ++i) v[rr][i] = *(const float4*)(xr + lane * 4 + 256 * i);
    }
    float4 gg[4];
#pragma unroll
    for (int i = 0; i < 4; ++i) gg[i] = *(const float4*)(g + lane * 4 + 256 * i);
#pragma unroll
    for (int rr = 0; rr < 2; ++rr) {
#pragma unroll
      for (int i = 0; i < 4; ++i) ss[rr] += v[rr][i].x * v[rr][i].x + v[rr][i].y * v[rr][i].y + v[rr][i].z * v[rr][i].z + v[rr][i].w * v[rr][i].w;
      ss[rr] = wave_sum_fast(ss[rr]);
    }
#pragma unroll
    for (int rr = 0; rr < 2; ++rr) {
      const int row = it * 16 + rr * 8 + w;
      const float rs = rsqrtf(ss[rr] * (1.f / 1024.f) + 1e-6f);
#pragma unroll
      for (int i = 0; i < 4; ++i) {
        const float o0 = v[rr][i].x * rs * gg[i].x, o1 = v[rr][i].y * rs * gg[i].y, o2 = v[rr][i].z * rs * gg[i].z, o3 = v[rr][i].w * rs * gg[i].w;
        if (outf) { *(float4*)(outf + (size_t)row * 1024 + lane * 4 + 256 * i) = make_float4(o0, o1, o2, o3); }
        else { uint2 o; o.x = pack2(o0, o1); o.y = pack2(o2, o3); *(uint2*)(outb + (size_t)row * 1024 + lane * 4 + 256 * i) = o; }
      }
    }
  }
}

DI void phase0(const Params& p, int l, char* smraw) {
  const int half = tidx() >> 8, ltid = tidx() & 255;
  float* tile = (float*)(smraw + half * 17408);
  {
    int id0 = bidx() * 2;
    TrTile cur = tr_find(p, l, id0 + half);
    float4 rg[4];
    tr_load(cur, ltid, rg);
    while (id0 < 2380) {
      tr_put(tile, ltid, rg);
      __syncthreads();
      const int id1 = id0 + gridDim.x * 2;
      TrTile nxt = tr_find(p, l, id1 + half);
      if (id1 < 2380) tr_load(nxt, ltid, rg);
      tr_store(cur, tile, ltid);
      __syncthreads();
      cur = nxt; id0 = id1;
    }
  }
  const float* xin = (l == 0) ? IN(0) : OUTP();
  rmsnorm_rows(xin, IN(1) + l * 1024, (bf16_t*)(WS(p) + O_XN), nullptr);
  const int gtid = bidx() * 512 + tidx(), nth = gridDim.x * 512;
  if (l == 1) {
    bf16_t* v1t = (bf16_t*)(WS(p) + O_V1T); bf16_t* v2t = (bf16_t*)(WS(p) + O_V2T);
    const float* v1 = IN(22); const float* v2 = IN(23);
    for (int idx = gtid; idx < 8192; idx += nth) {
      { const int j = idx >> 8, c = idx & 255; v1t[idx] = f2bf(v1[c * 32 + j]); }
      { const int c = idx >> 5, j = idx & 31; v2t[idx] = f2bf(v2[j * 256 + c]); }
    }
  }
  {
    bf16_t* kc = (bf16_t*)(WS(p) + O_KC); bf16_t* vct = (bf16_t*)(WS(p) + O_VCT);
    for (int idx = gtid; idx < 1024; idx += nth) {
      const int bg = idx >> 6, d = idx & 63;
      kc[(bg * 128 + 127) * 64 + d] = 0; vct[(bg * 64 + d) * 128 + 127] = 0;
    }
    if (gtid == 0) { ((int*)(WS(p) + O_CNT))[l] = 0; }
    if (gtid == 1) { ((int*)(WS(p) + O_CNT))[4 + l] = 0; }
  }
  {
    const int lane = tidx() & 63, gw = bidx() * 8 + (tidx() >> 6), nw = gridDim.x * 8;
    float* peb = (float*)(WS(p) + O_PEB);
    for (int o = gw; o < 256; o += nw) {
      const int which = o >> 7, n = o & 127;
      const float* pe = (which ? IN(7) : IN(4)) + (size_t)l * 2048;
      const float* w1 = (which ? IN(8) : IN(5)) + (size_t)l * 2048 * 128;
      float s = 0.f;
      float pa[32], pb[32];
#pragma unroll
      for (int i = 0; i < 32; ++i) { const int k = lane + 64 * i; pa[i] = pe[k]; pb[i] = w1[(size_t)k * 128 + n]; }
#pragma unroll
      for (int i = 0; i < 32; ++i) s += pa[i] * pb[i];
      s = wave_sum(s);
      if (lane == 0) peb[o] = s;
    }
  }
}

DI u32x4 pack8(const f32x4& a, const f32x4& b) {
  u32x4 w; w.x = pack2(a[0], a[1]); w.y = pack2(a[2], a[3]); w.z = pack2(b[0], b[1]); w.w = pack2(b[2], b[3]); return w;
}
struct EpiH {
  static constexpr bool PERM = true, AFTER_DRAIN = false;
  bf16_t* H; bf16_t* VT;
  DI void operator()(const f32x4 (&acc)[2][2][4][2], const Unit& u, int wr, int wc, int fr, int fq) const {
    const int row0 = u.pm * BM + wr * 64 + fr;
    const int cl = wc * 32 + 8 * fq;
    const int which = (u.pn == 3) ? 0 : (u.pn == 4) ? 1 : (u.pn == 8) ? 2 : -1;
#pragma unroll
    for (int ai = 0; ai < 2; ++ai)
#pragma unroll
      for (int m = 0; m < 4; ++m) {
        const int row = row0 + ai * HALF + m * 16;
        *(u32x4*)(H + (size_t)row * HS + u.pn * BM + cl) = pack8(acc[ai][0][m][0], acc[ai][0][m][1]);
        if (which < 0) {
          *(u32x4*)(H + (size_t)row * HS + u.pn * BM + HALF + cl) = pack8(acc[ai][1][m][0], acc[ai][1][m][1]);
        } else {
          const int b = row >> 11, t = row & 2047;
          bf16_t* vp = VT + ((size_t)((which * 8 + b) * 128 + cl)) * 2048 + t;
#pragma unroll
          for (int j = 0; j < 4; ++j) { vp[(size_t)j * 2048] = f2bf(acc[ai][1][m][0][j]); vp[(size_t)(4 + j) * 2048] = f2bf(acc[ai][1][m][1][j]); }
        }
      }
  }
};
DI void phase1(const Params& p, char* smraw) {
  Gemm g{(const bf16_t*)(WS(p) + O_XN), (const bf16_t*)(WS(p) + O_WTA), 1024, 1024, 1024};
  StaticOrder S; S.init(NTOK, HS, gridDim.x, bidx());
  EpiH E{(bf16_t*)(WS(p) + O_H), (bf16_t*)(WS(p) + O_VT)};
  gemm_phase<EpiH, StaticOrder>((LAS unsigned char*)smraw, g, S, E);
}

DI void compress_tile2(const Params& p, int l_, int tix, char* smraw) {
  const int half = tidx() >> 8, tid = tidx() & 255;
  const int which = tix >> 4, mt = tix & 15;
  bf16_t* sm = (bf16_t*)(smraw + half * SMEM_BYTES);
  const bf16_t* hb = (const bf16_t*)(WS(p) + O_H);
  const bf16_t* w1t = (const bf16_t*)(WS(p) + (which ? O_W1V : O_W1K));
  const bf16_t* w2t = (const bf16_t*)(WS(p) + (which ? O_W2V : O_W2K));
  const float* peb = (const float*)(WS(p) + O_PEB) + which * 128;
  const int lane = tid & 63, w = tid >> 6, wm = w >> 1, wn = w & 1, h = lane >> 5, r31 = lane & 31;
  const int wr = tid >> 3, wc = (tid & 7) * 8;
  const int col0 = which ? C_VC : C_KC;
  const bf16_t* ap[4];
#pragma unroll
  for (int i = 0; i < 4; ++i) {
    int m = mt * 128 + wr + 32 * i; if (m >= 2032) m = 0;
    const int b = m / 254, rem = m - b * 254, n = rem >> 1, g = rem & 1;
    ap[i] = hb + ((size_t)(b * 2048 + 16 * n + 16 * half)) * HS + col0 + g * 64 + wc;
  }
  const bf16_t* b0 = w1t + (size_t)wr * 2048 + wc + half * 1024;
  f32x16 acc[2][2];
  gemm_core(acc, ap[0], ap[1], ap[2], ap[3], HS, b0, b0 + 32 * 2048, b0 + 64 * 2048, b0 + 96 * 2048, 16, sm, tid);
  float4* part = (float4*)(smraw + SMEM_BYTES);
  if (half == 1) {
#pragma unroll
    for (int i = 0; i < 2; ++i)
#pragma unroll
      for (int j = 0; j < 2; ++j)
#pragma unroll
        for (int q = 0; q < 4; ++q)
          part[((i * 2 + j) * 4 + q) * 256 + tid] = make_float4(acc[i][j][4 * q], acc[i][j][4 * q + 1], acc[i][j][4 * q + 2], acc[i][j][4 * q + 3]);
  }
  __syncthreads();
  bf16_t* Hs = (bf16_t*)smraw;
  if (half == 0) {
#pragma unroll
    for (int i = 0; i < 2; ++i)
#pragma unroll
      for (int j = 0; j < 2; ++j) {
        const int n = wn * 64 + 32 * j + r31;
        const float bias = peb[n];
#pragma unroll
        for (int q = 0; q < 4; ++q) {
          const float4 o = part[((i * 2 + j) * 4 + q) * 256 + tid];
          const int r = wm * 64 + 32 * i + 8 * q + 4 * h;
          Hs[(r + 0) * 136 + n] = f2bf(siluf_(acc[i][j][4 * q + 0] + o.x + bias));
          Hs[(r + 1) * 136 + n] = f2bf(siluf_(acc[i][j][4 * q + 1] + o.y + bias));
          Hs[(r + 2) * 136 + n] = f2bf(siluf_(acc[i][j][4 * q + 2] + o.z + bias));
          Hs[(r + 3) * 136 + n] = f2bf(siluf_(acc[i][j][4 * q + 3] + o.w + bias));
        }
      }
  }
  __syncthreads();
  if (half == 0) {
    f32x16 o2[2];
#pragma unroll
    for (int j = 0; j < 2; ++j)
#pragma unroll
      for (int e = 0; e < 16; ++e) o2[j][e] = 0.f;
#pragma unroll
    for (int s = 0; s < 8; ++s) {
      const bf16x8 fa = *(const bf16x8*)(Hs + (w * 32 + r31) * 136 + 16 * s + 8 * h);
#pragma unroll
      for (int j = 0; j < 2; ++j) {
        const bf16x8 fb = *(const bf16x8*)(w2t + (32 * j + r31) * 128 + 16 * s + 8 * h);
        o2[j] = MFMA32(fa, fb, o2[j]);
      }
    }
    bf16_t* kc = (bf16_t*)(WS(p) + O_KC); bf16_t* vct = (bf16_t*)(WS(p) + O_VCT);
#pragma unroll
    for (int j = 0; j < 2; ++j) {
      const int d = 32 * j + r31;
#pragma unroll
      for (int e = 0; e < 16; ++e) {
        const int m = mt * 128 + w * 32 + crow(e, h);
        if (m < 2032) {
          const int b = m / 254, rem = m - b * 254, n = rem >> 1, g = rem & 1;
          if (which == 0) kc[((size_t)((b * 2 + g) * 128 + n)) * 64 + d] = f2bf(o2[j][e]);
          else vct[((size_t)((b * 2 + g) * 64 + d)) * 128 + n] = f2bf(o2[j][e]);
        }
      }
    }
  }
  __builtin_amdgcn_fence(__ATOMIC_RELEASE, "agent");
  __syncthreads();
  if (tidx() == 0) atomicAdd((int*)(WS(p) + O_CNT) + 4 + l_, 1);
}

DI void rwkv_prep(const Params& p, int l, int item, char* smraw) {
  const bf16_t* hb = (const bf16_t*)(WS(p) + O_H);
  bf16_t* A1 = (bf16_t*)smraw;
  bf16_t* A2 = A1 + 64 * LDT;
  bf16_t* A3 = A2 + 64 * LDT;
  const int tid = tidx(), lane = tid & 63, w = (tid >> 6) & 3, tt = tid >> 8, h = lane >> 5, r31 = lane & 31;
  const int T0 = item * 64;
  const float* mu = IN(11) + l * 896;
  __syncthreads();
  bf16_t* SR = A3 + 64 * 264;
  {
    const bool seqstart = (T0 & 2047) == 0;
    uint4 sv[13];
#pragma unroll
    for (int i = 0; i < 13; ++i) {
      const int idx = tid + 512 * i, row = idx / 96, c = idx - row * 96;
      sv[i] = make_uint4(0, 0, 0, 0);
      if (idx < 65 * 96 && (row > 0 || !seqstart)) sv[i] = *(const uint4*)(hb + (size_t)(T0 - 1 + row) * HS + C_R + c * 8);
    }
#pragma unroll
    for (int i = 0; i < 13; ++i) {
      const int idx = tid + 512 * i, row = idx / 96, c = idx - row * 96;
      if (idx < 65 * 96) *(uint4*)(SR + row * 776 + c * 8) = sv[i];
    }
  }
#pragma unroll
  for (int idx = tid; idx < 64 * 16; idx += 512) {
    const int tok = idx >> 4, c8 = idx & 15;
    const size_t m = (size_t)(T0 + tok);
    const uint4 z = *(const uint4*)(hb + m * HS + C_WD + c8 * 8);
    uint4 zp = make_uint4(0, 0, 0, 0);
    if (((T0 + tok) & 2047) != 0) zp = *(const uint4*)(hb + (m - 1) * HS + C_WD + c8 * 8);
    const unsigned zz[4] = {z.x, z.y, z.z, z.w}, pp[4] = {zp.x, zp.y, zp.z, zp.w};
    unsigned oo[4];
#pragma unroll
    for (int e = 0; e < 4; ++e) {
      const float m0 = mu[768 + c8 * 8 + 2 * e], m1 = mu[768 + c8 * 8 + 2 * e + 1];
      float x0 = bflo(zz[e]), x1 = bfhi(zz[e]);
      x0 = x0 + (bflo(pp[e]) - x0) * m0; x1 = x1 + (bfhi(pp[e]) - x1) * m1;
      if (c8 < 8) { x0 = 1.f - 2.f * __builtin_amdgcn_rcpf(__expf(2.f * x0) + 1.f); x1 = 1.f - 2.f * __builtin_amdgcn_rcpf(__expf(2.f * x1) + 1.f); }
      oo[e] = pack2(x0, x1);
    }
    bf16_t* dst = (c8 < 8) ? (A1 + tok * LDT + c8 * 8) : (A2 + tok * LDT + (c8 - 8) * 8);
    *(uint4*)dst = make_uint4(oo[0], oo[1], oo[2], oo[3]);
  }
  __syncthreads();
  if (l == 1) {
    for (int idx = tid; idx < 64 * 32; idx += 512) {
      const int tok = idx >> 5, c8 = idx & 31;
      const size_t m = (size_t)(T0 + tok);
      const uint4 z = *(const uint4*)(SR + (tok + 1) * 776 + 512 + c8 * 8);
      const uint4 zp = *(const uint4*)(SR + tok * 776 + 512 + c8 * 8);
      const unsigned zz[4] = {z.x, z.y, z.z, z.w}, pp[4] = {zp.x, zp.y, zp.z, zp.w};
      unsigned oo[4];
#pragma unroll
      for (int e = 0; e < 4; ++e) {
        const float m0 = mu[512 + c8 * 8 + 2 * e], m1 = mu[512 + c8 * 8 + 2 * e + 1];
        float x0 = bflo(zz[e]), x1 = bfhi(zz[e]);
        x0 = x0 + (bflo(pp[e]) - x0) * m0; x1 = x1 + (bfhi(pp[e]) - x1) * m1;
        oo[e] = pack2(x0, x1);
      }
      *(uint4*)(A3 + tok * 264 + c8 * 8) = make_uint4(oo[0], oo[1], oo[2], oo[3]);
    }
  }
  __syncthreads();
  const bf16_t* lw2 = (const bf16_t*)(WS(p) + O_LW2);
  const bf16_t* la2 = (const bf16_t*)(WS(p) + O_LA2);
  const bf16_t* v1t = (const bf16_t*)(WS(p) + O_V1T);
  const bf16_t* v2t = (const bf16_t*)(WS(p) + O_V2T);
  const float* w0 = IN(12) + l * 256; const float* a0 = IN(14) + l * 256;
  const float* kkw = IN(16) + l * 256; const float* kaw = IN(17) + l * 256; const float* rkw = IN(18) + l * 256;
  const float* v0 = IN(21);
  bf16_t* vf = (bf16_t*)(WS(p) + O_VF);
  bf16_t* pr = (bf16_t*)(WS(p) + O_PR);
  float* bon = (float*)(WS(p) + O_BON);
  {
    const int tokl = 32 * tt + r31;
    const size_t m = (size_t)(T0 + tokl);
    const bool first = (((T0 + tokl) & 2047) == 0);
    const int b = (int)(m >> 11), t = (int)(m & 2047);
    float ss = 0.f;
#pragma unroll
    for (int nt = 0; nt < 2; ++nt)
#pragma unroll
      for (int q = 0; q < 4; ++q) {
        const int c = w * 64 + 32 * nt + 8 * q + 4 * h;
        const uint2 zk = *(const uint2*)(SR + (tokl + 1) * 776 + 256 + c);
        const uint2 pk_ = *(const uint2*)(SR + tokl * 776 + 256 + c);
        const float4 muk = *(const float4*)(mu + 256 + c);
        const float4 kw4 = *(const float4*)(kkw + c);
        float x0 = bflo(zk.x), x1 = bfhi(zk.x), x2 = bflo(zk.y), x3 = bfhi(zk.y);
        x0 = (x0 + (bflo(pk_.x) - x0) * muk.x) * kw4.x; x1 = (x1 + (bfhi(pk_.x) - x1) * muk.y) * kw4.y;
        x2 = (x2 + (bflo(pk_.y) - x2) * muk.z) * kw4.z; x3 = (x3 + (bfhi(pk_.y) - x3) * muk.w) * kw4.w;
        ss += x0 * x0 + x1 * x1 + x2 * x2 + x3 * x3;
      }
    ss = xor32_sum(ss);
    const float inv = 1.f / fmaxf(sqrtf(ss), 1e-12f);
    float bsum = 0.f;
    bf16_t* prow = pr + ((size_t)((b * 4 + w) * 2048 + t)) * 384;
#pragma unroll 1
    for (int nt = 0; nt < 2; ++nt) {
      f32x16 aw, aa, av;
#pragma unroll
      for (int e = 0; e < 16; ++e) { aw[e] = 0.f; aa[e] = 0.f; av[e] = 0.f; }
#pragma unroll
      for (int s = 0; s < 4; ++s) {
        const bf16x8 f1 = *(const bf16x8*)(A1 + (32 * tt + r31) * LDT + 16 * s + 8 * h);
        const bf16x8 f2 = *(const bf16x8*)(A2 + (32 * tt + r31) * LDT + 16 * s + 8 * h);
        const bf16x8 gw = *(const bf16x8*)(lw2 + (w * 64 + 32 * nt + r31) * 64 + 16 * s + 8 * h);
        const bf16x8 ga = *(const bf16x8*)(la2 + (w * 64 + 32 * nt + r31) * 64 + 16 * s + 8 * h);
        aw = MFMA32(gw, f1, aw);
        aa = MFMA32(ga, f2, aa);
      }
      if (l == 1) {
        f32x16 t1;
#pragma unroll
        for (int e = 0; e < 16; ++e) t1[e] = 0.f;
#pragma unroll
        for (int s = 0; s < 16; ++s) {
          const bf16x8 fv = *(const bf16x8*)(A3 + (32 * tt + r31) * 264 + 16 * s + 8 * h);
          const bf16x8 g1 = *(const bf16x8*)(v1t + r31 * 256 + 16 * s + 8 * h);
          t1 = MFMA32(g1, fv, t1);
        }
#pragma unroll
        for (int s = 0; s < 2; ++s) {
          unsigned pk[4];
#pragma unroll
          for (int e = 0; e < 4; ++e) pk[e] = pack2(t1[8 * s + 2 * e], t1[8 * s + 2 * e + 1]);
          const bf16x8 fb = __builtin_bit_cast(bf16x8, make_uint4(pk[0], pk[1], pk[2], pk[3]));
          const bf16_t* vr = v2t + (w * 64 + 32 * nt + r31) * 32 + 16 * s + 4 * h;
          const uint2 lo = *(const uint2*)vr; const uint2 hi = *(const uint2*)(vr + 8);
          const bf16x8 fa = __builtin_bit_cast(bf16x8, make_uint4(lo.x, lo.y, hi.x, hi.y));
          av = MFMA32(fa, fb, av);
        }
      }
      uint2 sto[4][6];
#pragma unroll
      for (int q = 0; q < 4; ++q) {
        const int cl = 32 * nt + 8 * q + 4 * h;
        const int c = w * 64 + cl;
        const uint2 zr = *(const uint2*)(SR + (tokl + 1) * 776 + c);
        const uint2 zk = *(const uint2*)(SR + (tokl + 1) * 776 + 256 + c);
        const uint2 zv = *(const uint2*)(SR + (tokl + 1) * 776 + 512 + c);
        const uint2 pr_ = *(const uint2*)(SR + tokl * 776 + c);
        const uint2 pk_ = *(const uint2*)(SR + tokl * 776 + 256 + c);
        const uint2 pv_ = *(const uint2*)(SR + tokl * 776 + 512 + c);
        uint2 vfl = make_uint2(0, 0);
        if (l == 1) vfl = *(const uint2*)(vf + m * 256 + c);
        float orr[4], ou[4], okp[4], ovv[4], oa[4], ob[4];
#pragma unroll
        for (int e = 0; e < 4; ++e) {
          const int cc = c + e; const int i = 4 * q + e;
          const unsigned zru = (e < 2) ? zr.x : zr.y, zku = (e < 2) ? zk.x : zk.y, zvu = (e < 2) ? zv.x : zv.y;
          const unsigned pru = (e < 2) ? pr_.x : pr_.y, pku = (e < 2) ? pk_.x : pk_.y, pvu = (e < 2) ? pv_.x : pv_.y;
          const unsigned vfu = (e < 2) ? vfl.x : vfl.y;
          float xr = (e & 1) ? bfhi(zru) : bflo(zru), xk = (e & 1) ? bfhi(zku) : bflo(zku), xv = (e & 1) ? bfhi(zvu) : bflo(zvu);
          const float qr = (e & 1) ? bfhi(pru) : bflo(pru), qk = (e & 1) ? bfhi(pku) : bflo(pku), qv = (e & 1) ? bfhi(pvu) : bflo(pvu);
          xr = xr + (qr - xr) * mu[cc]; xk = xk + (qk - xk) * mu[256 + cc]; xv = xv + (qv - xv) * mu[512 + cc];
          const float wl = w0[cc] + aw[i];
          const float ew = 0.60653065971f * sigmoidf_(wl);
          const float u = 1.f - __expf(-ew);
          const float a = sigmoidf_(a0[cc] + aa[i]);
          if (l == 1) {
            const float vfirst = (e & 1) ? bfhi(vfu) : bflo(vfu);
            xv = xv + (vfirst - xv) * sigmoidf_(v0[cc] + av[i]);
          }
          const float kk = xk * kkw[cc] * inv;
          const float kp = xk * (1.f + (a - 1.f) * kaw[cc]);
          bsum += xr * kp * rkw[cc];
          orr[e] = xr; ou[e] = u; okp[e] = kp; ovv[e] = xv; oa[e] = -kk; ob[e] = kk * a;
        }
        uint2 o;
        o.x = pack2(orr[0], orr[1]); o.y = pack2(orr[2], orr[3]); sto[q][0] = o;
        o.x = pack2(ou[0], ou[1]); o.y = pack2(ou[2], ou[3]); sto[q][1] = o;
        o.x = pack2(okp[0], okp[1]); o.y = pack2(okp[2], okp[3]); sto[q][2] = o;
        o.x = pack2(ovv[0], ovv[1]); o.y = pack2(ovv[2], ovv[3]); sto[q][3] = o;
        o.x = pack2(oa[0], oa[1]); o.y = pack2(oa[2], oa[3]); sto[q][4] = o;
        o.x = pack2(ob[0], ob[1]); o.y = pack2(ob[2], ob[3]); sto[q][5] = o;
      }
#pragma unroll
      for (int q = 0; q < 4; ++q) {
        const int cl = 32 * nt + 8 * q + 4 * h;
#pragma unroll
        for (int k6 = 0; k6 < 6; ++k6) *(uint2*)(prow + k6 * 64 + cl) = sto[q][k6];
        if (l == 0) *(uint2*)(vf + m * 256 + w * 64 + cl) = sto[q][3];
      }
    }
    bsum = xor32_sum(bsum);
    if (h == 0) bon[m * 4 + w] = bsum;
  }
  __syncthreads();
}

DI float dpp_add(float x, const int ctrl_sel) {
  int xi = __float_as_int(x), yi;
  if (ctrl_sel == 0) yi = __builtin_amdgcn_update_dpp(0, xi, 0xB1, 0xF, 0xF, true);
  else if (ctrl_sel == 1) yi = __builtin_amdgcn_update_dpp(0, xi, 0x4E, 0xF, 0xF, true);
  else if (ctrl_sel == 2) yi = __builtin_amdgcn_update_dpp(0, xi, 0x141, 0xF, 0xF, true);
  else yi = __builtin_amdgcn_update_dpp(0, xi, 0x140, 0xF, 0xF, true);
  return x + __int_as_float(yi);
}
DI float row16_sum(float x) { x = dpp_add(x, 0); x = dpp_add(x, 1); x = dpp_add(x, 2); x = dpp_add(x, 3); return x; }

DI void scan_put(const uint4& g, int idx, float* dstbase) {
  const int e0 = idx * 8; const int arr = (e0 % 384) >> 6;
  float f[8] = {bflo(g.x), bfhi(g.x), bflo(g.y), bfhi(g.y), bflo(g.z), bfhi(g.z), bflo(g.w), bfhi(g.w)};
  if (arr == 1) {
#pragma unroll
    for (int e = 0; e < 8; ++e) f[e] = 1.f - f[e];
  }
  *(float4*)(dstbase + e0) = make_float4(f[0], f[1], f[2], f[3]);
  *(float4*)(dstbase + e0 + 4) = make_float4(f[4], f[5], f[6], f[7]);
}
DI void rwkv_scan(const Params& p, int item, char* smraw) {
  const int rg = item & 3, hd = (item >> 2) & 3, b = item >> 4;
  float* stage = (float*)smraw;
  float* ypart = (float*)(smraw + 3 * 16 * 384 * 4);
  const bf16_t* pr = (const bf16_t*)(WS(p) + O_PR) + ((size_t)((b * 4 + hd) * 2048)) * 384;
  bf16_t* yr = (bf16_t*)(WS(p) + O_YR);
  const int tid = tidx(), row = (tid >> 4) & 15, kq = tid & 15;
  const bool comp = tid < 256;
  const int st_ = tid & 255;
  fv2 S01 = {0.f, 0.f}, S23 = {0.f, 0.f};
  uint4 g[3];
  __syncthreads();
  if (comp) __builtin_amdgcn_s_setprio(3);
  if (!comp) {
#pragma unroll
    for (int c0 = 0; c0 < 2; ++c0) {
#pragma unroll
      for (int i = 0; i < 3; ++i) g[i] = *(const uint4*)(pr + (size_t)c0 * 16 * 384 + (size_t)(st_ + 256 * i) * 8);
#pragma unroll
      for (int i = 0; i < 3; ++i) scan_put(g[i], st_ + 256 * i, stage + c0 * 16 * 384);
    }
#pragma unroll
    for (int i = 0; i < 3; ++i) g[i] = *(const uint4*)(pr + (size_t)2 * 16 * 384 + (size_t)(st_ + 256 * i) * 8);
  }
  __syncthreads();
  float4 Pr0, Pw0, Pk0, Pa0, Pb0, Pr1, Pw1, Pk1, Pa1, Pb1; float Pv0, Pv1;
  {
    const float* sp = stage + 4 * kq; const float* vp = stage + 3 * 64 + 16 * rg + row;
    Pr0 = *(const float4*)(sp + 0 * 64); Pw0 = *(const float4*)(sp + 1 * 64); Pk0 = *(const float4*)(sp + 2 * 64); Pa0 = *(const float4*)(sp + 4 * 64); Pb0 = *(const float4*)(sp + 5 * 64); Pv0 = vp[0];
    sp += 384; vp += 384;
    Pr1 = *(const float4*)(sp + 0 * 64); Pw1 = *(const float4*)(sp + 1 * 64); Pk1 = *(const float4*)(sp + 2 * 64); Pa1 = *(const float4*)(sp + 4 * 64); Pb1 = *(const float4*)(sp + 5 * 64); Pv1 = vp[0];
  }
  int cur = 0;
  for (int ch = 0; ch < 128; ++ch) {
    if (comp) {
      int nxt = cur + 1; if (nxt == 3) nxt = 0;
      const float* st = stage + cur * 16 * 384 + 4 * kq;
      const float* sv = stage + cur * 16 * 384 + 3 * 64 + 16 * rg + row;
      const float* stn = stage + nxt * 16 * 384 + 4 * kq;
      const float* svn = stage + nxt * 16 * 384 + 3 * 64 + 16 * rg + row;
#pragma unroll
      for (int s = 0; s < 16; ++s) {
        float4 cr, cw, ck, ca, cb; float cv;
        if (s & 1) { cr = Pr1; cw = Pw1; ck = Pk1; ca = Pa1; cb = Pb1; cv = Pv1; }
        else { cr = Pr0; cw = Pw0; ck = Pk0; ca = Pa0; cb = Pb0; cv = Pv0; }
        {
          const float* sp = (s < 14) ? (st + (s + 2) * 384) : (stn + (s - 14) * 384);
          const float* vp = (s < 14) ? (sv + (s + 2) * 384) : (svn + (s - 14) * 384);
          if (s & 1) { Pr1 = *(const float4*)(sp + 0 * 64); Pw1 = *(const float4*)(sp + 1 * 64); Pk1 = *(const float4*)(sp + 2 * 64); Pa1 = *(const float4*)(sp + 4 * 64); Pb1 = *(const float4*)(sp + 5 * 64); Pv1 = vp[0]; }
          else { Pr0 = *(const float4*)(sp + 0 * 64); Pw0 = *(const float4*)(sp + 1 * 64); Pk0 = *(const float4*)(sp + 2 * 64); Pa0 = *(const float4*)(sp + 4 * 64); Pb0 = *(const float4*)(sp + 5 * 64); Pv0 = vp[0]; }
        }
        const fv2 a01 = {ca.x, ca.y}, a23 = {ca.z, ca.w}, w01 = {cw.x, cw.y}, w23 = {cw.z, cw.w};
        const fv2 k01 = {ck.x, ck.y}, k23 = {ck.z, ck.w}, b01 = {cb.x, cb.y}, b23 = {cb.z, cb.w};
        const fv2 r01 = {cr.x, cr.y}, r23 = {cr.z, cr.w};
        const fv2 vv = {cv, cv};
        fv2 pa = S01 * a01; pa = __builtin_elementwise_fma(S23, a23, pa);
        float sa = pa.x + pa.y;
        const fv2 t01 = __builtin_elementwise_fma(S01, w01, vv * k01);
        const fv2 t23 = __builtin_elementwise_fma(S23, w23, vv * k23);
        sa = row16_sum(sa);
        const fv2 sav = {sa, sa};
        S01 = __builtin_elementwise_fma(sav, b01, t01);
        S23 = __builtin_elementwise_fma(sav, b23, t23);
        fv2 py = S01 * r01; py = __builtin_elementwise_fma(S23, r23, py);
        ypart[(ch & 1) * 4096 + s * 256 + tid] = py.x + py.y;
      }
    } else {
      if (ch > 0) {
        const float4* yq = (const float4*)(ypart + ((ch - 1) & 1) * 4096 + st_ * 16);
        const float4 y0 = yq[0], y1 = yq[1], y2 = yq[2], y3 = yq[3];
        const float ys = ((y0.x + y0.y) + (y0.z + y0.w)) + ((y1.x + y1.y) + (y1.z + y1.w)) + ((y2.x + y2.y) + (y2.z + y2.w)) + ((y3.x + y3.y) + (y3.z + y3.w));
        yr[((size_t)(b * 2048 + (ch - 1) * 16 + (st_ >> 4))) * 256 + hd * 64 + 16 * rg + (st_ & 15)] = f2bf(ys);
      }
      if (ch + 2 < 128) {
        int nb = cur + 2; if (nb >= 3) nb -= 3;
        float* dst = stage + nb * 16 * 384;
#pragma unroll
        for (int i = 0; i < 3; ++i) scan_put(g[i], st_ + 256 * i, dst);
      }
      if (ch + 3 < 128) {
        const bf16_t* src = pr + (size_t)(ch + 3) * 16 * 384;
#pragma unroll
        for (int i = 0; i < 3; ++i) g[i] = *(const uint4*)(src + (size_t)(st_ + 256 * i) * 8);
      }
    }
    __syncthreads();
    cur = (cur == 2) ? 0 : cur + 1;
  }
  __builtin_amdgcn_s_setprio(0);
  if (!comp) {
    const float4* yq = (const float4*)(ypart + (127 & 1) * 4096 + st_ * 16);
    const float4 y0 = yq[0], y1 = yq[1], y2 = yq[2], y3 = yq[3];
    const float ys = ((y0.x + y0.y) + (y0.z + y0.w)) + ((y1.x + y1.y) + (y1.z + y1.w)) + ((y2.x + y2.y) + (y2.z + y2.w)) + ((y3.x + y3.y) + (y3.z + y3.w));
    yr[((size_t)(b * 2048 + 127 * 16 + (st_ >> 4))) * 256 + hd * 64 + 16 * rg + (st_ & 15)] = f2bf(ys);
  }
  __syncthreads();
}

constexpr float SL2 = 0.125f * 1.4426950408889634f;

template <int MODE>
DI void attn_loop(const bf16_t* kb, long kstride, const bf16_t* vtb, long vstride, int jlo, int jhi,
                  const bf16x8 (&qf)[4], int qpos, unsigned sel, unsigned uni, int W, int qmin, int qmax,
                  f32x16 (&o)[2], float& m, float& l, bf16_t* Ks, bf16_t* Vs,
                  float* impw = nullptr, float* lastb = nullptr, float* mts = nullptr) {
  const int tid = tidx(), lane = tid & 63, h = lane >> 5, r31 = lane & 31;
  const int lr = tid >> 3, lc = (tid & 7) * 8;
  int j = jlo;
  if (MODE == 1) { while (j <= jhi && !((uni >> j) & 1)) ++j; }
  uint4 k0, v0;
  if (j <= jhi) {
    k0 = *(const uint4*)(kb + (long)(64 * j + lr) * kstride + lc);
    v0 = *(const uint4*)(vtb + (long)lr * vstride + 64 * j + lc);
  }
  while (j <= jhi) {
    __syncthreads();
    *(uint4*)(Ks + lr * LDT + lc) = k0;
    *(uint4*)(Vs + lr * LDT + lc) = v0;
    __syncthreads();
    int jn = j + 1;
    if (MODE == 1) { while (jn <= jhi && !((uni >> jn) & 1)) ++jn; }
    if (jn <= jhi) {
      k0 = *(const uint4*)(kb + (long)(64 * jn + lr) * kstride + lc);
      v0 = *(const uint4*)(vtb + (long)lr * vstride + 64 * jn + lc);
    }
    __builtin_amdgcn_sched_barrier(0);
    f32x16 s[2];
#pragma unroll
    for (int kt = 0; kt < 2; ++kt) {
#pragma unroll
      for (int e = 0; e < 16; ++e) s[kt][e] = 0.f;
#pragma unroll
      for (int si = 0; si < 4; ++si) {
        const bf16x8 fa = *(const bf16x8*)(Ks + (32 * kt + r31) * LDT + 16 * si + 8 * h);
        s[kt] = MFMA32(fa, qf[si], s[kt]);
      }
    }
    const bool selj = (MODE == 1) ? (((sel >> j) & 1) != 0) : true;
    const bool interior = (MODE == 1) ? (64 * j + 63 <= qmin) : (MODE == 2) ? ((64 * j + 63 <= qmin) && (qmax - 64 * j < W)) : false;
    float mx = -1e30f;
    if (interior) {
#pragma unroll
      for (int kt = 0; kt < 2; ++kt)
#pragma unroll
        for (int e = 0; e < 16; ++e) {
          const float v = (MODE == 1) ? (selj ? s[kt][e] : -1e30f) : s[kt][e];
          s[kt][e] = v; mx = fmaxf(mx, v);
        }
    } else {
#pragma unroll
      for (int kt = 0; kt < 2; ++kt)
#pragma unroll
        for (int e = 0; e < 16; ++e) {
          const int key = 64 * j + 32 * kt + crow(e, h);
          bool valid;
          if (MODE == 0) valid = (16 * key + 31 <= qpos);
          else if (MODE == 1) valid = selj && (key <= qpos);
          else valid = (key <= qpos) && (qpos - key < W);
          const float v = valid ? s[kt][e] : -1e30f;
          s[kt][e] = v; mx = fmaxf(mx, v);
        }
    }
    mx = xor32_max(mx);
    const float mnew = fmaxf(m, mx);
    const float alpha = __builtin_amdgcn_exp2f(m - mnew);
    m = mnew; l *= alpha;
    if (__builtin_amdgcn_ballot_w64(alpha != 1.f)) {
#pragma unroll
      for (int e = 0; e < 16; ++e) { o[0][e] *= alpha; o[1][e] *= alpha; }
    }
    if (interior && (MODE == 2 || mnew > -1e29f)) {
#pragma unroll
      for (int kt = 0; kt < 2; ++kt)
#pragma unroll
        for (int e = 0; e < 16; ++e) {
          const float pv = __builtin_amdgcn_exp2f(s[kt][e] - mnew);
          l += pv; s[kt][e] = pv;
        }
    } else {
#pragma unroll
      for (int kt = 0; kt < 2; ++kt)
#pragma unroll
        for (int e = 0; e < 16; ++e) {
          const float pv = (s[kt][e] > -1e29f) ? __builtin_amdgcn_exp2f(s[kt][e] - mnew) : 0.f;
          l += pv; s[kt][e] = pv;
        }
    }
    if (MODE == 0) {
      if (impw != nullptr) {
#pragma unroll
        for (int kt = 0; kt < 2; ++kt)
#pragma unroll
          for (int q = 0; q < 4; ++q) {
            impw[16 * j + 8 * kt + 2 * q + h] = (s[kt][4 * q] + s[kt][4 * q + 1]) + (s[kt][4 * q + 2] + s[kt][4 * q + 3]);
            lastb[(j * 8 + kt * 4 + q) * 512 + tid] = s[kt][4 * q + 3];
          }
        mts[j * 512 + tid] = mnew;
      }
    }
#pragma unroll
    for (int kt = 0; kt < 2; ++kt)
#pragma unroll
      for (int sp = 0; sp < 2; ++sp) {
        const bf16x8 fb = __builtin_bit_cast(bf16x8, make_uint4(pack2(s[kt][8 * sp + 0], s[kt][8 * sp + 1]), pack2(s[kt][8 * sp + 2], s[kt][8 * sp + 3]),
                                                               pack2(s[kt][8 * sp + 4], s[kt][8 * sp + 5]), pack2(s[kt][8 * sp + 6], s[kt][8 * sp + 7])));
#pragma unroll
        for (int dt = 0; dt < 2; ++dt) {
          const bf16_t* vr = Vs + (32 * dt + r31) * LDT + 32 * kt + 16 * sp + 4 * h;
          const uint2 lo = *(const uint2*)vr; const uint2 hi = *(const uint2*)(vr + 8);
          const bf16x8 fa = __builtin_bit_cast(bf16x8, make_uint4(lo.x, lo.y, hi.x, hi.y));
          o[dt] = MFMA32(fa, fb, o[dt]);
        }
      }
    j = jn;
  }
}

DI void scale_q(bf16x8 (&qf)[4]) {
#pragma unroll
  for (int s = 0; s < 4; ++s) {
    const uint4 t = __builtin_bit_cast(uint4, qf[s]);
    qf[s] = __builtin_bit_cast(bf16x8, make_uint4(pack2(bflo(t.x) * SL2, bfhi(t.x) * SL2), pack2(bflo(t.y) * SL2, bfhi(t.y) * SL2),
                                                  pack2(bflo(t.z) * SL2, bfhi(t.z) * SL2), pack2(bflo(t.w) * SL2, bfhi(t.w) * SL2)));
  }
}
DI void zero_o(f32x16 (&o)[2]) {
#pragma unroll
  for (int e = 0; e < 16; ++e) { o[0][e] = 0.f; o[1][e] = 0.f; }
}

DI void nsa_item(const Params& p, int l_, int item, char* smraw, bool wr = true) {
  const int qb = 31 - (item >> 4), bg = item & 15, b = bg >> 1, g = bg & 1;
  bf16_t* Ks = (bf16_t*)smraw; bf16_t* Vs = Ks + 64 * LDT;
  float* imp = (float*)(smraw + 18432);
  float* scs = (float*)(smraw + 18432 + 33792);
  unsigned* selm = (unsigned*)(smraw + 18432 + 33792 + 8448);
  const bf16_t* hb = (const bf16_t*)(WS(p) + O_H);
  bf16_t* hw = (bf16_t*)(WS(p) + O_H);
  const bf16_t* vt = (const bf16_t*)(WS(p) + O_VT);
  const int tid = tidx(), lane = tid & 63, w = (tid >> 6) & 3, qh = tid >> 8, h = lane >> 5, r31 = lane & 31;
  const int H = g * 4 + w;
  const int qpos = 64 * qb + 32 * qh + r31;
  const size_t mrow = (size_t)b * 2048 + qpos;
  const int cur = qb;
  bf16x8 qf[4];
#pragma unroll
  for (int s = 0; s < 4; ++s) qf[s] = *(const bf16x8*)(hb + mrow * HS + C_AQ + H * 64 + 16 * s + 8 * h);
  scale_q(qf);
  const float g0 = sigmoidf_(bf2f(hb[mrow * HS + C_GATE + 0 * 8 + H]));
  const float g1 = sigmoidf_(bf2f(hb[mrow * HS + C_GATE + 1 * 8 + H]));
  const float g2 = sigmoidf_(bf2f(hb[mrow * HS + C_GATE + 2 * 8 + H]));
  f32x16 ot[2], o[2];
  float m, l;
  zero_o(o); m = -1e30f; l = 0.f;
  const int lo_ = 64 * qb - 511;
  const int jlo = (lo_ <= 0) ? 0 : (lo_ >> 6);
  attn_loop<2>(hb + (size_t)b * 2048 * HS + C_KW + g * 64, HS, vt + ((size_t)((1 * 8 + b) * 128 + g * 64)) * 2048, 2048, jlo, cur, qf, qpos, 0u, 0u, 512, 64 * qb, 64 * qb + 63, o, m, l, Ks, Vs);
  float lt = xor32_sum(l);
  float inv = (lt > 0.f) ? 1.f / lt : 0.f;
#pragma unroll
  for (int e = 0; e < 16; ++e) { ot[0][e] = g2 * inv * o[0][e]; ot[1][e] = g2 * inv * o[1][e]; }
  {
    int* seen = (int*)(smraw + DYN_XB + 20);
    if (*seen == 0) {
      if (tid == 0) {
        const int* cd = (const int*)(WS(p) + O_CNT) + 4 + l_;
        unsigned spins = 0;
        while (__hip_atomic_load(cd, __ATOMIC_RELAXED, __HIP_MEMORY_SCOPE_AGENT) < 32 && ++spins < (1u << 22)) __builtin_amdgcn_s_sleep(2);
      }
      __syncthreads();
      __builtin_amdgcn_fence(__ATOMIC_ACQUIRE, "agent");
      if (tid == 0) *seen = 1;
      __syncthreads();
    }
  }
  const bf16_t* kcb = (const bf16_t*)(WS(p) + O_KC) + (size_t)bg * 128 * 64;
  const bf16_t* vcb = (const bf16_t*)(WS(p) + O_VCT) + (size_t)bg * 64 * 128;
  const int ntile = (4 * qb + 3 + 63) >> 6;
  zero_o(o); m = -1e30f; l = 0.f;
  float* impw = imp + (w * 64 + 32 * qh + r31) * 33;
  float* lastb = (float*)(smraw + 61440);
  float* mts = (float*)(smraw + 61440 + 32768);
  if (cur >= 16) attn_loop<0>(kcb, 64, vcb, 128, 0, ntile - 1, qf, qpos, 0u, 0u, 0, 64 * qb, 64 * qb + 63, o, m, l, Ks, Vs, impw, lastb, mts);
  else attn_loop<0>(kcb, 64, vcb, 128, 0, ntile - 1, qf, qpos, 0u, 0u, 0, 64 * qb, 64 * qb + 63, o, m, l, Ks, Vs);
  lt = xor32_sum(l);
  inv = (lt > 0.f) ? 1.f / lt : 0.f;
#pragma unroll
  for (int e = 0; e < 16; ++e) { ot[0][e] += g0 * inv * o[0][e]; ot[1][e] += g0 * inv * o[1][e]; }
  unsigned sel, uni;
  if (cur < 16) {
    sel = (1u << (cur + 1)) - 1u; uni = sel;
  } else {
    {
      const float f0 = __builtin_amdgcn_exp2f(mts[tid] - m) * inv, f1 = __builtin_amdgcn_exp2f(mts[512 + tid] - m) * inv;
#pragma unroll
      for (int jt = 0; jt < 2; ++jt)
#pragma unroll
        for (int kt = 0; kt < 2; ++kt)
#pragma unroll
          for (int q = 0; q < 4; ++q) impw[16 * jt + 8 * kt + 2 * q + h] *= (jt ? f1 : f0);
      __syncthreads();
#pragma unroll
      for (int jt = 0; jt < 2; ++jt)
#pragma unroll
        for (int kt = 0; kt < 2; ++kt)
#pragma unroll
          for (int q = 0; q < 4; ++q) {
            const int j1 = 16 * jt + 8 * kt + 2 * q + h + 1;
            if (j1 < 32) impw[j1] += lastb[(jt * 8 + kt * 4 + q) * 512 + tid] * (jt ? f1 : f0);
          }
      __syncthreads();
    }
    {
      const int ql = tid >> 3, jj = tid & 7;
#pragma unroll
      for (int e = 0; e < 4; ++e) {
        const int j = jj * 4 + e;
        float sc;
        if (j == 0 || j == cur || j == cur - 1) sc = 1e9f;
        else if (j <= cur) sc = ((imp[(0 * 64 + ql) * 33 + j] + imp[(1 * 64 + ql) * 33 + j]) + imp[(2 * 64 + ql) * 33 + j]) + imp[(3 * 64 + ql) * 33 + j];
        else sc = -1e9f;
        scs[ql * 33 + j] = sc;
      }
      if (tid < 65) selm[tid] = 0u;
    }
    __syncthreads();
    {
      const int ql = tid >> 3, jj = tid & 7;
      unsigned bits = 0u;
#pragma unroll
      for (int e = 0; e < 4; ++e) {
        const int j = jj * 4 + e;
        const float my = scs[ql * 33 + j];
        int rank = 0;
#pragma unroll
        for (int j2 = 0; j2 < 32; ++j2) {
          const float o2 = scs[ql * 33 + j2];
          rank += (o2 > my || (o2 == my && j2 < j)) ? 1 : 0;
        }
        if (rank < 16) bits |= (1u << j);
      }
      atomicOr(&selm[ql], bits);
      atomicOr(&selm[64], bits);
    }
    __syncthreads();
    sel = selm[32 * qh + r31]; uni = selm[64];
  }
  zero_o(o); m = -1e30f; l = 0.f;
  if (cur < 16)
    attn_loop<2>(hb + (size_t)b * 2048 * HS + C_KS + g * 64, HS, vt + ((size_t)((0 * 8 + b) * 128 + g * 64)) * 2048, 2048, 0, cur, qf, qpos, 0u, 0u, 1 << 30, 64 * qb, 64 * qb + 63, o, m, l, Ks, Vs);
  else
  attn_loop<1>(hb + (size_t)b * 2048 * HS + C_KS + g * 64, HS, vt + ((size_t)((0 * 8 + b) * 128 + g * 64)) * 2048, 2048, 0, cur, qf, qpos, sel, uni, 0, 64 * qb, 64 * qb + 63, o, m, l, Ks, Vs);
  lt = xor32_sum(l);
  inv = (lt > 0.f) ? 1.f / lt : 0.f;
#pragma unroll
  for (int e = 0; e < 16; ++e) { ot[0][e] += g1 * inv * o[0][e]; ot[1][e] += g1 * inv * o[1][e]; }
#pragma unroll
  for (int dt = 0; dt < 2; ++dt)
#pragma unroll
    for (int q = 0; q < 4; ++q) {
      const int d = 32 * dt + 8 * q + 4 * h;
      bf16_t* zp = hw + mrow * HS + C_AZ + H * 64 + d;
      const uint2 z = *(const uint2*)zp;
      uint2 ov;
      ov.x = pack2(ot[dt][4 * q] * siluf_(bflo(z.x)), ot[dt][4 * q + 1] * siluf_(bfhi(z.x)));
      ov.y = pack2(ot[dt][4 * q + 2] * siluf_(bflo(z.y)), ot[dt][4 * q + 3] * siluf_(bfhi(z.y)));
      if (wr) *(uint2*)zp = ov;
    }
  __syncthreads();
}

DI void swa_item(const Params& p, int l_, int item, char* smraw, bool wr = true) {
  const int qb = 15 - (item >> 4), bg = item & 15, b = bg >> 1, g = bg & 1;
  bf16_t* Ks = (bf16_t*)smraw; bf16_t* Vs = Ks + 64 * LDT;
  const bf16_t* hb = (const bf16_t*)(WS(p) + O_H);
  bf16_t* hw = (bf16_t*)(WS(p) + O_H);
  const bf16_t* vt = (const bf16_t*)(WS(p) + O_VT);
  const int tid = tidx(), lane = tid & 63, w = tid >> 6, h = lane >> 5, r31 = lane & 31;
  const int H = g * 2 + (w & 1);
  const int qpos = 128 * qb + 32 * (w >> 1) + r31;
  const size_t mrow = (size_t)b * 2048 + qpos;
  bf16x8 qf[4];
#pragma unroll
  for (int s = 0; s < 4; ++s) qf[s] = *(const bf16x8*)(hb + mrow * HS + C_BQ + H * 64 + 16 * s + 8 * h);
  scale_q(qf);
  const float sink = IN(10)[l_ * 4 + H] * 1.4426950408889634f;
  f32x16 o[2];
  zero_o(o);
  float m = sink, l = (h == 0) ? 1.f : 0.f;
  const int jlo = (qb >= 1) ? 2 * qb - 2 : 0;
  attn_loop<2>(hb + (size_t)b * 2048 * HS + C_BK + g * 64, HS, vt + ((size_t)((2 * 8 + b) * 128 + g * 64)) * 2048, 2048, jlo, 2 * qb + 1, qf, qpos, 0u, 0u, 128, 128 * qb, 128 * qb + 127, o, m, l, Ks, Vs);
  const float lt = xor32_sum(l);
  const float inv = (lt > 0.f) ? 1.f / lt : 0.f;
#pragma unroll
  for (int dt = 0; dt < 2; ++dt)
#pragma unroll
    for (int q = 0; q < 4; ++q) {
      const int d = 32 * dt + 8 * q + 4 * h;
      bf16_t* zp = hw + mrow * HS + C_BZ + H * 64 + d;
      const uint2 z = *(const uint2*)zp;
      uint2 ov;
      ov.x = pack2(inv * o[dt][4 * q] * siluf_(bflo(z.x)), inv * o[dt][4 * q + 1] * siluf_(bfhi(z.x)));
      ov.y = pack2(inv * o[dt][4 * q + 2] * siluf_(bflo(z.y)), inv * o[dt][4 * q + 3] * siluf_(bfhi(z.y)));
      if (wr) *(uint2*)zp = ov;
    }
  __syncthreads();
}

DI void rwkv_post(const Params& p, int l) {
  const int lane = tidx() & 63, hd = (tidx() >> 6) & 3, sub = tidx() >> 8;
  const bf16_t* yr = (const bf16_t*)(WS(p) + O_YR);
  const bf16_t* pr = (const bf16_t*)(WS(p) + O_PR);
  const float* bon = (const float*)(WS(p) + O_BON);
  bf16_t* hw = (bf16_t*)(WS(p) + O_H);
  const float lw = IN(19)[l * 256 + hd * 64 + lane], lb = IN(20)[l * 256 + hd * 64 + lane];
  for (int it = bidx(); it < NTOK / 16; it += gridDim.x) {
    float y[8], v[8], z[8], bo[8];
#pragma unroll
    for (int q = 0; q < 8; ++q) {
      const size_t m = (size_t)it * 16 + sub * 8 + q;
      const int b = (int)(m >> 11), t = (int)(m & 2047);
      y[q] = bf2f(yr[m * 256 + hd * 64 + lane]);
      v[q] = bf2f(pr[((size_t)((b * 4 + hd) * 2048 + t)) * 384 + 3 * 64 + lane]);
      z[q] = bf2f(hw[m * HS + C_CZ + hd * 64 + lane]);
      bo[q] = bon[m * 4 + hd];
    }
#pragma unroll
    for (int q = 0; q < 8; ++q) {
      const size_t m = (size_t)it * 16 + sub * 8 + q;
      const float mean = wave_sum_fast(y[q]) * (1.f / 64.f);
      const float dlt = y[q] - mean;
      const float var = wave_sum_fast(dlt * dlt) * (1.f / 64.f);
      float o = dlt * rsqrtf(var + 64e-5f) * lw + lb + bo[q] * v[q];
      o *= siluf_(z[q]);
      hw[m * HS + C_CZ + hd * 64 + lane] = f2bf(o);
    }
  }
}

struct EpiP {
  static constexpr bool PERM = true, AFTER_DRAIN = false;
  char* scr;
  DI void operator()(const f32x4 (&acc)[2][2][4][2], const Unit&, int, int, int, int) const {
    char* sb = scr; asm volatile("" : "+s"(sb));
    const unsigned toff = (unsigned)tidx() * 16u;
#pragma unroll
    for (int ai = 0; ai < 2; ++ai)
#pragma unroll
      for (int m = 0; m < 4; ++m)
#pragma unroll
        for (int bj = 0; bj < 2; ++bj) *(u32x4*)(sb + (size_t)(((ai * 4 + m) * 2 + bj) * 8192) + toff) = pack8(acc[ai][bj][m][0], acc[ai][bj][m][1]);
  }
};
struct EpiMix {
  static constexpr bool PERM = true, AFTER_DRAIN = false;
  const char* scr; bf16_t* mixed; const float* bias; int first;
  DI void operator()(const f32x4 (&acc)[2][2][4][2], const Unit& u, int wr, int wc, int fr, int fq) const {
    const int row0 = u.pm * BM + wr * 64 + fr, col0 = u.pn * BM + wc * 32 + 8 * fq;
    const char* sb = scr; asm volatile("" : "+s"(sb));
    const unsigned toff = (unsigned)tidx() * 16u;
#pragma unroll
    for (int ai = 0; ai < 2; ++ai)
#pragma unroll
      for (int mp = 0; mp < 2; ++mp) {
        u32x4 pv[2][2], ov[2][2];
        f32x4 bv[2][2];
#pragma unroll
        for (int bj = 0; bj < 2; ++bj)
#pragma unroll
          for (int n = 0; n < 2; ++n) bv[bj][n] = *(const f32x4*)(bias + col0 + bj * HALF + 4 * n);
#pragma unroll
        for (int mm = 0; mm < 2; ++mm)
#pragma unroll
          for (int bj = 0; bj < 2; ++bj) {
            const int m = mp * 2 + mm;
            pv[mm][bj] = *(const u32x4*)(sb + (size_t)(((ai * 4 + m) * 2 + bj) * 8192) + toff);
            ov[mm][bj] = (u32x4){0u, 0u, 0u, 0u};
            if (!first) ov[mm][bj] = *(const u32x4*)(mixed + (size_t)(row0 + ai * HALF + m * 16) * 1024 + col0 + bj * HALF);
          }
#pragma unroll
        for (int mm = 0; mm < 2; ++mm)
#pragma unroll
          for (int bj = 0; bj < 2; ++bj) {
            const int m = mp * 2 + mm;
            const f32x4 g0 = acc[ai][bj][m][0] + bv[bj][0], g1 = acc[ai][bj][m][1] + bv[bj][1];
            const u32x4 p_ = pv[mm][bj], o_ = ov[mm][bj];
            u32x4 w;
            w.x = pack2(bflo(o_.x) + sigmoidf_(g0[0]) * bflo(p_.x), bfhi(o_.x) + sigmoidf_(g0[1]) * bfhi(p_.x));
            w.y = pack2(bflo(o_.y) + sigmoidf_(g0[2]) * bflo(p_.y), bfhi(o_.y) + sigmoidf_(g0[3]) * bfhi(p_.y));
            w.z = pack2(bflo(o_.z) + sigmoidf_(g1[0]) * bflo(p_.z), bfhi(o_.z) + sigmoidf_(g1[1]) * bfhi(p_.z));
            w.w = pack2(bflo(o_.w) + sigmoidf_(g1[2]) * bflo(p_.w), bfhi(o_.w) + sigmoidf_(g1[3]) * bfhi(p_.w));
            *(u32x4*)(mixed + (size_t)(row0 + ai * HALF + m * 16) * 1024 + col0 + bj * HALF) = w;
          }
      }
  }
};
struct Sub5 { const char* A; const char* B; int nt; int isP; };
DI Sub5 p5_sub(int i, const Unit& u, const bf16_t* hb, const bf16_t* xn, const bf16_t* wtm, const bf16_t* wtp) {
  const int br = i >> 1;
  Sub5 s;
  if (!(i & 1)) {
    const int zc = (br == 0) ? C_AZ : (br == 1) ? C_BZ : C_CZ;
    const int kof = (br == 0) ? 0 : (br == 1) ? 512 : 768;
    s.A = (const char*)(hb + zc + (size_t)u.pm * BM * HS);
    s.B = (const char*)(wtp + kof + (size_t)u.pn * BM * 1024);
    s.nt = (br == 0) ? 8 : 4; s.isP = 1;
  } else {
    s.A = (const char*)(xn + (size_t)u.pm * BM * 1024);
    s.B = (const char*)(wtm + ((size_t)br * 1024 + (size_t)u.pn * BM) * 1024);
    s.nt = 16; s.isP = 0;
  }
  return s;
}
DI void gemm_phase_p5(LAS unsigned char* lds, const Unit u, const bf16_t* hb, const bf16_t* xn, const bf16_t* wtm, const bf16_t* wtp,
                      char* scr, bf16_t* mixed, const float* bmerge) {
    const int tid = tidx(), wid = __builtin_amdgcn_readfirstlane(tid >> 6), lane = tid & 63, wr = wid >> 2, wc = wid & 3, fr = lane & 15, fq = lane >> 4;
    unsigned rowA, col2;
    { int R, C; stage_rc(tid * 16, R, C); rowA = (unsigned)R; col2 = (unsigned)C * 2u; }
#define PG8_ROWB ((rowA & ~31u) + (unsigned)perm32((int)(rowA & 31u)))
    const unsigned ldX = 1024u * 2u, ldH = (unsigned)HS * 2u;
    const size_t kstep = (size_t)(BK * 2);
    const size_t hstepB = (size_t)HALF * 1024 * 2, hsX = (size_t)HALF * 1024 * 2, hsH = (size_t)HALF * HS * 2;
    const unsigned ldsw = (unsigned)wid * 1024u;
    const int aoff = lds_byte(wr * 64 + fr, fq * 8), boff = lds_byte(wc * 32 + fr, fq * 8);
#define PG8_SA(b, h) (((b) * 2 + (h)) * HTB)
#define PG8_SB(b, h) ((4 + (b) * 2 + (h)) * HTB)
#define PG8_STAGE2(bufoff, gbase, row_, ld_) do { const unsigned v0__ = (row_) * (ld_) + col2;         __builtin_amdgcn_global_load_lds((const unsigned*)((const char*)(gbase) + v0__), (LAS unsigned*)(lds + (bufoff) + ldsw), 16, 0, 0);         __builtin_amdgcn_global_load_lds((const unsigned*)((const char*)(gbase) + (size_t)(64u * (ld_)) + v0__), (LAS unsigned*)(lds + (bufoff) + ldsw + 8192), 16, 0, 0); } while (0)
#define PG8_LDA(dst, b, h) do { _Pragma("unroll") for (int m = 0; m < 4; ++m) _Pragma("unroll") for (int k = 0; k < 2; ++k) dst[m][k] = *(const LAS bf16x8*)(lds + PG8_SA(b, h) + aoff + m * 2048 + k * 1024); } while (0)
#define PG8_LDB(dst, b, h) do { _Pragma("unroll") for (int n = 0; n < 2; ++n) _Pragma("unroll") for (int k = 0; k < 2; ++k) dst[n][k] = *(const LAS bf16x8*)(lds + PG8_SB(b, h) + boff + n * 2048 + k * 1024); } while (0)
#define PG8_MMA(ai, bj, At, Bt) do { __builtin_amdgcn_s_setprio(1); _Pragma("unroll") for (int m = 0; m < 4; ++m) _Pragma("unroll") for (int n = 0; n < 2; ++n) _Pragma("unroll") for (int k = 0; k < 2; ++k)         acc[ai][bj][m][n] = __builtin_amdgcn_mfma_f32_16x16x32_bf16(Bt[n][k], At[m][k], acc[ai][bj][m][n], 0, 0, 0); __builtin_amdgcn_s_setprio(0); } while (0)
#define PG8_WAIT_V(n) asm volatile("s_waitcnt vmcnt(" #n ")" ::: "memory")
#define PG8_WAIT_L(n) asm volatile("s_waitcnt lgkmcnt(" #n ")" ::: "memory")
#define PG8_BAR __builtin_amdgcn_s_barrier()
#define PG8_SCHED __builtin_amdgcn_sched_barrier(0)
    Sub5 cur = p5_sub(0, u, hb, xn, wtm, wtp), nxt;
    f32x4 acc[2][2][4][2];
#pragma unroll
    for (int a = 0; a < 2; ++a)
#pragma unroll
        for (int b = 0; b < 2; ++b)
#pragma unroll
            for (int m = 0; m < 4; ++m)
#pragma unroll
                for (int n = 0; n < 2; ++n) acc[a][b][m][n] = (f32x4){0.f, 0.f, 0.f, 0.f};
    bf16x8 At[4][2], B0[2][2], B1[2][2];
    unsigned ldc = cur.isP ? ldH : ldX;
    size_t hsc = cur.isP ? hsH : hsX;
    PG8_STAGE2(PG8_SB(0, 0), cur.B, PG8_ROWB, ldX); PG8_STAGE2(PG8_SA(0, 0), cur.A, rowA, ldc);
    PG8_STAGE2(PG8_SB(0, 1), cur.B + hstepB, PG8_ROWB, ldX); PG8_STAGE2(PG8_SA(0, 1), cur.A + hsc, rowA, ldc);
    if (wr == 1) PG8_BAR;
    PG8_WAIT_V(4); PG8_BAR;
    PG8_STAGE2(PG8_SB(1, 0), cur.B + kstep, PG8_ROWB, ldX); PG8_STAGE2(PG8_SA(1, 0), cur.A + kstep, rowA, ldc);
    PG8_STAGE2(PG8_SB(1, 1), cur.B + hstepB + kstep, PG8_ROWB, ldX);
    PG8_WAIT_V(6); PG8_BAR;
#pragma unroll 1
    for (int ui = 0;; ++ui) {
        const bool has_next = ui < 5;
        nxt = has_next ? p5_sub(ui + 1, u, hb, xn, wtm, wtp) : cur;
        const unsigned ldn = nxt.isP ? ldH : ldX;
        const size_t hsn = nxt.isP ? hsH : hsX;
        const int nt = cur.nt;
#pragma unroll 1
        for (int t = 0; t < nt; t += 2) {
            const bool last = (t == nt - 2);
            const char* a1 = cur.A + (size_t)(t + 1) * kstep;
            const char* a2 = last ? nxt.A : cur.A + (size_t)(t + 2) * kstep; const char* b2 = last ? nxt.B : cur.B + (size_t)(t + 2) * kstep;
            const unsigned ld2 = last ? ldn : ldc; const size_t hs2 = last ? hsn : hsc;
            const char* a3 = a2 + kstep; const char* b3 = b2 + kstep;
            PG8_LDB(B0, 0, 0); PG8_SCHED; PG8_LDA(At, 0, 0); PG8_STAGE2(PG8_SA(1, 1), a1 + hsc, rowA, ldc);
            PG8_WAIT_L(8); PG8_BAR; PG8_WAIT_L(0); PG8_MMA(0, 0, At, B0); PG8_BAR; PG8_SCHED;
            PG8_LDB(B1, 0, 1); PG8_STAGE2(PG8_SB(0, 0), b2, PG8_ROWB, ldX);
            PG8_BAR; PG8_WAIT_L(0); PG8_MMA(0, 1, At, B1); PG8_BAR;
            PG8_LDA(At, 0, 1); PG8_STAGE2(PG8_SA(0, 0), a2, rowA, ld2);
            PG8_BAR; PG8_WAIT_L(0); PG8_MMA(1, 0, At, B0); PG8_BAR; PG8_SCHED;
            PG8_STAGE2(PG8_SB(0, 1), b2 + hstepB, PG8_ROWB, ldX);
            PG8_WAIT_V(6); PG8_BAR; PG8_MMA(1, 1, At, B1); PG8_BAR;
            PG8_LDB(B0, 1, 0); PG8_SCHED; PG8_LDA(At, 1, 0); PG8_STAGE2(PG8_SA(0, 1), a2 + hs2, rowA, ld2);
            PG8_WAIT_L(8); PG8_BAR; PG8_WAIT_L(0); PG8_MMA(0, 0, At, B0); PG8_BAR; PG8_SCHED;
            PG8_LDB(B1, 1, 1); PG8_STAGE2(PG8_SB(1, 0), b3, PG8_ROWB, ldX);
            PG8_BAR; PG8_WAIT_L(0); PG8_MMA(0, 1, At, B1); PG8_BAR;
            PG8_LDA(At, 1, 1); PG8_STAGE2(PG8_SA(1, 0), a3, rowA, ld2);
            PG8_BAR; PG8_WAIT_L(0); PG8_MMA(1, 0, At, B0); PG8_BAR; PG8_SCHED;
            PG8_STAGE2(PG8_SB(1, 1), b3 + hstepB, PG8_ROWB, ldX);
            PG8_WAIT_V(6); PG8_BAR; PG8_MMA(1, 1, At, B1); PG8_BAR;
        }
        PG8_SCHED;
        {
          const int t2 = tidx(), fr2 = t2 & 15, fq2 = (t2 & 63) >> 4;
          if (cur.isP) { EpiP E{scr}; E(acc, u, wr, wc, fr2, fq2); }
          else { const int br = ui >> 1; EpiMix E{scr, mixed, bmerge + br * 1024, br == 0 ? 1 : 0}; E(acc, u, wr, wc, fr2, fq2); }
        }
        PG8_SCHED;
        if (!has_next) break;
#pragma unroll
        for (int a = 0; a < 2; ++a)
#pragma unroll
            for (int b = 0; b < 2; ++b)
#pragma unroll
                for (int m = 0; m < 4; ++m)
#pragma unroll
                    for (int n = 0; n < 2; ++n) acc[a][b][m][n] = (f32x4){0.f, 0.f, 0.f, 0.f};
        cur = nxt; ldc = ldn; hsc = hsn;
    }
    PG8_WAIT_V(0);
    if (wr == 0) PG8_BAR;
    PG8_BAR;
#undef PG8_SA
#undef PG8_SB
#undef PG8_STAGE2
#undef PG8_ROWB
#undef PG8_LDA
#undef PG8_LDB
#undef PG8_MMA
#undef PG8_WAIT_V
#undef PG8_WAIT_L
#undef PG8_BAR
#undef PG8_SCHED
}
DI void phase5(const Params& p, int l, char* smraw) {
  const bf16_t* xn = (const bf16_t*)(WS(p) + O_XN);
  const bf16_t* hb = (const bf16_t*)(WS(p) + O_H);
  const bf16_t* wtm = (const bf16_t*)(WS(p) + O_WTM);
  const bf16_t* wtp = (const bf16_t*)(WS(p) + O_WTP);
  bf16_t* mixed = (bf16_t*)(WS(p) + O_PR);
  const int blk = bidx();
  char* sbase = (blk < 128) ? (WS(p) + O_PR + (size_t)NTOK * 1024 * 2 + (size_t)blk * 131072)
              : (blk < 224) ? (WS(p) + O_VT + (size_t)(blk - 128) * 131072)
                            : (WS(p) + O_YR + (size_t)(blk - 224) * 131072);
  char* scr = sbase;
  StaticOrder S; S.init(NTOK, 1024, gridDim.x, bidx());
  Unit u;
  for (int i = 0; S.next(i, u); ++i)
    gemm_phase_p5((LAS unsigned char*)smraw, u, hb, xn, wtm, wtp, scr, mixed, IN(3) + l * 3072);
}

struct EpiRes {
  static constexpr bool PERM = false, AFTER_DRAIN = false;
  const float* X; float* O;
  DI void operator()(const f32x4 (&acc)[2][2][4][2], const Unit& u, int wr, int wc, int fr, int fq) const {
    const int row0 = u.pm * BM + wr * 64 + fr, col0 = u.pn * BM + wc * 32 + 4 * fq;
#pragma unroll
    for (int ai = 0; ai < 2; ++ai)
#pragma unroll
      for (int mp = 0; mp < 2; ++mp) {
        f32x4 xv[2][2][2];
#pragma unroll
        for (int mm = 0; mm < 2; ++mm)
#pragma unroll
          for (int bj = 0; bj < 2; ++bj)
#pragma unroll
            for (int n = 0; n < 2; ++n)
              xv[mm][bj][n] = *(const f32x4*)(X + (size_t)(row0 + ai * HALF + (mp * 2 + mm) * 16) * 1024 + col0 + bj * HALF + n * 16);
#pragma unroll
        for (int mm = 0; mm < 2; ++mm)
#pragma unroll
          for (int bj = 0; bj < 2; ++bj)
#pragma unroll
            for (int n = 0; n < 2; ++n)
              *(f32x4*)(O + (size_t)(row0 + ai * HALF + (mp * 2 + mm) * 16) * 1024 + col0 + bj * HALF + n * 16) = xv[mm][bj][n] + acc[ai][bj][mp * 2 + mm][n];
      }
  }
};
DI void phase6(const Params& p, int l, char* smraw) {
  Gemm g{(const bf16_t*)(WS(p) + O_PR), (const bf16_t*)(WS(p) + O_WTO), 1024, 1024, 1024};
  StaticOrder S; S.init(NTOK, 1024, gridDim.x, bidx());
  EpiRes E{(l == 0) ? IN(0) : OUTP(), OUTP()};
  gemm_phase<EpiRes, StaticOrder>((LAS unsigned char*)smraw, g, S, E);
}

#define XB_TMO      128
#define XB_XCNT(j)  (256  + 64 * (j))
#define XB_XSUB(j)  (1280 + 64 * (j))
#define XB_XGEN(j)  (2304 + 64 * (j))
#define XB_TOP      3328
#define XB_TOPGEN   3392
#define XCD_BAR_WORDS 3456
#define XB_SPIN_CAP (1u << 18)

__device__ __forceinline__ unsigned xb_ld(unsigned* p)              { return __hip_atomic_load(p, __ATOMIC_RELAXED, __HIP_MEMORY_SCOPE_AGENT); }
__device__ __forceinline__ unsigned xb_add(unsigned* p, unsigned v) { return __hip_atomic_fetch_add(p, v, __ATOMIC_RELAXED, __HIP_MEMORY_SCOPE_AGENT); }
__device__ __forceinline__ unsigned xb_xcc_id() { return (unsigned)__builtin_amdgcn_s_getreg((3 << 11) | 20) & 0xFu; }
#define XB_SPIN(cond, bar) do { unsigned _sp = 0; while (cond) { __builtin_amdgcn_s_sleep(1); \
    if ((++_sp & 255u) == 0u) { if (xb_ld(&(bar)[XB_TMO])) break; if (_sp > XB_SPIN_CAP) { atomicAdd(&(bar)[XB_TMO], 1u); break; } } } } while (0)

struct XcdBarrier {
    unsigned* bar; unsigned x;
    volatile LAS unsigned* st;
};

__device__ __forceinline__ XcdBarrier xcd_barrier_post(unsigned* bar, volatile LAS unsigned* st) {
    XcdBarrier b; b.bar = bar; b.x = xb_xcc_id(); b.st = st;
    if (tidx() == 0) (void)xb_add(&bar[XB_XCNT(b.x)], 1u);
    return b;
}
__device__ __forceinline__ void xcd_barrier_complete(unsigned* bar, unsigned x, unsigned& nloc, unsigned& nx) {
    const unsigned G = gridDim.x * gridDim.y * gridDim.z;
    unsigned sum, cnt, mine, sp = 0u;
    for (;;) {
        sum = 0u; cnt = 0u; mine = 0u;
#pragma unroll
        for (unsigned j = 0; j < 16; ++j) { const unsigned c = xb_ld(&bar[XB_XCNT(j)]); sum += c; cnt += (c > 0u) ? 1u : 0u; mine = (j == x) ? c : mine; }
        if (sum == G) break;
        __builtin_amdgcn_s_sleep(1);
        if ((++sp & 255u) == 0u) { if (xb_ld(&bar[XB_TMO])) break; if (sp > XB_SPIN_CAP) { atomicAdd(&bar[XB_TMO], 1u); break; } }
    }
    nloc = mine > 0u ? mine : 1u; nx = cnt > 0u ? cnt : 1u;
}

__device__ __forceinline__ void xcd_barrier(const XcdBarrier& b) {
    asm volatile("s_waitcnt vmcnt(0)" ::: "memory");
    __syncthreads();
    if (tidx() == 0) {
        unsigned* bar = b.bar; asm volatile("" : "+s"(bar));
        __builtin_amdgcn_s_waitcnt(0);
        unsigned nloc = b.st[0], nx = b.st[1];
        if (nloc == 0u) { xcd_barrier_complete(bar, b.x, nloc, nx); b.st[0] = nloc; b.st[1] = nx; }
        const unsigned old = xb_add(&bar[XB_XSUB(b.x)], 1u);
        const unsigned gen = old / nloc;
        if (old + 1u == (gen + 1u) * nloc) {
            __builtin_amdgcn_fence(__ATOMIC_RELEASE, "agent");
            asm volatile("s_waitcnt vmcnt(0)" ::: "memory");
            const unsigned og = xb_add(&bar[XB_TOP], 1u);
            const unsigned tg = og / nx;
            if (og + 1u == (tg + 1u) * nx) xb_add(&bar[XB_TOPGEN], 1u);
            else XB_SPIN(xb_ld(&bar[XB_TOPGEN]) == tg, bar);
            __builtin_amdgcn_fence(__ATOMIC_ACQUIRE, "agent");
            xb_add(&bar[XB_XGEN(b.x)], 1u);
            asm volatile("s_waitcnt vmcnt(0)" ::: "memory");
        } else {
            XB_SPIN(xb_ld(&bar[XB_XGEN(b.x)]) == gen, bar);
            __builtin_amdgcn_fence(__ATOMIC_ACQUIRE, "agent");
            asm volatile("s_waitcnt vmcnt(0)" ::: "memory");
        }
    }
    __syncthreads();
}


__global__ void __launch_bounds__(512, 2) fwd_megakernel(Params p) {
  cg::grid_group grid = cg::this_grid();
  extern __shared__ __attribute__((aligned(16))) char smraw[];
  uint4* xb_words = (uint4*)(smraw + DYN_XB);
  int* s_item = (int*)(smraw + DYN_XB + 16);
  if (tidx() == 0) *xb_words = make_uint4(0u, 0u, 0u, 0u);
  __syncthreads();
  XcdBarrier xb = xcd_barrier_post((unsigned*)(WS(p) + O_BAR), (volatile LAS unsigned*)xb_words);
  if (WS(p) == nullptr) grid.sync();
  unsigned long long tacc = 0ull, t0 = 0ull;
#define TB(k) do { if (PROBE_T == (k)) t0 = __builtin_amdgcn_s_memrealtime(); } while (0)
#define TE(k) do { if (PROBE_T == (k)) tacc += __builtin_amdgcn_s_memrealtime() - t0; } while (0)
  for (int l = 0; l < 2; ++l) {
    TB(10);
    phase0(p, l, smraw);
    xcd_barrier(xb);
    TE(10); TB(11);
    phase1(p, smraw);
    xcd_barrier(xb);
    TE(11); TB(12);
    for (int it = bidx(); it < 256; it += gridDim.x) rwkv_prep(p, l, it, smraw);
    xcd_barrier(xb);
    TE(12); TB(13); TB(18);
    {
      int* cnt = (int*)(WS(p) + O_CNT) + l;
      if (tidx() == 0) *(int*)(smraw + DYN_XB + 20) = 0;
      __syncthreads();
      for (int it = bidx(); it < 128; it += gridDim.x) rwkv_scan(p, it, smraw);
      TE(18);
      while (true) {
        if (tidx() == 0) *s_item = atomicAdd(cnt, 1);
        __syncthreads();
        const int item = *s_item;
        __syncthreads();
        if (item >= 32 + 512 + 256) break;
        if (item < 32) compress_tile2(p, l, item, smraw);
        else if (item < 32 + 256) swa_item(p, l, item - 32, smraw);
        else nsa_item(p, l, item - 32 - 256, smraw);
      }
      TB(19);
    }
    xcd_barrier(xb);
    TE(13); TE(19); TB(14);
    rwkv_post(p, l);
    xcd_barrier(xb);
    TE(14); TB(15);
    phase5(p, l, smraw);
    xcd_barrier(xb);
    TE(15); TB(16);
    phase6(p, l, smraw);
    xcd_barrier(xb);
    TE(16);
  }
  TB(17);
  rmsnorm_rows(OUTP(), IN(28), nullptr, OUTP());
  TE(17);
  if (PROBE_T && bidx() == 0) {
    asm volatile("s_waitcnt vmcnt(0)" ::: "memory");
    __syncthreads();
    if (tidx() == 0) atomicAdd(OUTP(), 0.04f + (float)tacc * 0.01f * PROBE_TSCALE);
  }
}

extern "C" void kernel_launch(void* const* d_in, const int* in_sizes, int n_in, void* d_out, int out_size, void* d_ws,
                              size_t ws_size, hipStream_t stream) {
  static int grid_blocks = 0;
  if (!grid_blocks) {
    int dev = 0, cus = 0, per_cu = 0;
    (void)hipGetDevice(&dev);
    (void)hipDeviceGetAttribute(&cus, hipDeviceAttributeMultiprocessorCount, dev);
    if (hipFuncSetAttribute((const void*)fwd_megakernel, hipFuncAttributeMaxDynamicSharedMemorySize, DYN_LDS) != hipSuccess) {
      fprintf(stderr, "hipFuncSetAttribute failed\n"); grid_blocks = -1;
    } else {
      (void)hipOccupancyMaxActiveBlocksPerMultiprocessor(&per_cu, (const void*)fwd_megakernel, 512, DYN_LDS);
      if (per_cu > 1) per_cu = 1;
      grid_blocks = (cus * per_cu) & ~7;
      if (grid_blocks > 256) grid_blocks = 256;
    }
  }
  if (ws_size < WS_TOTAL || grid_blocks < 8) {
    fprintf(stderr, "workspace too small or grid too small: %zu < %zu, grid %d\n", ws_size, (size_t)WS_TOTAL, grid_blocks);
    return;
  }
  Params p{};
  for (int i = 0; i < 29; ++i) p.in[i] = (const float*)d_in[i];
  p.out = (float*)d_out;
  p.ws = (char*)d_ws;
  (void)hipMemsetAsync((char*)d_ws + O_BAR, 0, 16384, stream);
  void* args[] = {&p};
  hipError_t e = hipLaunchCooperativeKernel((void*)fwd_megakernel, dim3(grid_blocks), dim3(512), args, DYN_LDS, stream);
  if (e != hipSuccess) fprintf(stderr, "cooperative launch failed: %s (grid %d)\n", hipGetErrorString(e), grid_blocks);
}
```
